# Optimizing an MI355X kernel written in HIP

```python
import math
import jax, jax.numpy as jnp
from jax import lax
import numpy as np

D_MODEL = 2048
BATCH = 1
SEQ = 16384
DEPTH = 2

GRID_W = 64
CTX_LEN = 256

HEAD_DIM = 128
ATTN_WIDTH = D_MODEL // 2
N_Q_HEADS = ATTN_WIDTH // HEAD_DIM
N_KV_HEADS = 2
Q_PER_KV = N_Q_HEADS // N_KV_HEADS
KV_WIDTH = N_KV_HEADS * HEAD_DIM
Q_BLOCK = 128
ROPE_THETA = 10000.0
ROPE_PAIRS = HEAD_DIM // 4

SSM_WIDTH = D_MODEL // 4
SSM_GROUP = 16
N_SSM_GROUPS = SSM_WIDTH // SSM_GROUP
SSM_STATE = 64
DT_MIN = 0.001
DT_MAX = 0.1

FOURIER_WIDTH = D_MODEL - ATTN_WIDTH - SSM_WIDTH
FOURIER_HEADS = 4
FOURIER_HEAD_DIM = FOURIER_WIDTH // FOURIER_HEADS

Q_END = ATTN_WIDTH
K_END = Q_END + KV_WIDTH
V_END = K_END + KV_WIDTH
S_END = V_END + SSM_WIDTH
IN_WIDTH = S_END + FOURIER_WIDTH

FFN_HIDDEN = ((8 * D_MODEL // 3 + 255) // 256) * 256
NORM_EPS = 1e-6

kernel_name = 'hybrid_gqa_s5_fnet_diffusion_block'


def rms_norm(x, g):
    x32 = x.astype(jnp.float32)
    r = x32 * lax.rsqrt(jnp.mean(x32 * x32, axis=-1, keepdims=True) + NORM_EPS)
    return (r * g.astype(jnp.float32)).astype(x.dtype)


def modulate(h, shift, scale):
    return h * (1 + scale) + shift


def axial_rope_tables(rows):
    row = jnp.repeat(jnp.arange(rows, dtype=jnp.float32), GRID_W)
    col = jnp.tile(jnp.arange(GRID_W, dtype=jnp.float32), rows)
    freqs = ROPE_THETA ** (-jnp.arange(ROPE_PAIRS, dtype=jnp.float32) / ROPE_PAIRS)
    ang_r = (row[:, None] * freqs)[:, None, :]
    ang_c = (col[:, None] * freqs)[:, None, :]
    return (jnp.cos(ang_r), jnp.sin(ang_r), jnp.cos(ang_c), jnp.sin(ang_c))


def apply_axial_rope(x, tabs):
    cr, sr, cc, sc = [t.astype(x.dtype) for t in tabs]
    x1, x2, x3, x4 = jnp.split(x, 4, axis=-1)
    return jnp.concatenate([x1 * cr - x2 * sr, x2 * cr + x1 * sr,
                            x3 * cc - x4 * sc, x4 * cc + x3 * sc], axis=-1)


def attend(q, k, v):
    s = jnp.einsum('bqkgd,bskd->bkgqs', q, k).astype(jnp.float32) * (HEAD_DIM ** -0.5)
    p = jax.nn.softmax(s, axis=-1).astype(v.dtype)
    return jnp.einsum('bkgqs,bskd->bqkgd', p, v)


def latent_attention(q, k_all, v_all):
    b, l = q.shape[:2]
    nb = l // Q_BLOCK
    qb = jnp.moveaxis(q.reshape(b, nb, Q_BLOCK, N_KV_HEADS, Q_PER_KV, HEAD_DIM), 1, 0)
    o = lax.map(lambda qblk: attend(qblk, k_all, v_all), qb)
    return jnp.moveaxis(o, 0, 1).reshape(b, l, ATTN_WIDTH)


def s5_discretize(lam_re, lam_im, log_dt, b_re, b_im):
    lr = lam_re.astype(jnp.float32)
    li = lam_im.astype(jnp.float32)
    dt = jnp.exp(log_dt.astype(jnp.float32))[:, None]
    mag = jnp.exp(lr * dt)
    ar = mag * jnp.cos(li * dt)
    ai = mag * jnp.sin(li * dt)
    den = lr * lr + li * li
    cr = ((ar - 1.0) * lr + ai * li) / den
    ci = (ai * lr - (ar - 1.0) * li) / den
    br = b_re.astype(jnp.float32)
    bi = b_im.astype(jnp.float32)
    bbr = cr[..., None] * br - ci[..., None] * bi
    bbi = cr[..., None] * bi + ci[..., None] * br
    return ar, ai, bbr, bbi


def s5_combine(e1, e2):
    a1r, a1i, b1r, b1i = e1
    a2r, a2i, b2r, b2i = e2
    return (a2r * a1r - a2i * a1i, a2r * a1i + a2i * a1r,
            a2r * b1r - a2i * b1i + b2r, a2r * b1i + a2i * b1r + b2i)


def s5_scan(u, ar, ai, bbr, bbi, h0, reverse):
    l = u.shape[1]
    bu_r = jnp.einsum('blgh,gph->blgp', u, bbr)
    bu_i = jnp.einsum('blgh,gph->blgp', u, bbi)
    if h0 is not None:
        h0r, h0i = h0
        edge = l - 1 if reverse else 0
        bu_r = bu_r.at[:, edge].add(ar * h0r - ai * h0i)
        bu_i = bu_i.at[:, edge].add(ar * h0i + ai * h0r)
    shape = bu_r.shape
    elems = (jnp.broadcast_to(ar, shape), jnp.broadcast_to(ai, shape), bu_r, bu_i)
    _, _, hr, hi = lax.associative_scan(s5_combine, elems, reverse=reverse, axis=1)
    return hr, hi


def s5_readout(hr, hi, c_re, c_im):
    return (jnp.einsum('blgp,ghp->blgh', hr, c_re.astype(jnp.float32))
            - jnp.einsum('blgp,ghp->blgh', hi, c_im.astype(jnp.float32)))


def s5_bidirectional(u, uc, lam_re, lam_im, log_dt, b_re, b_im, c_re, c_im, d, need_ctx):
    b, l = u.shape[:2]
    u32 = u.astype(jnp.float32).reshape(b, l, N_SSM_GROUPS, SSM_GROUP)
    uc32 = uc.astype(jnp.float32).reshape(b, uc.shape[1], N_SSM_GROUPS, SSM_GROUP)
    dd = d.astype(jnp.float32).reshape(N_SSM_GROUPS, SSM_GROUP)
    y = dd * u32
    yc = dd * uc32 if need_ctx else None
    for direction in range(2):
        rev = direction == 1
        ar, ai, bbr, bbi = s5_discretize(lam_re[direction], lam_im[direction],
                                         log_dt[direction], b_re[direction], b_im[direction])
        hcr, hci = s5_scan(uc32, ar, ai, bbr, bbi, None, rev)
        end = 0 if rev else -1
        hr, hi = s5_scan(u32, ar, ai, bbr, bbi, (hcr[:, end], hci[:, end]), rev)
        y = y + s5_readout(hr, hi, c_re[direction], c_im[direction])
        if need_ctx:
            yc = yc + s5_readout(hcr, hci, c_re[direction], c_im[direction])
    y = y.reshape(b, l, SSM_WIDTH).astype(u.dtype)
    if need_ctx:
        yc = yc.reshape(b, uc.shape[1], SSM_WIDTH).astype(uc.dtype)
    return y, yc


def s5_glu(y, w, bias):
    g = jax.nn.gelu(y)
    return g * jax.nn.sigmoid(g @ w + bias)


def fourier_mix(u):
    b, l = u.shape[:2]
    u32 = u.astype(jnp.float32).reshape(b, l, FOURIER_HEADS, FOURIER_HEAD_DIM)
    f = jnp.fft.fftn(u32, axes=(1, 3), norm='ortho').real
    return f.reshape(b, l, FOURIER_WIDTH).astype(u.dtype)


def swiglu(h, w_gate, w_up, w_down):
    return (jax.nn.silu(h @ w_gate) * (h @ w_up)) @ w_down


def mixer(h, hc, tabs, w_in, q_norm, k_norm, lam_re, lam_im, log_dt, b_re, b_im,
          c_re, c_im, ssm_d, glu_w, glu_b, fourier_w, w_out, need_ctx):
    b, l, _ = h.shape
    n_ctx = hc.shape[1]
    proj = h @ w_in
    q = rms_norm(proj[..., :Q_END].reshape(b, l, N_Q_HEADS, HEAD_DIM), q_norm)
    q = apply_axial_rope(q, tabs).reshape(b, l, N_KV_HEADS, Q_PER_KV, HEAD_DIM)
    k = apply_axial_rope(rms_norm(proj[..., Q_END:K_END].reshape(b, l, N_KV_HEADS, HEAD_DIM), k_norm), tabs)
    v = proj[..., K_END:V_END].reshape(b, l, N_KV_HEADS, HEAD_DIM)
    u_s = proj[..., V_END:S_END]
    u_f = proj[..., S_END:]
    proj_c = hc @ (w_in if need_ctx else w_in[:, Q_END:S_END])
    off = 0 if need_ctx else Q_END
    kc = rms_norm(proj_c[..., Q_END - off:K_END - off].reshape(b, n_ctx, N_KV_HEADS, HEAD_DIM), k_norm)
    vc = proj_c[..., K_END - off:V_END - off].reshape(b, n_ctx, N_KV_HEADS, HEAD_DIM)
    uc_s = proj_c[..., V_END - off:S_END - off]

    attn = latent_attention(q, jnp.concatenate([k, kc], axis=1), jnp.concatenate([v, vc], axis=1))
    ys, ysc = s5_bidirectional(u_s, uc_s, lam_re, lam_im, log_dt, b_re, b_im, c_re, c_im, ssm_d, need_ctx)
    ssm_out = s5_glu(ys, glu_w, glu_b)
    four = fourier_mix(u_f) @ fourier_w
    y = jnp.concatenate([attn, ssm_out, four], axis=-1) @ w_out
    if not need_ctx:
        return y, None
    qc = rms_norm(proj_c[..., :Q_END].reshape(b, n_ctx, N_Q_HEADS, HEAD_DIM), q_norm)
    qc = qc.reshape(b, n_ctx, N_KV_HEADS, Q_PER_KV, HEAD_DIM)
    attn_c = attend(qc, kc, vc).reshape(b, n_ctx, ATTN_WIDTH)
    four_c = fourier_mix(proj_c[..., S_END:]) @ fourier_w
    yc = jnp.concatenate([attn_c, s5_glu(ysc, glu_w, glu_b), four_c], axis=-1) @ w_out
    return y, yc


def setup_inputs(seed: int = 0) -> dict:
    key = jax.random.key(seed)
    ks = jax.random.split(key, 28)
    f32 = jnp.float32

    def nrm(k, shape, scale):
        return jax.random.normal(k, shape, f32) * scale

    g_p = (DEPTH, 2, N_SSM_GROUPS, SSM_STATE)
    n_idx = jnp.arange(SSM_STATE, dtype=f32)
    return {
        'x': nrm(ks[0], (BATCH, SEQ, D_MODEL), 1.0),
        'c': nrm(ks[1], (BATCH, D_MODEL), 1.0),
        'ctx': nrm(ks[2], (BATCH, CTX_LEN, D_MODEL), 1.0),
        'c_ctx': nrm(ks[3], (D_MODEL,), 1.0),
        'ada_w': nrm(ks[4], (DEPTH, D_MODEL, 6 * D_MODEL), 0.5 * D_MODEL ** -0.5),
        'ada_b': nrm(ks[5], (DEPTH, 6 * D_MODEL), 0.01),
        'norm_mix_pre': 1 + nrm(ks[6], (DEPTH, D_MODEL), 0.05),
        'norm_mix_post': 1 + nrm(ks[7], (DEPTH, D_MODEL), 0.05),
        'norm_ffn_pre': 1 + nrm(ks[8], (DEPTH, D_MODEL), 0.05),
        'norm_ffn_post': 1 + nrm(ks[9], (DEPTH, D_MODEL), 0.05),
        'w_in': nrm(ks[10], (DEPTH, D_MODEL, IN_WIDTH), D_MODEL ** -0.5),
        'q_norm': 1 + nrm(ks[11], (DEPTH, HEAD_DIM), 0.05),
        'k_norm': 1 + nrm(ks[12], (DEPTH, HEAD_DIM), 0.05),
        'ssm_lam_re': -0.5 + nrm(ks[13], g_p, 0.02),
        'ssm_lam_im': math.pi * n_idx + nrm(ks[14], g_p, 0.02),
        'ssm_log_dt': jax.random.uniform(ks[15], (DEPTH, 2, N_SSM_GROUPS), f32,
                                         math.log(DT_MIN), math.log(DT_MAX)),
        'ssm_b_re': nrm(ks[16], (DEPTH, 2, N_SSM_GROUPS, SSM_STATE, SSM_GROUP), (2 * SSM_GROUP) ** -0.5),
        'ssm_b_im': nrm(ks[17], (DEPTH, 2, N_SSM_GROUPS, SSM_STATE, SSM_GROUP), (2 * SSM_GROUP) ** -0.5),
        'ssm_c_re': nrm(ks[18], (DEPTH, 2, N_SSM_GROUPS, SSM_GROUP, SSM_STATE), (2 * SSM_STATE) ** -0.5),
        'ssm_c_im': nrm(ks[19], (DEPTH, 2, N_SSM_GROUPS, SSM_GROUP, SSM_STATE), (2 * SSM_STATE) ** -0.5),
        'ssm_d': nrm(ks[20], (DEPTH, SSM_WIDTH), 1.0),
        'ssm_glu_w': nrm(ks[21], (DEPTH, SSM_WIDTH, SSM_WIDTH), SSM_WIDTH ** -0.5),
        'ssm_glu_b': nrm(ks[22], (DEPTH, SSM_WIDTH), 0.01),
        'fourier_w': nrm(ks[23], (DEPTH, FOURIER_WIDTH, FOURIER_WIDTH), FOURIER_WIDTH ** -0.5),
        'w_out': nrm(ks[24], (DEPTH, D_MODEL, D_MODEL), D_MODEL ** -0.5),
        'ffn_w_gate': nrm(ks[25], (DEPTH, D_MODEL, FFN_HIDDEN), D_MODEL ** -0.5),
        'ffn_w_up': nrm(ks[26], (DEPTH, D_MODEL, FFN_HIDDEN), D_MODEL ** -0.5),
        'ffn_w_down': nrm(ks[27], (DEPTH, FFN_HIDDEN, D_MODEL), FFN_HIDDEN ** -0.5),
    }


def reference(x, c, ctx, c_ctx, ada_w, ada_b, norm_mix_pre, norm_mix_post, norm_ffn_pre,
              norm_ffn_post, w_in, q_norm, k_norm, ssm_lam_re, ssm_lam_im, ssm_log_dt,
              ssm_b_re, ssm_b_im, ssm_c_re, ssm_c_im, ssm_d, ssm_glu_w, ssm_glu_b,
              fourier_w, w_out, ffn_w_gate, ffn_w_up, ffn_w_down):
    n_tok = x.shape[1]
    ROWS = n_tok // GRID_W
    tabs = axial_rope_tables(ROWS)
    xc = ctx
    for layer in range(DEPTH):
        need_ctx = layer < DEPTH - 1
        mod = jax.nn.silu(c) @ ada_w[layer] + ada_b[layer]
        sh_m, sc_m, g_m, sh_f, sc_f, g_f = jnp.split(mod[:, None, :], 6, axis=-1)
        mod_c = jax.nn.silu(c_ctx) @ ada_w[layer] + ada_b[layer]
        shc_m, scc_m, gc_m, shc_f, scc_f, gc_f = jnp.split(mod_c, 6, axis=-1)

        h = modulate(rms_norm(x, norm_mix_pre[layer]), sh_m, sc_m)
        hc = modulate(rms_norm(xc, norm_mix_pre[layer]), shc_m, scc_m)
        y, yc = mixer(h, hc, tabs, w_in[layer], q_norm[layer], k_norm[layer],
                      ssm_lam_re[layer], ssm_lam_im[layer], ssm_log_dt[layer],
                      ssm_b_re[layer], ssm_b_im[layer], ssm_c_re[layer], ssm_c_im[layer],
                      ssm_d[layer], ssm_glu_w[layer], ssm_glu_b[layer], fourier_w[layer],
                      w_out[layer], need_ctx)
        x = x + g_m * rms_norm(y, norm_mix_post[layer])
        h = modulate(rms_norm(x, norm_ffn_pre[layer]), sh_f, sc_f)
        x = x + g_f * rms_norm(swiglu(h, ffn_w_gate[layer], ffn_w_up[layer], ffn_w_down[layer]),
                               norm_ffn_post[layer])
        if need_ctx:
            xc = xc + gc_m * rms_norm(yc, norm_mix_post[layer])
            hc = modulate(rms_norm(xc, norm_ffn_pre[layer]), shc_f, scc_f)
            xc = xc + gc_f * rms_norm(swiglu(hc, ffn_w_gate[layer], ffn_w_up[layer], ffn_w_down[layer]),
                                      norm_ffn_post[layer])
    return x
```

```cpp
#include <hip/hip_runtime.h>
#include <hip/hip_cooperative_groups.h>
#include <hip/hip_bf16.h>
#include <cstdio>
#include <cstdint>
#include <cmath>
namespace cg = cooperative_groups;
namespace pg8 {
#define PG8_LAS __attribute__((address_space(3)))
typedef unsigned short bf16_t;
typedef short bf16x8 __attribute__((ext_vector_type(8)));
typedef float f32x4 __attribute__((ext_vector_type(4)));
typedef unsigned u32x4 __attribute__((ext_vector_type(4)));
constexpr int BM = 256, BK = 64, HALF = 128, HTB = HALF * BK * 2  , STAGE_BYTES = 8 * HTB, NXCD = 8, WGM = 8;

__host__ __device__ __forceinline__ int lds_byte(int r, int c) { const int st = (r >> 4) * 2 + (c >> 5), rr = r & 15, cc = c & 31, ob = rr * 64 + cc * 2; return st * 1024 + (ob ^ (((ob >> 9) & 1) << 5)); }
__host__ __device__ __forceinline__ void stage_rc(int b, int& R, int& C) { const int st = b / 1024, sb = b % 1024, swz = sb ^ (((sb >> 9) & 1) << 5); R = (st >> 1) * 16 + swz / 64; C = (st & 1) * 32 + (swz % 64) / 2; }
__host__ __device__ __forceinline__ int perm32(int rho) { const int n = rho >> 4, i = rho & 15; return 8 * (i >> 2) + 4 * n + (i & 3); }

struct Unit { int pm, pn; };
struct Gemm { const bf16_t* A; const bf16_t* Bt; int M, N, K; };

struct StaticOrder {
    int nM, nN, nwg, G, c;
    __host__ __device__ void init(int M, int N, int G_, int c_) { nM = M / BM; nN = N / BM; nwg = nM * nN; G = G_; c = c_; }
    __host__ __device__ bool next(int i, Unit& u) const {
        const long L = (long)i * G + c; if (L >= nwg) return false;
        int wgid = (int)L; { const int q = nwg / NXCD, r = nwg % NXCD, xcd = wgid % NXCD, off = wgid / NXCD; wgid = (xcd < r ? xcd * (q + 1) : r * (q + 1) + (xcd - r) * q) + off; }
        const int nig = WGM * nN, gid = wgid / nig, fm = gid * WGM, gsz = (nM - fm) < WGM ? (nM - fm) : WGM;
        u.pm = fm + ((wgid % nig) % gsz); u.pn = (wgid % nig) / gsz; return true;
    }
    __device__ __forceinline__ void a_ready(const Unit&) const {}
    __device__ __forceinline__ void done(const Unit&) const {}
};

__device__ __forceinline__ unsigned cvt_pk_bf16(float lo, float hi) { unsigned r; asm volatile("v_cvt_pk_bf16_f32 %0, %1, %2" : "=v"(r) : "v"(lo), "v"(hi)); return r; }
typedef float f32x2 __attribute__((ext_vector_type(2)));
template <class Epi, class Sched, bool ALIGN_EPI = false, bool SP2 = false>
__device__ __forceinline__ void gemm_phase(PG8_LAS unsigned char* lds, const Gemm g, const Sched& S, const Epi& E) {
    int tid_ = threadIdx.x; asm volatile("" : "+v"(tid_)); const int tid = tid_, wid = __builtin_amdgcn_readfirstlane(tid >> 6), lane = tid & 63, wr = wid >> 2, wc = wid & 3, fr = lane & 15, fq = lane >> 4;
    const int K = g.K, nt = K / BK;
    unsigned voffA[2], voffB[2];
#pragma unroll
    for (int i = 0; i < 2; ++i) { int R, C; stage_rc(tid * 16 + i * 8192, R, C); const int Rb = Epi::PERM ? ((R & ~31) + perm32(R & 31)) : R;
        voffA[i] = (unsigned)(R * K + C) * 2u; voffB[i] = (unsigned)(Rb * K + C) * 2u; }
    const size_t kstep = (size_t)(BK * 2);
    const size_t hstep = (size_t)HALF * K * 2;
    const size_t tstep = 2 * hstep;
    const unsigned ldsw = (unsigned)wid * 1024u;
    const int aoff = lds_byte(wr * 64 + fr, fq * 8), boff = lds_byte(wc * 32 + fr, fq * 8);
#define PG8_SA(b, h) (((b) * 2 + (h)) * HTB)
#define PG8_SB(b, h) ((4 + (b) * 2 + (h)) * HTB)
#define PG8_STAGE(bufoff, gbase, voff) do { _Pragma("unroll") for (int _i = 0; _i < 2; ++_i) \
        __builtin_amdgcn_global_load_lds((const unsigned*)((const char*)(gbase) + (voff)[_i]), (PG8_LAS unsigned*)(lds + (bufoff) + ldsw + _i * 8192), 16, 0, 0); } while (0)
#define PG8_LDA(dst, b, h) do { _Pragma("unroll") for (int m = 0; m < 4; ++m) _Pragma("unroll") for (int k = 0; k < 2; ++k) dst[m][k] = *(const PG8_LAS bf16x8*)(lds + PG8_SA(b, h) + aoff + m * 2048 + k * 1024); } while (0)
#define PG8_LDB(dst, b, h) do { _Pragma("unroll") for (int n = 0; n < 2; ++n) _Pragma("unroll") for (int k = 0; k < 2; ++k) dst[n][k] = *(const PG8_LAS bf16x8*)(lds + PG8_SB(b, h) + boff + n * 2048 + k * 1024); } while (0)
#define PG8_MMA(ai, bj, At, Bt) do { __builtin_amdgcn_s_setprio(1); _Pragma("unroll") for (int m = 0; m < 4; ++m) _Pragma("unroll") for (int n = 0; n < 2; ++n) _Pragma("unroll") for (int k = 0; k < 2; ++k) \
        acc[ai][bj][m][n] = __builtin_amdgcn_mfma_f32_16x16x32_bf16(Bt[n][k], At[m][k], acc[ai][bj][m][n], 0, 0, 0); __builtin_amdgcn_s_setprio(0); } while (0)
#define PG8_WAIT_V(n) asm volatile("s_waitcnt vmcnt(" #n ")" ::: "memory")
#define PG8_WAIT_L(n) asm volatile("s_waitcnt lgkmcnt(" #n ")" ::: "memory")
#define PG8_BAR __builtin_amdgcn_s_barrier()
#define PG8_SCHED __builtin_amdgcn_sched_barrier(0)
    Unit cur, nxt; int ui = 0;
    if (!S.next(0, cur)) return;
    f32x4 acc[2][2][4][2];
#pragma unroll
    for (int a = 0; a < 2; ++a)
#pragma unroll
        for (int b = 0; b < 2; ++b)
#pragma unroll
            for (int m = 0; m < 4; ++m)
#pragma unroll
                for (int n = 0; n < 2; ++n) acc[a][b][m][n] = (f32x4){0.f, 0.f, 0.f, 0.f};
    bf16x8 At[4][2], B0[2][2], B1[2][2];
    const char* cA = (const char*)g.A + (size_t)cur.pm * tstep; const char* cB = (const char*)g.Bt + (size_t)cur.pn * tstep;
    S.a_ready(cur);
    if constexpr (SP2) {
        PG8_STAGE(PG8_SB(0, 0), cB, voffB); PG8_STAGE(PG8_SB(0, 1), cB + hstep, voffB); PG8_STAGE(PG8_SA(0, 0), cA, voffA); PG8_STAGE(PG8_SA(0, 1), cA + hstep, voffA);
        if (wr == 1) PG8_BAR;
        PG8_WAIT_V(2); PG8_BAR;
        PG8_STAGE(PG8_SB(1, 0), cB + kstep, voffB); PG8_STAGE(PG8_SA(1, 0), cA + kstep, voffA); PG8_STAGE(PG8_SB(1, 1), cB + hstep + kstep, voffB);
        PG8_WAIT_V(6); PG8_BAR;
    } else {
        PG8_STAGE(PG8_SB(0, 0), cB, voffB); PG8_STAGE(PG8_SA(0, 0), cA, voffA); PG8_STAGE(PG8_SB(0, 1), cB + hstep, voffB); PG8_STAGE(PG8_SA(0, 1), cA + hstep, voffA);
        if (wr == 1) PG8_BAR;
        PG8_WAIT_V(4); PG8_BAR;
        PG8_STAGE(PG8_SB(1, 0), cB + kstep, voffB); PG8_STAGE(PG8_SA(1, 0), cA + kstep, voffA); PG8_STAGE(PG8_SB(1, 1), cB + hstep + kstep, voffB);
        PG8_WAIT_V(6); PG8_BAR;
    }
    for (;;) {
        const bool has_next = S.next(ui + 1, nxt);
        const char* nA = has_next ? (const char*)g.A + (size_t)nxt.pm * tstep : cA; const char* nB = has_next ? (const char*)g.Bt + (size_t)nxt.pn * tstep : cB;
        for (int t = 0; t < nt; t += 2) {
            const bool last = (t == nt - 2);
            const char* a1 = cA + (size_t)(t + 1) * kstep;
            const char* a2 = last ? nA : cA + (size_t)(t + 2) * kstep; const char* b2 = last ? nB : cB + (size_t)(t + 2) * kstep;
            const char* a3 = a2 + kstep; const char* b3 = b2 + kstep;
            if (last && has_next) S.a_ready(nxt);
            if constexpr (SP2) {
            PG8_LDB(B0, 0, 0); PG8_LDB(B1, 0, 1); PG8_SCHED; PG8_LDA(At, 0, 0); PG8_STAGE(PG8_SA(1, 1), a1 + hstep, voffA);
            PG8_WAIT_V(8); PG8_WAIT_L(0); PG8_BAR; PG8_MMA(0, 0, At, B0); PG8_MMA(0, 1, At, B1); PG8_BAR; PG8_SCHED;
            PG8_LDA(At, 0, 1); PG8_STAGE(PG8_SB(0, 0), b2, voffB); PG8_STAGE(PG8_SB(0, 1), b2 + hstep, voffB); PG8_STAGE(PG8_SA(0, 0), a2, voffA);
            PG8_WAIT_V(8); PG8_WAIT_L(0); PG8_BAR; PG8_MMA(1, 0, At, B0); PG8_MMA(1, 1, At, B1); PG8_BAR; PG8_SCHED;
            PG8_LDB(B0, 1, 0); PG8_LDB(B1, 1, 1); PG8_SCHED; PG8_LDA(At, 1, 0); PG8_STAGE(PG8_SA(0, 1), a2 + hstep, voffA);
            PG8_WAIT_V(8); PG8_WAIT_L(0); PG8_BAR; PG8_MMA(0, 0, At, B0); PG8_MMA(0, 1, At, B1); PG8_BAR; PG8_SCHED;
            PG8_LDA(At, 1, 1); PG8_STAGE(PG8_SB(1, 0), b3, voffB); PG8_STAGE(PG8_SB(1, 1), b3 + hstep, voffB); PG8_STAGE(PG8_SA(1, 0), a3, voffA);
            PG8_WAIT_V(8); PG8_WAIT_L(0); PG8_BAR; PG8_MMA(1, 0, At, B0); PG8_MMA(1, 1, At, B1); PG8_BAR; PG8_SCHED;
            } else {
            PG8_LDB(B0, 0, 0); PG8_SCHED; PG8_LDA(At, 0, 0); PG8_STAGE(PG8_SA(1, 1), a1 + hstep, voffA);
            PG8_WAIT_L(8); PG8_BAR; PG8_WAIT_L(0); PG8_MMA(0, 0, At, B0); PG8_BAR; PG8_SCHED;
            PG8_LDB(B1, 0, 1); PG8_STAGE(PG8_SB(0, 0), b2, voffB);
            PG8_BAR; PG8_WAIT_L(0); PG8_MMA(0, 1, At, B1); PG8_BAR;
            PG8_LDA(At, 0, 1); PG8_STAGE(PG8_SA(0, 0), a2, voffA);
            PG8_BAR; PG8_WAIT_L(0); PG8_MMA(1, 0, At, B0); PG8_BAR; PG8_SCHED;
            PG8_STAGE(PG8_SB(0, 1), b2 + hstep, voffB);
            PG8_WAIT_V(6); PG8_BAR; PG8_MMA(1, 1, At, B1); PG8_BAR;
            PG8_LDB(B0, 1, 0); PG8_SCHED; PG8_LDA(At, 1, 0); PG8_STAGE(PG8_SA(0, 1), a2 + hstep, voffA);
            PG8_WAIT_L(8); PG8_BAR; PG8_WAIT_L(0); PG8_MMA(0, 0, At, B0); PG8_BAR; PG8_SCHED;
            PG8_LDB(B1, 1, 1); PG8_STAGE(PG8_SB(1, 0), b3, voffB);
            PG8_BAR; PG8_WAIT_L(0); PG8_MMA(0, 1, At, B1); PG8_BAR;
            PG8_LDA(At, 1, 1); PG8_STAGE(PG8_SA(1, 0), a3, voffA);
            PG8_BAR; PG8_WAIT_L(0); PG8_MMA(1, 0, At, B0); PG8_BAR; PG8_SCHED;
            PG8_STAGE(PG8_SB(1, 1), b3 + hstep, voffB);
            PG8_WAIT_V(6); PG8_BAR; PG8_MMA(1, 1, At, B1); PG8_BAR;
            }
        }
        if constexpr (ALIGN_EPI) { if (wr == 0) PG8_BAR; }
        if constexpr (!Epi::AFTER_DRAIN) { E(acc, cur, wr, wc, fr, fq); S.done(cur); }
        if (!has_next) break;
#pragma unroll
        for (int a = 0; a < 2; ++a)
#pragma unroll
            for (int b = 0; b < 2; ++b)
#pragma unroll
                for (int m = 0; m < 4; ++m)
#pragma unroll
                    for (int n = 0; n < 2; ++n) acc[a][b][m][n] = (f32x4){0.f, 0.f, 0.f, 0.f};
        cur = nxt; cA = nA; cB = nB; ++ui;
        if constexpr (ALIGN_EPI) { if (wr == 1) PG8_BAR; }
    }
    PG8_WAIT_V(0);
    if constexpr (!ALIGN_EPI) { if (wr == 0) PG8_BAR; }
    PG8_BAR;
    if constexpr (Epi::AFTER_DRAIN) { E.fused(acc, cur, wr, wc, fr, fq, lds, wid, lane); S.done(cur); }
#undef PG8_SA
#undef PG8_SB
#undef PG8_STAGE
#undef PG8_LDA
#undef PG8_LDB
#undef PG8_MMA
#undef PG8_WAIT_V
#undef PG8_WAIT_L
#undef PG8_BAR
#undef PG8_SCHED
}
}
namespace att {
using bf16 = __hip_bfloat16;
constexpr int   D = 128, NW = 8, QBLK = 32, KVBLK = 64;
constexpr float SCALE = 0.088388347648318440f;
constexpr float THR = 8.f;
constexpr int SDEPTH = 2;
constexpr int LDQ = 1024, LDK = 256, LDO = 2048;
constexpr size_t SHM_V = KVBLK * D * 2, SHM_K = KVBLK * D * 2, SHM_ATTN = 2 * SHM_V + 2 * SHM_K + NW * 64 * 4;
using bf16x8 = __attribute__((ext_vector_type(8))) short;
using s16x4  = __attribute__((ext_vector_type(4))) short;
using f32x16 = __attribute__((ext_vector_type(16))) float;
using f32x8  = __attribute__((ext_vector_type(8))) float;
using u32x4  = __attribute__((ext_vector_type(4))) unsigned;
#define KSWZ(row, colB) ((row) * 256 + ((colB) ^ (((row) & 7) << 4)))
#define SBAR() __builtin_amdgcn_sched_barrier(0)
__device__ __forceinline__ int crow(int r, int hi) { return (r & 3) + 8 * (r >> 2) + 4 * hi; }
__device__ __forceinline__ unsigned cvtpk(float lo, float hi) {
  unsigned r; asm volatile("v_cvt_pk_bf16_f32 %0, %1, %2" : "=v"(r) : "v"(lo), "v"(hi)); return r;
}
template <typename TIn> struct Stage;
template <> struct Stage<bf16>  { using T = bf16x8;
  __device__ static __forceinline__ T ld8(const bf16* p) { return *reinterpret_cast<const bf16x8*>(p); }
  __device__ static __forceinline__ bf16x8 tobf(T x) { return x; } };
template <> struct Stage<float> { using T = f32x8;
  __device__ static __forceinline__ T ld8(const float* p) { return *reinterpret_cast<const f32x8*>(p); }
  __device__ static __forceinline__ bf16x8 tobf(T x) {
    u32x4 w = {cvtpk(x[0], x[1]), cvtpk(x[2], x[3]), cvtpk(x[4], x[5]), cvtpk(x[6], x[7])}; return *reinterpret_cast<bf16x8*>(&w); } };

__device__ __forceinline__ void partialSM(f32x16& p0, f32x16& p1, float& m_reg, float& mn, float& alpha) {
  constexpr float C = SCALE * 1.4426950408889634f;
  float pmax = p0[0]; for (int r = 1; r < 16; ++r) pmax = fmaxf(pmax, p0[r]); for (int r = 0; r < 16; ++r) pmax = fmaxf(pmax, p1[r]);
  { auto rr = __builtin_amdgcn_permlane32_swap(__float_as_uint(pmax), __float_as_uint(pmax), false, false);
    pmax = fmaxf(__uint_as_float(rr[0]), __uint_as_float(rr[1])); }
  if (__builtin_expect(__all(pmax - m_reg <= THR / SCALE), 1)) { mn = m_reg; alpha = 1.f; }
  else { mn = fmaxf(m_reg, pmax); alpha = __builtin_amdgcn_exp2f((m_reg - mn) * C); m_reg = mn; }
  float mnC = -mn * C;
  for (int r = 0; r < 16; ++r) p0[r] = fmaf(p0[r], C, mnC); for (int r = 0; r < 16; ++r) p1[r] = fmaf(p1[r], C, mnC);
  for (int r = 0; r < 16; ++r) p0[r] = __builtin_amdgcn_exp2f(p0[r]);
}
__device__ __forceinline__ void finishSM(f32x16& p0, f32x16& p1, float alpha, float& l_reg, bf16x8& pa0, bf16x8& pa1, bf16x8& pa2, bf16x8& pa3) {
  for (int r = 0; r < 16; ++r) p1[r] = __builtin_amdgcn_exp2f(p1[r]);
  float ps = 0; for (int r = 0; r < 16; ++r) ps += p0[r]; for (int r = 0; r < 16; ++r) ps += p1[r];
  { auto rr = __builtin_amdgcn_permlane32_swap(__float_as_uint(ps), __float_as_uint(ps), false, false);
    ps = __uint_as_float(rr[0]) + __uint_as_float(rr[1]); }
  l_reg = l_reg * alpha + ps;
#define PK4(P, BASE, OUT) do { unsigned a0 = cvtpk(P[BASE + 0], P[BASE + 1]), a1 = cvtpk(P[BASE + 2], P[BASE + 3]);   \
    unsigned b0 = cvtpk(P[BASE + 4], P[BASE + 5]), b1 = cvtpk(P[BASE + 6], P[BASE + 7]);                              \
    auto r0 = __builtin_amdgcn_permlane32_swap(a0, b0, false, false); auto r1 = __builtin_amdgcn_permlane32_swap(a1, b1, false, false); \
    u32x4 w = {r0[0], r1[0], r0[1], r1[1]}; OUT = *reinterpret_cast<bf16x8*>(&w); } while (0)
  PK4(p0, 0, pa0); PK4(p0, 8, pa1); PK4(p1, 0, pa2); PK4(p1, 8, pa3);
#undef PK4
}
__device__ __forceinline__ void qkt(f32x16& p0, f32x16& p1, const bf16* Ks, const bf16x8* qr, int r32, int hi) {
  p0 = f32x16{}; p1 = f32x16{};
  for (int d0 = 0; d0 < 8; ++d0) { int cb = (d0 * 16 + hi * 8) * 2;
    bf16x8 b0 = *reinterpret_cast<const bf16x8*>((const char*)Ks + KSWZ(r32, cb));
    bf16x8 b1 = *reinterpret_cast<const bf16x8*>((const char*)Ks + KSWZ(32 + r32, cb));
    p0 = __builtin_amdgcn_mfma_f32_32x32x16_bf16(b0, qr[d0], p0, 0, 0, 0);
    p1 = __builtin_amdgcn_mfma_f32_32x32x16_bf16(b1, qr[d0], p1, 0, 0, 0); }
}
__device__ __forceinline__ int v_st(int k, int c) { const int kk = (k & ~0xC) | ((k & 4) << 1) | ((k & 8) >> 1); return ((kk >> 3) * 4 + (c >> 5)) * 512 + ((kk & 7) * 32 + (c & 31)) * 2; }
__device__ __forceinline__ int v_rd_base(int lane) { return ((lane & 3) << 3) | (((lane >> 2) & 3) << 6) | (((lane >> 4) & 1) << 5) | (((lane >> 5) & 1) << 8); }
constexpr int v_rd_off(int d0, int ks, int half) { return d0 * 512 + ks * 4096 + half * 2048; }
template <int OFF> __device__ __forceinline__ s16x4 tr_read(int vb) {
  s16x4 r; asm volatile("ds_read_b64_tr_b16 %0, %1 offset:%2" : "=&v"(r) : "v"(vb), "i"(OFF) : "memory"); return r;
}
template <int D0> __device__ __forceinline__ void pv_one(f32x16& od, int vb, bf16x8 pa0, bf16x8 pa1, bf16x8 pa2, bf16x8 pa3) {
  const s16x4 l0 = tr_read<v_rd_off(D0, 0, 0)>(vb), h0 = tr_read<v_rd_off(D0, 0, 1)>(vb), l1 = tr_read<v_rd_off(D0, 1, 0)>(vb), h1 = tr_read<v_rd_off(D0, 1, 1)>(vb);
  const s16x4 l2 = tr_read<v_rd_off(D0, 2, 0)>(vb), h2 = tr_read<v_rd_off(D0, 2, 1)>(vb), l3 = tr_read<v_rd_off(D0, 3, 0)>(vb), h3 = tr_read<v_rd_off(D0, 3, 1)>(vb);
  asm volatile("s_waitcnt lgkmcnt(0)" ::: "memory"); SBAR();
#define PK(L, H) (bf16x8){L[0], L[1], L[2], L[3], H[0], H[1], H[2], H[3]}
  od = __builtin_amdgcn_mfma_f32_32x32x16_bf16(pa0, PK(l0, h0), od, 0, 0, 0);
  od = __builtin_amdgcn_mfma_f32_32x32x16_bf16(pa1, PK(l1, h1), od, 0, 0, 0);
  od = __builtin_amdgcn_mfma_f32_32x32x16_bf16(pa2, PK(l2, h2), od, 0, 0, 0);
  od = __builtin_amdgcn_mfma_f32_32x32x16_bf16(pa3, PK(l3, h3), od, 0, 0, 0);
#undef PK
}
__device__ __forceinline__ void pv_d0(f32x16* o, int vb, bf16x8 pa0, bf16x8 pa1, bf16x8 pa2, bf16x8 pa3) {
  pv_one<0>(o[0], vb, pa0, pa1, pa2, pa3); pv_one<1>(o[1], vb, pa0, pa1, pa2, pa3); pv_one<2>(o[2], vb, pa0, pa1, pa2, pa3); pv_one<3>(o[3], vb, pa0, pa1, pa2, pa3);
}
template <typename TQ>
__device__ __forceinline__ void attn_dense_body(const TQ* Qb, const bf16* Kh, const bf16* Vh,
                                                bf16* Ob, int seq, char* lds) {
  using St = Stage<bf16>; using SQ = Stage<TQ>;
  int tid_ = threadIdx.x; asm volatile("" : "+v"(tid_)); const int tid = tid_, wid = tid >> 6, lane = tid & 63, r32 = lane & 31, hi = lane >> 5;
  bf16* V_lds = (bf16*)lds; bf16* K_lds = (bf16*)(lds + 2 * SHM_V);
  float* ws = (float*)(lds + 2 * SHM_V + 2 * SHM_K) + wid * 64; float* li_l = ws; float* al_l = ws + 32;
  float m_reg = -1e30f, l_reg = 0; f32x16 o[4] = {}; bf16x8 qr[8];
  const TQ* Qw = Qb + (long)(wid * QBLK + r32) * LDQ + hi * 8;
#pragma unroll
  for (int d0 = 0; d0 < 8; ++d0) qr[d0] = SQ::tobf(SQ::ld8(Qw + d0 * 16));
  const int sr = tid >> 4, sc = (tid & 15) * 8, vst0 = v_st(sr, sc), vst1 = v_st(32 + sr, sc);
  const int vb0 = (int)(uintptr_t)V_lds + v_rd_base(lane);
  struct { typename St::T vs0, vs1, ks0, ks1; } sr_[SDEPTH];
#define SLOAD(i, k0) do { sr_[i].vs0 = St::ld8(&Vh[(long)((k0) + sr) * LDK + sc]); sr_[i].vs1 = St::ld8(&Vh[(long)((k0) + 32 + sr) * LDK + sc]); \
    sr_[i].ks0 = St::ld8(&Kh[(long)((k0) + sr) * LDK + sc]); sr_[i].ks1 = St::ld8(&Kh[(long)((k0) + 32 + sr) * LDK + sc]); } while (0)
#define SWRITE(b, i) do { *(bf16x8*)((char*)V_lds + (b) * SHM_V + vst0) = St::tobf(sr_[i].vs0);          \
    *(bf16x8*)((char*)V_lds + (b) * SHM_V + vst1) = St::tobf(sr_[i].vs1); int kc = sc * 2;               \
    *(bf16x8*)((char*)K_lds + (b) * SHM_K + KSWZ(sr, kc)) = St::tobf(sr_[i].ks0);                       \
    *(bf16x8*)((char*)K_lds + (b) * SHM_K + KSWZ(32 + sr, kc)) = St::tobf(sr_[i].ks1); } while (0)
#define SWAIT() do { if constexpr (SDEPTH == 2) asm volatile("s_waitcnt vmcnt(4)" ::: "memory"); else asm volatile("s_waitcnt vmcnt(0)" ::: "memory"); } while (0)
#define RESC(a) do { if (__any((a) < 1.f)) { if (hi == 0) al_l[r32] = (a); asm volatile("s_waitcnt lgkmcnt(0)" ::: "memory"); \
    for (int d = 0; d < 4; ++d) for (int r = 0; r < 16; ++r) o[d][r] *= al_l[crow(r, hi)]; } } while (0)
  f32x16 pA0, pA1, pB0, pB1; float mnA, mnB, alA, alB; bf16x8 pa0, pa1, pa2, pa3; const int NT = seq / KVBLK;
  constexpr int SE = 0, SO = SDEPTH - 1;
  SLOAD(SE, 0); asm volatile("s_waitcnt vmcnt(0)" ::: "memory"); SWRITE(0, SE); __syncthreads();
  qkt(pA0, pA1, K_lds, qr, r32, hi); partialSM(pA0, pA1, m_reg, mnA, alA);
  SLOAD(SO, KVBLK); if constexpr (SDEPTH == 2) { if (2 < NT) SLOAD(SE, 2 * KVBLK); }
  SWAIT(); SWRITE(1, SO); __syncthreads();
  for (int j = 1; j + 1 < NT; j += 2) {
    SBAR(); qkt(pB0, pB1, (bf16*)((char*)K_lds + SHM_K), qr, r32, hi);
    finishSM(pA0, pA1, alA, l_reg, pa0, pa1, pa2, pa3); SBAR();
    SLOAD(SO, (j + SDEPTH) * KVBLK); SBAR();
    pv_d0(o, vb0, pa0, pa1, pa2, pa3); partialSM(pB0, pB1, m_reg, mnB, alB);
    __syncthreads(); SWAIT(); SWRITE(0, SE);
    RESC(alB); __syncthreads();
    SBAR(); qkt(pA0, pA1, K_lds, qr, r32, hi);
    finishSM(pB0, pB1, alB, l_reg, pa0, pa1, pa2, pa3); SBAR();
    if (SDEPTH == 1 || j + 3 < NT) SLOAD(SE, (j + 1 + SDEPTH) * KVBLK); SBAR();
    pv_d0(o, vb0 + (int)SHM_V, pa0, pa1, pa2, pa3); partialSM(pA0, pA1, m_reg, mnA, alA);
    __syncthreads(); SWAIT(); SWRITE(1, SO);
    RESC(alA); __syncthreads();
  }
  SBAR(); qkt(pB0, pB1, (bf16*)((char*)K_lds + SHM_K), qr, r32, hi);
  finishSM(pA0, pA1, alA, l_reg, pa0, pa1, pa2, pa3); SBAR();
  pv_d0(o, vb0, pa0, pa1, pa2, pa3); partialSM(pB0, pB1, m_reg, mnB, alB);
  __syncthreads(); RESC(alB);
  finishSM(pB0, pB1, alB, l_reg, pa0, pa1, pa2, pa3); SBAR();
  pv_d0(o, vb0 + (int)SHM_V, pa0, pa1, pa2, pa3);
  if (hi == 0) li_l[r32] = l_reg; asm volatile("s_waitcnt lgkmcnt(0)" ::: "memory");
  float rli[16];
#pragma unroll
  for (int r = 0; r < 16; ++r) rli[r] = __builtin_amdgcn_rcpf(li_l[crow(r, hi)]);
  bf16* Ow = Ob + (long)(wid * QBLK) * LDO;
#pragma unroll
  for (int r = 0; r < 16; ++r) { int orow = crow(r, hi);
    for (int d0 = 0; d0 < 4; ++d0) Ow[(long)orow * LDO + d0 * 32 + r32] = __float2bfloat16(o[d0][r] * rli[r]); }
#undef SLOAD
#undef SWRITE
#undef SWAIT
#undef RESC
}
}

#define LAS __attribute__((address_space(3)))
typedef unsigned short bf16_t;
typedef float f32x4 __attribute__((ext_vector_type(4)));
typedef float f32x2 __attribute__((ext_vector_type(2)));
typedef unsigned u32x4 __attribute__((ext_vector_type(4)));
typedef unsigned u32x2 __attribute__((ext_vector_type(2)));
typedef short bf16x8 __attribute__((ext_vector_type(8)));

constexpr int L = 16384, NCTX = 256, MT = L + NCTX, DM = 2048, INW = 2560, FF = 5632, NCH = 260;
constexpr float EPS = 1e-6f;

constexpr size_t al256(size_t x) { return (x + 255) / 256 * 256; }
constexpr size_t SZ_WIN = (size_t)INW * DM * 2, SZ_WOUT = (size_t)DM * DM * 2, SZ_WGU = (size_t)2 * FF * DM * 2, SZ_WDN = (size_t)DM * FF * 2,
                 SZ_WGLU = 512 * 512 * 2, SZ_WF = 512 * 1024 * 2;
constexpr size_t O_WIN = 0;
constexpr size_t O_WOUT = O_WIN + 2 * SZ_WIN;
constexpr size_t O_WGU = O_WOUT + 2 * SZ_WOUT;
constexpr size_t O_WDN = O_WGU + 2 * SZ_WGU;
constexpr size_t O_WGLU = O_WDN + 2 * SZ_WDN;
constexpr size_t O_WF = O_WGLU + 2 * SZ_WGLU;
constexpr size_t O_MODP = O_WF + 2 * SZ_WF;
constexpr size_t O_MOD = O_MODP + (size_t)16 * 4 * 12288 * 4;
constexpr size_t O_ROPE = O_MOD + (size_t)4 * 12288 * 4;
constexpr size_t O_AB = O_ROPE + 65536;
constexpr size_t O_BB = O_AB + 8192 * 16;
constexpr size_t O_CB = O_BB + (size_t)8192 * 16 * 8;
constexpr size_t O_W1 = O_CB + (size_t)128 * 16 * 128 * 2;
constexpr size_t O_W2 = O_W1 + 65536;
constexpr size_t O_WC = O_W2 + 131072;
constexpr size_t O_TW = O_WC + 262144;
constexpr size_t O_XC = O_TW + 131072;
constexpr size_t SZ_S = (size_t)2 * NCH * 32 * 128 * 4;
constexpr size_t O_S = O_XC + (size_t)NCTX * DM * 4;
constexpr size_t O_HIN = O_S + SZ_S;
constexpr size_t O_H = al256(O_HIN + SZ_S);
constexpr size_t O_Y = O_H + (size_t)MT * DM * 2;
constexpr size_t O_OV = O_Y + (size_t)MT * DM * 4;
constexpr size_t O_QRAW = O_OV;
constexpr size_t O_KRAW = O_QRAW + (size_t)MT * 1024 * 4;
constexpr size_t O_QB = O_KRAW + (size_t)MT * 256 * 4;
constexpr size_t O_KB = O_QB + (size_t)MT * 1024 * 2;
constexpr size_t O_VB = O_KB + (size_t)MT * 256 * 2;
constexpr size_t O_US = O_VB + (size_t)MT * 256 * 2;
constexpr size_t O_UF = O_US + (size_t)MT * 512 * 4;
constexpr size_t O_TB = O_UF + (size_t)MT * 512 * 2;
constexpr size_t O_XF = O_TB + (size_t)2 * 128 * 128 * 512 * 2;
constexpr size_t O_G = O_XF + (size_t)MT * 1024 * 2;
constexpr size_t O_CAT = O_G + (size_t)MT * 512 * 2;
constexpr size_t O_OVEND = O_CAT + (size_t)MT * DM * 2;
constexpr size_t O_HID = O_OV;
constexpr size_t WS_END = (O_OVEND > O_HID + (size_t)MT * FF * 2) ? O_OVEND : O_HID + (size_t)MT * FF * 2;
static_assert(WS_END <= (size_t)768 * 1024 * 1024, "d_ws map exceeds 768 MiB");

constexpr int LDS_BYTES = 147456;

struct Params { const float* in[28]; float* out; unsigned char* ws; };

__device__ __forceinline__ unsigned pk2(float lo, float hi) { typedef __bf16 bf2_t __attribute__((ext_vector_type(2))); f32x2 v = {lo, hi}; bf2_t b = __builtin_convertvector(v, bf2_t); return __builtin_bit_cast(unsigned, b); }
__device__ __forceinline__ bf16_t f2bf(float f) { return (bf16_t)(pk2(f, 0.f) & 0xffffu); }
__device__ __forceinline__ float bf2f(unsigned b) { return __uint_as_float(b << 16); }
__device__ __forceinline__ float wave_sum(float v) {
#pragma unroll
    for (int o = 1; o < 64; o <<= 1) v += __shfl_xor(v, o);
    return v;
}
__device__ __forceinline__ float sigmoidf_(float x) { return 1.0f / (1.0f + __expf(-x)); }
__device__ __forceinline__ float gelu_tanh(float x) { const float u = 0.7978845608028654f * (x + 0.044715f * x * x * x); return x * sigmoidf_(2.f * u); }
#define LDS_WAIT() asm volatile("s_waitcnt lgkmcnt(0)" ::: "memory")

struct EpiIn {
    static constexpr bool PERM = true, AFTER_DRAIN = false;
    float* qraw; float* kraw; bf16_t* vb; float* us; bf16_t* uf;
    __device__ __forceinline__ void operator()(const pg8::f32x4 (&acc)[2][2][4][2], const pg8::Unit& u, int wr, int wc, int fr, int fq) const {
        const int row0 = u.pm * 256 + wr * 64 + fr, cl = wc * 32 + 8 * fq, pn = u.pn;
        float* fbase = nullptr; bf16_t* bbase = nullptr; int ldc = 0;
        if (pn < 4) { fbase = qraw + pn * 256; ldc = 1024; } else if (pn == 4) { fbase = kraw; ldc = 256; } else if (pn == 5) { bbase = vb; ldc = 256; }
        else if (pn < 8) { fbase = us + (pn - 6) * 256; ldc = 512; } else { bbase = uf + (pn - 8) * 256; ldc = 512; }
#pragma unroll
        for (int ai = 0; ai < 2; ++ai)
#pragma unroll
            for (int m = 0; m < 4; ++m) { const size_t ro = (size_t)(row0 + ai * 128 + m * 16) * ldc + cl;
#pragma unroll
                for (int bj = 0; bj < 2; ++bj) { const pg8::f32x4 v0 = acc[ai][bj][m][0], v1 = acc[ai][bj][m][1];
                    if (fbase) { float* p = fbase + ro + bj * 128; *(f32x4*)p = (f32x4){v0[0], v0[1], v0[2], v0[3]}; *(f32x4*)(p + 4) = (f32x4){v1[0], v1[1], v1[2], v1[3]}; }
                    else { u32x4 w; w.x = pk2(v0[0], v0[1]); w.y = pk2(v0[2], v0[3]); w.z = pk2(v1[0], v1[1]); w.w = pk2(v1[2], v1[3]); *(u32x4*)(bbase + ro + bj * 128) = w; } } }
    }
};
struct EpiF32 {
    static constexpr bool PERM = true, AFTER_DRAIN = false;
    float* O; int ldc;
    __device__ __forceinline__ void operator()(const pg8::f32x4 (&acc)[2][2][4][2], const pg8::Unit& u, int wr, int wc, int fr, int fq) const {
        const int row0 = u.pm * 256 + wr * 64 + fr, col0 = u.pn * 256 + wc * 32 + 8 * fq;
#pragma unroll
        for (int ai = 0; ai < 2; ++ai)
#pragma unroll
            for (int m = 0; m < 4; ++m) { float* rowp = O + (size_t)(row0 + ai * 128 + m * 16) * ldc + col0;
#pragma unroll
                for (int bj = 0; bj < 2; ++bj) { const pg8::f32x4 v0 = acc[ai][bj][m][0], v1 = acc[ai][bj][m][1];
                    *(f32x4*)(rowp + bj * 128) = (f32x4){v0[0], v0[1], v0[2], v0[3]}; *(f32x4*)(rowp + bj * 128 + 4) = (f32x4){v1[0], v1[1], v1[2], v1[3]}; } }
    }
};
struct EpiUp {
    static constexpr bool PERM = true, AFTER_DRAIN = false;
    bf16_t* hid;
    __device__ __forceinline__ void operator()(const pg8::f32x4 (&acc)[2][2][4][2], const pg8::Unit& u, int wr, int wc, int fr, int fq) const {
        const int row0 = u.pm * 256 + wr * 64 + fr, col0 = u.pn * 128 + wc * 32 + 8 * fq;
#pragma unroll
        for (int ai = 0; ai < 2; ++ai)
#pragma unroll
            for (int m = 0; m < 4; ++m) { bf16_t* rowp = hid + (size_t)(row0 + ai * 128 + m * 16) * FF + col0;
                float o[8];
#pragma unroll
                for (int n = 0; n < 2; ++n)
#pragma unroll
                    for (int e = 0; e < 4; ++e) { const float g = acc[ai][0][m][n][e], up = acc[ai][1][m][n][e]; o[4 * n + e] = g * sigmoidf_(g) * up; }
                u32x4 w; w.x = pk2(o[0], o[1]); w.y = pk2(o[2], o[3]); w.z = pk2(o[4], o[5]); w.w = pk2(o[6], o[7]); *(u32x4*)rowp = w; }
    }
};
struct EpiMix {
    static constexpr bool PERM = true, AFTER_DRAIN = false;
    bf16_t* cat; const bf16_t* gbuf; const float* bias; int mode;
    __device__ __forceinline__ void operator()(const pg8::f32x4 (&acc)[2][2][4][2], const pg8::Unit& u, int wr, int wc, int fr, int fq) const {
        const int row0 = u.pm * 256 + wr * 64 + fr, col0 = u.pn * 256 + wc * 32 + 8 * fq;
#pragma unroll
        for (int ai = 0; ai < 2; ++ai)
#pragma unroll
            for (int m = 0; m < 4; ++m) { const size_t row = (size_t)(row0 + ai * 128 + m * 16);
#pragma unroll
                for (int bj = 0; bj < 2; ++bj) { const int col = col0 + bj * 128; float o[8];
#pragma unroll
                    for (int n = 0; n < 2; ++n)
#pragma unroll
                        for (int e = 0; e < 4; ++e) o[4 * n + e] = acc[ai][bj][m][n][e];
                    if (mode == 0) { const u32x4 gv = *(const u32x4*)(gbuf + row * 512 + col); const f32x4 b0 = *(const f32x4*)(bias + col), b1 = *(const f32x4*)(bias + col + 4);
                        const unsigned gw_[4] = {gv.x, gv.y, gv.z, gv.w};
#pragma unroll
                        for (int q = 0; q < 4; ++q) { const float g0 = bf2f(gw_[q] & 0xffffu), g1 = bf2f(gw_[q] >> 16);
                            const float z0 = o[2 * q] + (q < 2 ? b0[2 * q] : b1[2 * q - 4]), z1 = o[2 * q + 1] + (q < 2 ? b0[2 * q + 1] : b1[2 * q - 3]);
                            o[2 * q] = g0 * sigmoidf_(z0); o[2 * q + 1] = g1 * sigmoidf_(z1); } }
                    u32x4 w; w.x = pk2(o[0], o[1]); w.y = pk2(o[2], o[3]); w.z = pk2(o[4], o[5]); w.w = pk2(o[6], o[7]);
                    *(u32x4*)(cat + row * 2048 + (mode == 0 ? 1024 : 1536) + col) = w; } }
    }
};

__device__ __forceinline__ void tr_item(const float* W, int K, int N, bf16_t* WT, int mode, LAS float* scr, int item, int lane) {
    const int nblk = N / 32, kb = item / nblk, nb = item % nblk, k0 = 64 * kb, n0 = 32 * nb;
    const int drow0 = (mode == 0) ? n0 : ((n0 >> 7) * 256 + (mode == 2 ? 128 : 0) + (n0 & 127));
#pragma unroll 8
    for (int i = 0; i < 32; ++i) { const int kk = 2 * i + (lane >> 5); scr[kk * 33 + (lane & 31)] = W[(size_t)(k0 + kk) * N + n0 + (lane & 31)]; }
    LDS_WAIT(); asm volatile("" ::: "memory");
    const int c = lane & 7;
#pragma unroll
    for (int j = 0; j < 4; ++j) { const int n = (lane >> 3) + 8 * j; const LAS float* s = scr + (8 * c) * 33 + n;
        u32x4 o; o.x = pk2(s[0 * 33], s[1 * 33]); o.y = pk2(s[2 * 33], s[3 * 33]); o.z = pk2(s[4 * 33], s[5 * 33]); o.w = pk2(s[6 * 33], s[7 * 33]);
        *(u32x4*)(WT + (size_t)(drow0 + n) * K + k0 + 8 * c) = o; }
    LDS_WAIT(); asm volatile("" ::: "memory");
}

__device__ __forceinline__ void prenorm_rows(const float* xl, const float* xc, bf16_t* H, const float* g, const float* modl, const float* modc, int sh_off, int sc_off,
                                             int nrows, int gw, int NGW, int lane) {
    for (int row = gw; row < nrows; row += NGW) {
        const float* src = row < L ? xl + (size_t)row * DM : xc + (size_t)(row - L) * DM;
        const float* md = row < L ? modl : modc;
        f32x4 v[8]; float ss = 0.f;
#pragma unroll
        for (int j = 0; j < 8; ++j) { v[j] = *(const f32x4*)(src + 4 * lane + 256 * j); ss += (v[j].x * v[j].x + v[j].y * v[j].y) + (v[j].z * v[j].z + v[j].w * v[j].w); }
        const float rstd = rsqrtf(wave_sum(ss) * (1.f / DM) + EPS);
#pragma unroll
        for (int j = 0; j < 8; ++j) { const int col = 4 * lane + 256 * j;
            const f32x4 g4 = *(const f32x4*)(g + col), s4 = *(const f32x4*)(md + sc_off + col), h4 = *(const f32x4*)(md + sh_off + col);
            const f32x4 o = v[j] * rstd * g4 * (1.f + s4) + h4;
            u32x2 w; w.x = pk2(o.x, o.y); w.y = pk2(o.z, o.w); *(u32x2*)(H + (size_t)row * DM + col) = w; }
    }
}
__device__ __forceinline__ void post_rows(const float* xl_src, const float* xc_src, float* xl_dst, float* xc_dst, const float* Y, const float* wpost, const float* modl, const float* modc, int gate_off,
                                          bool do_next, bf16_t* H, const float* wpre, const float* nmodl, const float* nmodc, int sh_off, int sc_off,
                                          int nrows, int gw, int NGW, int lane) {
    for (int row = gw; row < nrows; row += NGW) {
        const bool lat = row < L;
        const float* src = lat ? xl_src + (size_t)row * DM : xc_src + (size_t)(row - L) * DM;
        float* dst = lat ? xl_dst + (size_t)row * DM : xc_dst + (size_t)(row - L) * DM;
        const float* md = lat ? modl : modc;
        const float* yr = Y + (size_t)row * DM;
        f32x4 x[8], y[8]; float ss = 0.f;
#pragma unroll
        for (int j = 0; j < 8; ++j) { y[j] = *(const f32x4*)(yr + 4 * lane + 256 * j); x[j] = *(const f32x4*)(src + 4 * lane + 256 * j);
            ss += (y[j].x * y[j].x + y[j].y * y[j].y) + (y[j].z * y[j].z + y[j].w * y[j].w); }
        const float rstd = rsqrtf(wave_sum(ss) * (1.f / DM) + EPS);
        float s2 = 0.f;
#pragma unroll
        for (int j = 0; j < 8; ++j) { const int col = 4 * lane + 256 * j;
            const f32x4 w4 = *(const f32x4*)(wpost + col), g4 = *(const f32x4*)(md + gate_off + col);
            x[j] = x[j] + g4 * (y[j] * rstd * w4);
            *(f32x4*)(dst + col) = x[j];
            s2 += (x[j].x * x[j].x + x[j].y * x[j].y) + (x[j].z * x[j].z + x[j].w * x[j].w); }
        if (do_next) {
            const float* nmd = lat ? nmodl : nmodc;
            const float rstd2 = rsqrtf(wave_sum(s2) * (1.f / DM) + EPS);
#pragma unroll
            for (int j = 0; j < 8; ++j) { const int col = 4 * lane + 256 * j;
                const f32x4 g4 = *(const f32x4*)(wpre + col), s4 = *(const f32x4*)(nmd + sc_off + col), h4 = *(const f32x4*)(nmd + sh_off + col);
                const f32x4 o = x[j] * rstd2 * g4 * (1.f + s4) + h4;
                u32x2 w; w.x = pk2(o.x, o.y); w.y = pk2(o.z, o.w); *(u32x2*)(H + (size_t)row * DM + col) = w; }
        }
    }
}

__device__ __forceinline__ void kq_post(const float* qraw, const float* kraw, bf16_t* qb, bf16_t* kb, const float* qn, const float* kn, const float* rope, int gw, int NGW, int lane) {
    const int j = lane & 31, hsel = lane >> 5;
    for (int it = gw; it < MT * 5; it += NGW) {
        const int row = it / 5, hp = it - row * 5, head = 2 * hp + hsel;
        const float* src; bf16_t* dst; const float* w;
        if (head < 8) { src = qraw + (size_t)row * 1024 + head * 128 + 4 * j; dst = qb + (size_t)row * 1024 + head * 128 + 4 * j; w = qn + 4 * j; }
        else { src = kraw + (size_t)row * 256 + (head - 8) * 128 + 4 * j; dst = kb + (size_t)row * 256 + (head - 8) * 128 + 4 * j; w = kn + 4 * j; }
        f32x4 v = *(const f32x4*)src; const f32x4 w4 = *(const f32x4*)w;
        float ss = (v.x * v.x + v.y * v.y) + (v.z * v.z + v.w * v.w);
#pragma unroll
        for (int o = 1; o < 32; o <<= 1) ss += __shfl_xor(ss, o);
        const float rstd = rsqrtf(ss * (1.f / 128.f) + EPS);
        v = v * rstd * w4;
        f32x4 pt; pt.x = __shfl_xor(v.x, 8); pt.y = __shfl_xor(v.y, 8); pt.z = __shfl_xor(v.z, 8); pt.w = __shfl_xor(v.w, 8);
        if (row < L) {
            const int pos = (j < 16) ? (row >> 6) : (row & 63), fi = (4 * j) & 31;
            const f32x4 t0 = *(const f32x4*)(rope + (pos * 32 + fi) * 2), t1 = *(const f32x4*)(rope + (pos * 32 + fi) * 2 + 4);
            const float sg = (j & 8) ? 1.f : -1.f;
            v.x = v.x * t0.x + sg * pt.x * t0.y; v.y = v.y * t0.z + sg * pt.y * t0.w; v.z = v.z * t1.x + sg * pt.z * t1.y; v.w = v.w * t1.z + sg * pt.w * t1.w;
        }
        u32x2 o; o.x = pk2(v.x, v.y); o.y = pk2(v.z, v.w); *(u32x2*)dst = o;
    }
}

__device__ __forceinline__ void ssm_stage_u(const float* US, LAS float* us, int k, int g, int lane) {
    const float* src = US + (size_t)(64 * k + lane) * 512 + 16 * g;
#pragma unroll
    for (int q = 0; q < 4; ++q) *(LAS f32x4*)(us + lane * 16 + 4 * q) = *(const f32x4*)(src + 4 * q);
}
#define SSM_BU(j_) \
    const LAS f32x4* up_ = (const LAS f32x4*)(us + (j_) * 16); const f32x4 u0 = up_[0], u1 = up_[1], u2 = up_[2], u3 = up_[3]; \
    const float uu[16] = {u0.x, u0.y, u0.z, u0.w, u1.x, u1.y, u1.z, u1.w, u2.x, u2.y, u2.z, u2.w, u3.x, u3.y, u3.z, u3.w}; \
    float bur = 0.f, bui = 0.f; \
    _Pragma("unroll") for (int h = 0; h < 16; ++h) { bur += bb[h].x * uu[h]; bui += bb[h].y * uu[h]; } \
    { const float nr = ar * hr - ai * hi + bur, ni = ar * hi + ai * hr + bui; hr = nr; hi = ni; }

template <int DIR> __device__ __forceinline__ void ssm_s1_dir(const f32x4* AB, const f32x2* BB, float* S, const LAS float* us, int layer, int k, int g, int lane) {
    const int idx = ((layer * 2 + DIR) * 32 + g) * 64 + lane;
    const f32x4 ab = AB[idx]; const float ar = ab.x, ai = ab.y;
    f32x2 bb[16];
#pragma unroll
    for (int h = 0; h < 16; ++h) bb[h] = BB[(size_t)idx * 16 + h];
    float hr = 0.f, hi = 0.f;
    for (int jj = 0; jj < 64; ++jj) { const int j = DIR == 0 ? jj : 63 - jj; SSM_BU(j) }
    float* o = S + ((size_t)(DIR * NCH + k) * 32 + g) * 128;
    o[lane] = hr; o[64 + lane] = hi;
}
template <int DIR, int HH> __device__ __forceinline__ void ssm_s3_half(float ar, float ai, const f32x2 (&bb)[16], const bf16x8 (&cb)[4], float& hr, float& hi, const LAS float* us, LAS unsigned* st,
                                                                       pg8::f32x4& y0, pg8::f32x4& y1, int lane) {
    const int fr = lane & 15, fq = lane >> 4;
    for (int jj = 0; jj < 32; ++jj) { const int jl = DIR == 0 ? jj : 31 - jj; const int j = HH * 32 + jl; SSM_BU(j) st[jl * 68 + lane] = pk2(hr, hi); }
#pragma unroll
    for (int ks = 0; ks < 4; ++ks) {
        const bf16x8 a0 = *(const LAS bf16x8*)((const LAS unsigned char*)st + (fr) * 272 + (32 * ks + 8 * fq) * 2);
        const bf16x8 a1 = *(const LAS bf16x8*)((const LAS unsigned char*)st + (16 + fr) * 272 + (32 * ks + 8 * fq) * 2);
        y0 = __builtin_amdgcn_mfma_f32_16x16x32_bf16(a0, cb[ks], y0, 0, 0, 0);
        y1 = __builtin_amdgcn_mfma_f32_16x16x32_bf16(a1, cb[ks], y1, 0, 0, 0);
    }
}
template <int DIR> __device__ __forceinline__ void ssm_s3_dir(const f32x4* AB, const f32x2* BB, const bf16_t* CB, const float* HIN, const LAS float* us, LAS unsigned* st,
                                                              pg8::f32x4 (&yacc)[4], int layer, int k, int g, int lane) {
    const int fr = lane & 15, fq = lane >> 4;
    const int idx = ((layer * 2 + DIR) * 32 + g) * 64 + lane;
    const f32x4 ab = AB[idx]; const float ar = ab.x, ai = ab.y;
    f32x2 bb[16];
#pragma unroll
    for (int h = 0; h < 16; ++h) bb[h] = BB[(size_t)idx * 16 + h];
    bf16x8 cb[4];
#pragma unroll
    for (int ks = 0; ks < 4; ++ks) cb[ks] = *(const bf16x8*)(CB + ((size_t)(((layer * 2 + DIR) * 32 + g) * 16 + fr)) * 128 + 32 * ks + 8 * fq);
    const float* hin = HIN + ((size_t)(DIR * NCH + k) * 32 + g) * 128;
    float hr = hin[lane], hi = hin[64 + lane];
    if (DIR == 0) { ssm_s3_half<0, 0>(ar, ai, bb, cb, hr, hi, us, st, yacc[0], yacc[1], lane); ssm_s3_half<0, 1>(ar, ai, bb, cb, hr, hi, us, st, yacc[2], yacc[3], lane); }
    else          { ssm_s3_half<1, 1>(ar, ai, bb, cb, hr, hi, us, st, yacc[2], yacc[3], lane); ssm_s3_half<1, 0>(ar, ai, bb, cb, hr, hi, us, st, yacc[0], yacc[1], lane); }
}
__device__ __forceinline__ void cmul_add(float& dr, float& di, float ar, float ai, float br, float bi, float cr, float ci) { dr = ar * br - ai * bi + cr; di = ar * bi + ai * br + ci; }
__device__ __forceinline__ void ssm_s2_task(const f32x4* AB, const float* S, float* HIN, int layer, int task, int lane) {
    const int p = task & 63, g = (task >> 6) & 31, dir = task >> 11;
    const f32x4 ab = AB[((layer * 2 + dir) * 32 + g) * 64 + p]; const float ar = ab.z, ai = ab.w;
    const size_t dbase = (size_t)dir * NCH * 32 * 128 + (size_t)g * 128 + p;
#define CH_OF(q) (dir == 0 ? (((q) + 256) % NCH) : (NCH - 1 - (q)))
    float h4r = 0.f, h4i = 0.f;
    for (int q = 0; q < 4; ++q) { const size_t o = dbase + (size_t)CH_OF(q) * 4096; if (lane == 0) { HIN[o] = h4r; HIN[o + 64] = h4i; }
        const float sr = S[o], si = S[o + 64]; float nr, ni; cmul_add(nr, ni, ar, ai, h4r, h4i, sr, si); h4r = nr; h4i = ni; }
    float sr[4], si[4];
#pragma unroll
    for (int i = 0; i < 4; ++i) { const size_t o = dbase + (size_t)CH_OF(4 + 4 * lane + i) * 4096; sr[i] = S[o]; si[i] = S[o + 64]; }
    float er = sr[0], ei = si[0];
#pragma unroll
    for (int i = 1; i < 4; ++i) { float nr, ni; cmul_add(nr, ni, ar, ai, er, ei, sr[i], si[i]); er = nr; ei = ni; }
    float mr, mi; { const float a2r = ar * ar - ai * ai, a2i = 2.f * ar * ai; mr = a2r * a2r - a2i * a2i; mi = 2.f * a2r * a2i; }
#pragma unroll
    for (int d = 1; d < 64; d <<= 1) {
        const float pr = __shfl_up(er, d), pi = __shfl_up(ei, d), qr = __shfl_up(mr, d), qi = __shfl_up(mi, d);
        if (lane >= d) { float nr, ni; cmul_add(nr, ni, mr, mi, pr, pi, er, ei); er = nr; ei = ni; const float tr = mr * qr - mi * qi, ti = mr * qi + mi * qr; mr = tr; mi = ti; }
    }
    float outr, outi; cmul_add(outr, outi, mr, mi, h4r, h4i, er, ei);
    float inr = __shfl_up(outr, 1), ini = __shfl_up(outi, 1);
    if (lane == 0) { inr = h4r; ini = h4i; }
#pragma unroll
    for (int i = 0; i < 4; ++i) { const size_t o = dbase + (size_t)CH_OF(4 + 4 * lane + i) * 4096; HIN[o] = inr; HIN[o + 64] = ini; float nr, ni; cmul_add(nr, ni, ar, ai, inr, ini, sr[i], si[i]); inr = nr; ini = ni; }
#undef CH_OF
}

#define MFMA16(a, b, c) __builtin_amdgcn_mfma_f32_16x16x32_bf16(a, b, c, 0, 0, 0)
__device__ __forceinline__ void fft1_task(const bf16_t* UF, bf16_t* TB, const f32x2* TW, const LAS unsigned char* w1, int task, int lane) {
    const int fr = lane & 15, fq = lane >> 4, n2 = task >> 5, cb = task & 31;
    bf16x8 xb[4];
#pragma unroll
    for (int ks = 0; ks < 4; ++ks)
#pragma unroll
        for (int i = 0; i < 8; ++i) xb[ks][i] = (short)UF[(size_t)(128 * (32 * ks + 8 * fq + i) + n2) * 512 + 16 * cb + fr];
    for (int mt = 0; mt < 8; ++mt) {
        pg8::f32x4 accr = {0.f, 0.f, 0.f, 0.f}, acci = {0.f, 0.f, 0.f, 0.f};
#pragma unroll
        for (int ks = 0; ks < 4; ++ks) {
            const bf16x8 are = *(const LAS bf16x8*)(w1 + (16 * mt + fr) * 272 + (32 * ks + 8 * fq) * 2);
            const bf16x8 aim = *(const LAS bf16x8*)(w1 + (128 + 16 * mt + fr) * 272 + (32 * ks + 8 * fq) * 2);
            accr = MFMA16(are, xb[ks], accr); acci = MFMA16(aim, xb[ks], acci);
        }
#pragma unroll
        for (int e = 0; e < 4; ++e) { const int k1 = 16 * mt + 4 * fq + e; const f32x2 tw = TW[k1 * 128 + n2];
            const float tr = accr[e] * tw.x + acci[e] * tw.y, ti = acci[e] * tw.x - accr[e] * tw.y;
            TB[((size_t)(k1) * 128 + n2) * 512 + 16 * cb + fr] = f2bf(tr); TB[((size_t)(128 + k1) * 128 + n2) * 512 + 16 * cb + fr] = f2bf(ti); }
    }
}
__device__ __forceinline__ void fft2_task(const bf16_t* TB, bf16_t* XF, const LAS unsigned char* w2, int task, int lane) {
    const int fr = lane & 15, fq = lane >> 4, k1 = task >> 5, cb = task & 31, c = 16 * cb + fr, hh = c >> 7, cc = c & 127;
    bf16x8 tb[8];
#pragma unroll
    for (int ks = 0; ks < 8; ++ks)
#pragma unroll
        for (int i = 0; i < 8; ++i) { const int kk = 32 * ks + 8 * fq + i; tb[ks][i] = (short)TB[((size_t)((kk >> 7) * 128 + k1) * 128 + (kk & 127)) * 512 + c]; }
    for (int mt = 0; mt < 16; ++mt) {
        pg8::f32x4 acc = {0.f, 0.f, 0.f, 0.f};
#pragma unroll
        for (int ks = 0; ks < 8; ++ks) { const bf16x8 a = *(const LAS bf16x8*)(w2 + (16 * mt + fr) * 528 + (32 * ks + 8 * fq) * 2); acc = MFMA16(a, tb[ks], acc); }
#pragma unroll
        for (int e = 0; e < 4; ++e) { const int r = 16 * mt + 4 * fq + e, po = r >> 7, k2 = r & 127;
            XF[(size_t)(k1 + 128 * k2) * 1024 + hh * 256 + po * 128 + cc] = f2bf(acc[e]); }
    }
}
__device__ __forceinline__ void fftc_task(const bf16_t* UF, bf16_t* XF, const bf16_t* WC, int task, int lane) {
    const int fr = lane & 15, fq = lane >> 4, cb = task & 31, mtg = task >> 5, c = 16 * cb + fr, hh = c >> 7, cc = c & 127;
    bf16x8 xb[8];
#pragma unroll
    for (int ks = 0; ks < 8; ++ks)
#pragma unroll
        for (int i = 0; i < 8; ++i) xb[ks][i] = (short)UF[(size_t)(L + 32 * ks + 8 * fq + i) * 512 + c];
    for (int mt = 8 * mtg; mt < 8 * mtg + 8; ++mt) {
        pg8::f32x4 acc = {0.f, 0.f, 0.f, 0.f};
#pragma unroll
        for (int ks = 0; ks < 8; ++ks) { const bf16x8 a = *(const bf16x8*)(WC + (size_t)(16 * mt + fr) * 256 + 32 * ks + 8 * fq); acc = MFMA16(a, xb[ks], acc); }
#pragma unroll
        for (int e = 0; e < 4; ++e) { const int r = 16 * mt + 4 * fq + e, po = r >> 8, kk = r & 255;
            XF[(size_t)(L + kk) * 1024 + hh * 256 + po * 128 + cc] = f2bf(acc[e]); }
    }
}

constexpr int TAB_OFF = LDS_BYTES - 256;
__device__ __forceinline__ const void* tabptr(LAS unsigned char* lds, int i) {
    const LAS unsigned* t = (const LAS unsigned*)(lds + TAB_OFF) + 2 * i;
    const unsigned lo = __builtin_amdgcn_readfirstlane(t[0]), hi = __builtin_amdgcn_readfirstlane(t[1]);
    return (const void*)(((unsigned long long)hi << 32) | lo);
}
#define INP(i) ((const float*)tabptr(lds, (i)))
#define PH_IDS \
    int tid = threadIdx.x; asm volatile("" : "+v"(tid)); const int lane = tid & 63, wave = __builtin_amdgcn_readfirstlane(tid >> 6); \
    int bx = blockIdx.x, G = gridDim.x; asm volatile("" : "+s"(bx), "+s"(G)); \
    const int gw = bx * 8 + wave, NGW = G * 8, gt = bx * 512 + tid, NTH = G * 512; (void)lane; (void)gw; (void)NGW; (void)gt; (void)NTH; \
    unsigned char* ws = (unsigned char*)tabptr(lds, 29); (void)ws;
#define WSP(T, off) ((T*)(ws + (off)))

__global__ void __launch_bounds__(512, 2) hybrid_fwd(Params P) {
    extern __shared__ __attribute__((aligned(16))) unsigned char lds_raw[];
    cg::grid_group grid = cg::this_grid();
    LAS unsigned char* lds = (LAS unsigned char*)lds_raw;
    if (threadIdx.x == 0) {
        LAS unsigned long long* t = (LAS unsigned long long*)(lds + TAB_OFF);
#pragma unroll
        for (int i = 0; i < 28; ++i) t[i] = (unsigned long long)P.in[i];
        t[28] = (unsigned long long)P.out; t[29] = (unsigned long long)P.ws;
    }
    __syncthreads();

    {
        PH_IDS
        LAS float* sl = (LAS float*)lds;
        LAS float* ct = (LAS float*)(lds + 16384);
        { const float* cin = INP(1); const float* cctx = INP(3);
          for (int i = tid; i < 2048; i += 512) { const float a = cin[i], b = cctx[i]; sl[i] = a / (1.f + expf(-a)); sl[2048 + i] = b / (1.f + expf(-b)); } }
        if (tid < 128) ct[tid] = cospif((float)tid * (1.f / 64.f));
        __syncthreads();
        { const float* adaw = INP(4); float* MODP = WSP(float, O_MODP);
          for (int it = gt; it < 98304; it += NTH) {
            const int kc = it / 6144, r = it - kc * 6144, layer = r / 3072, c4 = r - layer * 3072;
            const float* w = adaw + ((size_t)layer * 2048 + kc * 128) * 12288 + 4 * c4;
            f32x4 a0 = {0.f, 0.f, 0.f, 0.f}, a1 = {0.f, 0.f, 0.f, 0.f};
#pragma unroll 8
            for (int k = 0; k < 128; ++k) { const f32x4 wv = *(const f32x4*)(w + (size_t)k * 12288); const float s0 = sl[kc * 128 + k], s1 = sl[2048 + kc * 128 + k]; a0 += wv * s0; a1 += wv * s1; }
            float* o = MODP + ((size_t)(kc * 2 + layer) * 2) * 12288 + 4 * c4;
            *(f32x4*)o = a0; *(f32x4*)(o + 12288) = a1;
          } }
        { float* ROPE = WSP(float, O_ROPE);
          for (int it = gt; it < 8192; it += NTH) { const int pos = it >> 5, i = it & 31; const float freq = powf(10000.f, -(float)i * (1.f / 32.f)); const float ang = (float)pos * freq;
            const double a = (double)ang, kq = rint(a * 0.15915494309189535), rr = a - kq * 6.283185307179586; const float rf = (float)rr; ROPE[2 * it] = cosf(rf); ROPE[2 * it + 1] = sinf(rf); } }
        { const float* lamre = INP(13); const float* lamim = INP(14); const float* logdt = INP(15); const float* bre = INP(16); const float* bim = INP(17); const float* cre = INP(18); const float* cim = INP(19);
          f32x4* AB = WSP(f32x4, O_AB); f32x2* BB = WSP(f32x2, O_BB); unsigned* CB32 = WSP(unsigned, O_CB);
          for (int it = gt; it < 8192; it += NTH) {
            const int p = it & 63;
            const float lr = lamre[it], li = lamim[it], ldt = logdt[it >> 6];
            const float dt = expf(ldt), mag = expf(lr * dt), th = li * dt;
            const float ar = mag * cosf(th), ai = mag * sinf(th);
            const float den = lr * lr + li * li, cr = ((ar - 1.f) * lr + ai * li) / den, ci = (ai * lr - (ar - 1.f) * li) / den;
            float pr = ar, pi = ai;
#pragma unroll
            for (int s = 0; s < 6; ++s) { const float nr = pr * pr - pi * pi, ni = 2.f * pr * pi; pr = nr; pi = ni; }
            AB[it] = (f32x4){ar, ai, pr, pi};
#pragma unroll
            for (int h = 0; h < 16; ++h) { const float br = bre[(size_t)it * 16 + h], bi = bim[(size_t)it * 16 + h]; BB[(size_t)it * 16 + h] = (f32x2){cr * br - ci * bi, cr * bi + ci * br}; }
#pragma unroll
            for (int h = 0; h < 16; ++h) { const size_t ci_ = ((size_t)(it >> 6) * 16 + h) * 64 + p; CB32[ci_] = pk2(cre[ci_], -cim[ci_]); }
          } }
        { bf16_t* W1 = WSP(bf16_t, O_W1); bf16_t* W2 = WSP(bf16_t, O_W2); bf16_t* WC = WSP(bf16_t, O_WC); f32x2* TW = WSP(f32x2, O_TW);
          for (int it = gt; it < 32768; it += NTH) { const int r = it >> 7, n1 = it & 127, m = ((r & 127) * n1) & 127; const float x = (float)m * (1.f / 64.f); W1[it] = f2bf(r < 128 ? cospif(x) : -sinpif(x)); }
          for (int it = gt; it < 65536; it += NTH) { const int r = it >> 8, kk = it & 255, po = r >> 7, k2 = r & 127, pi_ = kk >> 7, n2 = kk & 127, m = (k2 * n2) & 127; const float x = (float)m * (1.f / 64.f);
            const float cv = cospif(x), sv = sinpif(x); W2[it] = f2bf(po == pi_ ? cv : (po == 0 ? sv : -sv)); }
          for (int it = gt; it < 131072; it += NTH) { const int r = it >> 8, n = it & 255, part = r >> 8, k = r & 255, m = (k * n) & 255; const float x = (float)m * (1.f / 128.f); WC[it] = f2bf(8.f * (part == 0 ? cospif(x) : -sinpif(x))); }
          for (int it = gt; it < 16384; it += NTH) { const int k1 = it >> 7, n2 = it & 127; const float x = (float)(k1 * n2) * (1.f / 8192.f); TW[it] = (f32x2){cospif(x), sinpif(x)}; } }
        { const float* fwp = INP(23); bf16_t* WF = WSP(bf16_t, O_WF);
          for (int it = gt; it < 2 * 524288; it += NTH) { const int layer = it >> 19, r = it & 524287, n = r & 511, kk = r >> 9, hh = kk >> 8, part = (kk >> 7) & 1, c = kk & 127;
            const float* fw = fwp + (size_t)layer * 262144 + (size_t)(hh * 128) * 512 + n; float acc = 0.f;
            for (int j = 0; j < 128; ++j) { const int m = (c * j) & 127; const float t = part ? ct[(m + 96) & 127] : ct[m]; acc += t * fw[(size_t)j * 512]; }
            WF[(size_t)layer * 524288 + (size_t)n * 1024 + kk] = f2bf(acc * 6.9053396600248786e-4f); } }
        { LAS float* scr = (LAS float*)(lds + 32768 + wave * 8448);
          for (int it = gw; it < 2 * 21632; it += NGW) {
            const int layer = it / 21632; int r = it - layer * 21632;
            if (r < 2560) { tr_item(INP(10) + (size_t)layer * DM * INW, DM, INW, WSP(bf16_t, O_WIN) + (size_t)layer * INW * DM, 0, scr, r, lane); continue; } r -= 2560;
            if (r < 2048) { tr_item(INP(24) + (size_t)layer * DM * DM, DM, DM, WSP(bf16_t, O_WOUT) + (size_t)layer * DM * DM, 0, scr, r, lane); continue; } r -= 2048;
            if (r < 5632) { tr_item(INP(25) + (size_t)layer * DM * FF, DM, FF, WSP(bf16_t, O_WGU) + (size_t)layer * 2 * FF * DM, 1, scr, r, lane); continue; } r -= 5632;
            if (r < 5632) { tr_item(INP(26) + (size_t)layer * DM * FF, DM, FF, WSP(bf16_t, O_WGU) + (size_t)layer * 2 * FF * DM, 2, scr, r, lane); continue; } r -= 5632;
            if (r < 5632) { tr_item(INP(27) + (size_t)layer * FF * DM, FF, DM, WSP(bf16_t, O_WDN) + (size_t)layer * DM * FF, 0, scr, r, lane); continue; } r -= 5632;
            tr_item(INP(21) + (size_t)layer * 512 * 512, 512, 512, WSP(bf16_t, O_WGLU) + (size_t)layer * 512 * 512, 0, scr, r, lane);
          } }
    }
    grid.sync();
    {
        PH_IDS
        const float* adab = INP(5); const float* MODP = WSP(float, O_MODP); float* MOD = WSP(float, O_MOD);
        for (int it = gt; it < 49152; it += NTH) { const int layer = it / 24576, v = (it / 12288) & 1, col = it % 12288; float s = adab[layer * 12288 + col];
#pragma unroll
            for (int kc = 0; kc < 16; ++kc) s += MODP[((size_t)(kc * 2 + layer) * 2 + v) * 12288 + col];
            MOD[it] = s; }
    }
    grid.sync();
    {
        PH_IDS
        const float* MOD = WSP(float, O_MOD);
        prenorm_rows(INP(0), INP(2), WSP(bf16_t, O_H), INP(6), MOD, MOD + 12288, 0, 2048, MT, gw, NGW, lane);
    }
    grid.sync();

#pragma unroll 1
    for (int layer = 0; layer < 2; ++layer) {
        { PH_IDS
          pg8::Gemm g{WSP(bf16_t, O_H), WSP(bf16_t, O_WIN) + (size_t)layer * INW * DM, MT, INW, DM}; pg8::StaticOrder S; S.init(MT, INW, G, bx);
          EpiIn E{WSP(float, O_QRAW), WSP(float, O_KRAW), WSP(bf16_t, O_VB), WSP(float, O_US), WSP(bf16_t, O_UF)};
          pg8::gemm_phase<EpiIn, pg8::StaticOrder, true, true>(lds, g, S, E); }
        grid.sync();
        {
            PH_IDS
            { const bf16_t* W1 = WSP(bf16_t, O_W1);
              for (int i = tid; i < 256 * 16; i += 512) { const int r = i >> 4, ch = i & 15; *(LAS u32x4*)(lds + r * 272 + ch * 16) = *(const u32x4*)(W1 + r * 128 + ch * 8); } }
            __syncthreads();
            { const bf16_t* UF = WSP(bf16_t, O_UF); bf16_t* TB = WSP(bf16_t, O_TB); const f32x2* TW = WSP(f32x2, O_TW);
              for (int task = gw; task < 4096; task += NGW) fft1_task(UF, TB, TW, lds, task, lane); }
            { LAS float* us = (LAS float*)(lds + 69632 + wave * 4096);
              const float* US = WSP(float, O_US); const f32x4* AB = WSP(f32x4, O_AB); const f32x2* BB = WSP(f32x2, O_BB); float* SS = WSP(float, O_S);
              for (int task = gw; task < NCH * 32; task += NGW) { const int k = task >> 5, g = task & 31;
                ssm_stage_u(US, us, k, g, lane);
                ssm_s1_dir<0>(AB, BB, SS, us, layer, k, g, lane); ssm_s1_dir<1>(AB, BB, SS, us, layer, k, g, lane); } }
            kq_post(WSP(float, O_QRAW), WSP(float, O_KRAW), WSP(bf16_t, O_QB), WSP(bf16_t, O_KB), INP(11) + layer * 128, INP(12) + layer * 128, WSP(float, O_ROPE), gw, NGW, lane);
        }
        grid.sync();
        {
            PH_IDS
            { const bf16_t* W2 = WSP(bf16_t, O_W2);
              for (int i = tid; i < 256 * 32; i += 512) { const int r = i >> 5, ch = i & 31; *(LAS u32x4*)(lds + r * 528 + ch * 16) = *(const u32x4*)(W2 + r * 256 + ch * 8); } }
            __syncthreads();
            { const f32x4* AB = WSP(f32x4, O_AB); const float* SS = WSP(float, O_S); float* HIN = WSP(float, O_HIN);
              for (int task = gw; task < 4096; task += NGW) ssm_s2_task(AB, SS, HIN, layer, task, lane); }
            { const bf16_t* TB = WSP(bf16_t, O_TB); bf16_t* XF = WSP(bf16_t, O_XF);
              for (int task = gw; task < 4096; task += NGW) fft2_task(TB, XF, lds, task, lane); }
            if (layer == 0) { const bf16_t* UF = WSP(bf16_t, O_UF); bf16_t* XF = WSP(bf16_t, O_XF); const bf16_t* WC = WSP(bf16_t, O_WC);
              for (int task = gw; task < 128; task += NGW) fftc_task(UF, XF, WC, task, lane); }
        }
        grid.sync();
        {
            PH_IDS
            LAS float* us = (LAS float*)(lds + wave * 12800);
            LAS unsigned* st = (LAS unsigned*)(lds + wave * 12800 + 4096);
            const int fr = lane & 15, fq = lane >> 4;
            const int nchunk = layer == 0 ? NCH : 256;
            const float* US = WSP(float, O_US); const f32x4* AB = WSP(f32x4, O_AB); const f32x2* BB = WSP(f32x2, O_BB); const bf16_t* CB = WSP(bf16_t, O_CB); const float* HIN = WSP(float, O_HIN);
            bf16_t* GB = WSP(bf16_t, O_G); const float* dvp = INP(20) + layer * 512;
            for (int task = gw; task < nchunk * 32; task += NGW) { const int k = task >> 5, g = task & 31;
                ssm_stage_u(US, us, k, g, lane);
                pg8::f32x4 yacc[4];
#pragma unroll
                for (int q = 0; q < 4; ++q) yacc[q] = (pg8::f32x4){0.f, 0.f, 0.f, 0.f};
                ssm_s3_dir<0>(AB, BB, CB, HIN, us, st, yacc, layer, k, g, lane);
                ssm_s3_dir<1>(AB, BB, CB, HIN, us, st, yacc, layer, k, g, lane);
                const float dv = dvp[16 * g + fr];
#pragma unroll
                for (int q = 0; q < 4; ++q)
#pragma unroll
                    for (int e = 0; e < 4; ++e) { const int tok = 16 * q + 4 * fq + e; const float yv = yacc[q][e] + dv * us[tok * 16 + fr];
                        GB[(size_t)(64 * k + tok) * 512 + 16 * g + fr] = f2bf(gelu_tanh(yv)); }
            }
        }
        grid.sync();
        { PH_IDS
          const int MR = layer == 0 ? MT : L;
          pg8::Gemm g{WSP(bf16_t, O_G), WSP(bf16_t, O_WGLU) + (size_t)layer * 512 * 512, MR, 512, 512}; pg8::StaticOrder S; S.init(MR, 512, G, bx);
          EpiMix E{WSP(bf16_t, O_CAT), WSP(bf16_t, O_G), INP(22) + layer * 512, 0};
          pg8::gemm_phase<EpiMix, pg8::StaticOrder, true, true>(lds, g, S, E); }
        __syncthreads();
        { PH_IDS
          const int MR = layer == 0 ? MT : L;
          pg8::Gemm g{WSP(bf16_t, O_XF), WSP(bf16_t, O_WF) + (size_t)layer * 524288, MR, 512, 1024}; pg8::StaticOrder S; S.init(MR, 512, G, (bx + 128) % G);
          EpiMix E{WSP(bf16_t, O_CAT), WSP(bf16_t, O_G), INP(22) + layer * 512, 1};
          pg8::gemm_phase<EpiMix, pg8::StaticOrder, true, true>(lds, g, S, E); }
        __syncthreads();
        { PH_IDS
          const att::bf16* q_ = WSP(const att::bf16, O_QB); const att::bf16* k_ = WSP(const att::bf16, O_KB); const att::bf16* v_ = WSP(const att::bf16, O_VB); att::bf16* o_ = WSP(att::bf16, O_CAT);
          for (int u = bx; u < 512; u += G) { const int xcd = u & 7, j = (u >> 3) & 31, rr = u >> 8, kvh = xcd & 1, head = 4 * kvh + (xcd >> 1), qb = j + 32 * rr;
              att::attn_dense_body<att::bf16>(q_ + (size_t)qb * 256 * 1024 + head * 128, k_ + kvh * 128, v_ + kvh * 128, o_ + (size_t)qb * 256 * 2048 + head * 128, MT, (char*)lds_raw);
              __syncthreads(); }
          if (layer == 0) for (int u = bx; u < 8; u += G) { const int head = u, kvh = head >> 2;
              att::attn_dense_body<att::bf16>(q_ + (size_t)L * 1024 + head * 128, k_ + (size_t)L * 256 + kvh * 128, v_ + (size_t)L * 256 + kvh * 128, o_ + (size_t)L * 2048 + head * 128, 256, (char*)lds_raw);
              __syncthreads(); }
        }
        grid.sync();
        { PH_IDS
          const int MR = layer == 0 ? MT : L;
          pg8::Gemm g{WSP(bf16_t, O_CAT), WSP(bf16_t, O_WOUT) + (size_t)layer * DM * DM, MR, DM, DM}; pg8::StaticOrder S; S.init(MR, DM, G, bx);
          EpiF32 E{WSP(float, O_Y), DM};
          pg8::gemm_phase<EpiF32, pg8::StaticOrder, true, true>(lds, g, S, E); }
        grid.sync();
        { PH_IDS
          const int MR = layer == 0 ? MT : L;
          const float* modl = WSP(float, O_MOD) + (size_t)layer * 24576; const float* modc = modl + 12288;
          float* outp = (float*)tabptr(lds, 28); float* XC = WSP(float, O_XC);
          const float* xl_src = layer == 0 ? INP(0) : outp; const float* xc_src = layer == 0 ? INP(2) : XC;
          post_rows(xl_src, xc_src, outp, XC, WSP(float, O_Y), INP(7) + layer * DM, modl, modc, 2 * 2048, true, WSP(bf16_t, O_H), INP(8) + layer * DM, modl, modc, 3 * 2048, 4 * 2048, MR, gw, NGW, lane); }
        grid.sync();
        { PH_IDS
          const int MR = layer == 0 ? MT : L;
          pg8::Gemm g{WSP(bf16_t, O_H), WSP(bf16_t, O_WGU) + (size_t)layer * 2 * FF * DM, MR, 2 * FF, DM}; pg8::StaticOrder S; S.init(MR, 2 * FF, G, bx);
          EpiUp E{WSP(bf16_t, O_HID)};
          pg8::gemm_phase<EpiUp, pg8::StaticOrder, true, true>(lds, g, S, E); }
        grid.sync();
        { PH_IDS
          const int MR = layer == 0 ? MT : L;
          pg8::Gemm g{WSP(bf16_t, O_HID), WSP(bf16_t, O_WDN) + (size_t)layer * DM * FF, MR, DM, FF}; pg8::StaticOrder S; S.init(MR, DM, G, bx);
          EpiF32 E{WSP(float, O_Y), DM};
          pg8::gemm_phase<EpiF32, pg8::StaticOrder, true, true>(lds, g, S, E); }
        grid.sync();
        { PH_IDS
          const int MR = layer == 0 ? MT : L;
          const float* modl = WSP(float, O_MOD) + (size_t)layer * 24576; const float* modc = modl + 12288; const float* nmodl = modl + 24576;
          float* outp = (float*)tabptr(lds, 28); float* XC = WSP(float, O_XC);
          post_rows(outp, XC, outp, XC, WSP(float, O_Y), INP(9) + layer * DM, modl, modc, 5 * 2048, layer == 0, WSP(bf16_t, O_H), INP(6) + (layer + 1) * DM, nmodl, nmodl + 12288, 0, 2048, MR, gw, NGW, lane); }
        grid.sync();
    }
}

extern "C" void kernel_launch(void* const* d_in, const int* in_sizes, int n_in, void* d_out, int out_size, void* d_ws, size_t ws_size, hipStream_t stream) {
    static int grid = 0;
    if (grid == 0) {
        if (n_in != 28 || ws_size < WS_END) { fprintf(stderr, "kernel_launch: n_in %d (want 28), ws %zu (want >= %zu)\n", n_in, ws_size, (size_t)WS_END); grid = -1; return; }
        int dev = 0, cus = 0, per_cu = 0;
        (void)hipGetDevice(&dev); (void)hipDeviceGetAttribute(&cus, hipDeviceAttributeMultiprocessorCount, dev);
        if (hipFuncSetAttribute((const void*)hybrid_fwd, hipFuncAttributeMaxDynamicSharedMemorySize, LDS_BYTES) != hipSuccess) { fprintf(stderr, "kernel_launch: hipFuncSetAttribute failed\n"); grid = -1; return; }
        if (hipOccupancyMaxActiveBlocksPerMultiprocessor(&per_cu, (const void*)hybrid_fwd, 512, LDS_BYTES) != hipSuccess || per_cu < 1) { fprintf(stderr, "kernel_launch: occupancy query gave %d\n", per_cu); per_cu = 1; }
        (void)hipGetLastError();
        grid = cus * 1;
        if (grid <= 0) grid = 256;
    }
    if (grid < 0) return;
    Params p{};
    for (int i = 0; i < 28; ++i) p.in[i] = (const float*)d_in[i];
    p.out = (float*)d_out; p.ws = (unsigned char*)d_ws;
    void* args[] = {&p};
    hipError_t e = hipLaunchCooperativeKernel((const void*)hybrid_fwd, dim3(grid), dim3(512), args, LDS_BYTES, stream);
    if (e != hipSuccess) fprintf(stderr, "kernel_launch: cooperative launch failed: %s (grid %d)\n", hipGetErrorString(e), grid);
}
```

```cpp
#include <hip/hip_runtime.h>
#include <hip/hip_cooperative_groups.h>
#include <hip/hip_bf16.h>
#include <cstdio>
#include <cstdint>
#include <cmath>
namespace cg = cooperative_groups;
namespace pg8 {
#define PG8_LAS __attribute__((address_space(3)))
typedef unsigned short bf16_t;
typedef short bf16x8 __attribute__((ext_vector_type(8)));
typedef float f32x4 __attribute__((ext_vector_type(4)));
typedef unsigned u32x4 __attribute__((ext_vector_type(4)));
constexpr int BM = 256, BK = 64, HALF = 128, HTB = HALF * BK * 2  , STAGE_BYTES = 8 * HTB, NXCD = 8, WGM = 8;

__host__ __device__ __forceinline__ int lds_byte(int r, int c) { const int st = (r >> 4) * 2 + (c >> 5), rr = r & 15, cc = c & 31, ob = rr * 64 + cc * 2; return st * 1024 + (ob ^ (((ob >> 9) & 1) << 5)); }
__host__ __device__ __forceinline__ void stage_rc(int b, int& R, int& C) { const int st = b / 1024, sb = b % 1024, swz = sb ^ (((sb >> 9) & 1) << 5); R = (st >> 1) * 16 + swz / 64; C = (st & 1) * 32 + (swz % 64) / 2; }
__host__ __device__ __forceinline__ int perm32(int rho) { const int n = rho >> 4, i = rho & 15; return 8 * (i >> 2) + 4 * n + (i & 3); }

struct Unit { int pm, pn; };
struct Gemm { const bf16_t* A; const bf16_t* Bt; int M, N, K; int ld = 0; };

struct StaticOrder {
    int nM, nN, nwg, G, c;
    __host__ __device__ void init(int M, int N, int G_, int c_) { nM = M / BM; nN = N / BM; nwg = nM * nN; G = G_; c = c_; }
    __host__ __device__ bool next(int i, Unit& u) const {
        const long L = (long)i * G + c; if (L >= nwg) return false;
        int wgid = (int)L; { const int q = nwg / NXCD, r = nwg % NXCD, xcd = wgid % NXCD, off = wgid / NXCD; wgid = (xcd < r ? xcd * (q + 1) : r * (q + 1) + (xcd - r) * q) + off; }
        const int nig = WGM * nN, gid = wgid / nig, fm = gid * WGM, gsz = (nM - fm) < WGM ? (nM - fm) : WGM;
        u.pm = fm + ((wgid % nig) % gsz); u.pn = (wgid % nig) / gsz; return true;
    }
    __device__ __forceinline__ void a_ready(const Unit&) const {}
    __device__ __forceinline__ void done(const Unit&) const {}
};

__device__ __forceinline__ unsigned cvt_pk_bf16(float lo, float hi) { unsigned r; asm volatile("v_cvt_pk_bf16_f32 %0, %1, %2" : "=v"(r) : "v"(lo), "v"(hi)); return r; }
typedef float f32x2 __attribute__((ext_vector_type(2)));
template <class Epi, class Sched, bool ALIGN_EPI = false, bool SP2 = false>
__device__ __forceinline__ void gemm_phase(PG8_LAS unsigned char* lds, const Gemm g, const Sched& S, const Epi& E) {
    int tid_ = threadIdx.x; asm volatile("" : "+v"(tid_)); const int tid = tid_, wid = __builtin_amdgcn_readfirstlane(tid >> 6), lane = tid & 63, wr = wid >> 2, wc = wid & 3, fr = lane & 15, fq = lane >> 4;
    const int nt = g.K / BK, K = g.ld ? g.ld : g.K;
    unsigned voffA[2], voffB[2];
#pragma unroll
    for (int i = 0; i < 2; ++i) { int R, C; stage_rc(tid * 16 + i * 8192, R, C); const int Rb = Epi::PERM ? ((R & ~31) + perm32(R & 31)) : R;
        voffA[i] = (unsigned)(R * K + C) * 2u; voffB[i] = (unsigned)(Rb * K + C) * 2u; }
    const size_t kstep = (size_t)(BK * 2);
    const size_t hstep = (size_t)HALF * K * 2;
    const size_t tstep = 2 * hstep;
    const unsigned ldsw = (unsigned)wid * 1024u;
    const int aoff = lds_byte(wr * 64 + fr, fq * 8), boff = lds_byte(wc * 32 + fr, fq * 8);
#define PG8_SA(b, h) (((b) * 2 + (h)) * HTB)
#define PG8_SB(b, h) ((4 + (b) * 2 + (h)) * HTB)
#define PG8_STAGE(bufoff, gbase, voff) do { _Pragma("unroll") for (int _i = 0; _i < 2; ++_i) \
        __builtin_amdgcn_global_load_lds((const unsigned*)((const char*)(gbase) + (voff)[_i]), (PG8_LAS unsigned*)(lds + (bufoff) + ldsw + _i * 8192), 16, 0, 0); } while (0)
#define PG8_LDA(dst, b, h) do { _Pragma("unroll") for (int m = 0; m < 4; ++m) _Pragma("unroll") for (int k = 0; k < 2; ++k) dst[m][k] = *(const PG8_LAS bf16x8*)(lds + PG8_SA(b, h) + aoff + m * 2048 + k * 1024); } while (0)
#define PG8_LDB(dst, b, h) do { _Pragma("unroll") for (int n = 0; n < 2; ++n) _Pragma("unroll") for (int k = 0; k < 2; ++k) dst[n][k] = *(const PG8_LAS bf16x8*)(lds + PG8_SB(b, h) + boff + n * 2048 + k * 1024); } while (0)
#define PG8_MMA(ai, bj, At, Bt) do { __builtin_amdgcn_s_setprio(1); _Pragma("unroll") for (int m = 0; m < 4; ++m) _Pragma("unroll") for (int n = 0; n < 2; ++n) _Pragma("unroll") for (int k = 0; k < 2; ++k) \
        acc[ai][bj][m][n] = __builtin_amdgcn_mfma_f32_16x16x32_bf16(Bt[n][k], At[m][k], acc[ai][bj][m][n], 0, 0, 0); __builtin_amdgcn_s_setprio(0); } while (0)
#define PG8_WAIT_V(n) asm volatile("s_waitcnt vmcnt(" #n ")" ::: "memory")
#define PG8_WAIT_L(n) asm volatile("s_waitcnt lgkmcnt(" #n ")" ::: "memory")
#define PG8_BAR __builtin_amdgcn_s_barrier()
#define PG8_SCHED __builtin_amdgcn_sched_barrier(0)
    Unit cur, nxt; int ui = 0;
    if (!S.next(0, cur)) return;
    f32x4 acc[2][2][4][2];
#pragma unroll
    for (int a = 0; a < 2; ++a)
#pragma unroll
        for (int b = 0; b < 2; ++b)
#pragma unroll
            for (int m = 0; m < 4; ++m)
#pragma unroll
                for (int n = 0; n < 2; ++n) acc[a][b][m][n] = (f32x4){0.f, 0.f, 0.f, 0.f};
    bf16x8 At[4][2], B0[2][2], B1[2][2];
    const char* cA = (const char*)g.A + (size_t)cur.pm * tstep; const char* cB = (const char*)g.Bt + (size_t)cur.pn * tstep;
    S.a_ready(cur);
    if constexpr (SP2) {
        PG8_STAGE(PG8_SB(0, 0), cB, voffB); PG8_STAGE(PG8_SB(0, 1), cB + hstep, voffB); PG8_STAGE(PG8_SA(0, 0), cA, voffA); PG8_STAGE(PG8_SA(0, 1), cA + hstep, voffA);
        if (wr == 1) PG8_BAR;
        PG8_WAIT_V(2); PG8_BAR;
        PG8_STAGE(PG8_SB(1, 0), cB + kstep, voffB); PG8_STAGE(PG8_SA(1, 0), cA + kstep, voffA); PG8_STAGE(PG8_SB(1, 1), cB + hstep + kstep, voffB);
        PG8_WAIT_V(6); PG8_BAR;
    } else {
        PG8_STAGE(PG8_SB(0, 0), cB, voffB); PG8_STAGE(PG8_SA(0, 0), cA, voffA); PG8_STAGE(PG8_SB(0, 1), cB + hstep, voffB); PG8_STAGE(PG8_SA(0, 1), cA + hstep, voffA);
        if (wr == 1) PG8_BAR;
        PG8_WAIT_V(4); PG8_BAR;
        PG8_STAGE(PG8_SB(1, 0), cB + kstep, voffB); PG8_STAGE(PG8_SA(1, 0), cA + kstep, voffA); PG8_STAGE(PG8_SB(1, 1), cB + hstep + kstep, voffB);
        PG8_WAIT_V(6); PG8_BAR;
    }
    for (;;) {
        const bool has_next = S.next(ui + 1, nxt);
        const char* nA = has_next ? (const char*)g.A + (size_t)nxt.pm * tstep : cA; const char* nB = has_next ? (const char*)g.Bt + (size_t)nxt.pn * tstep : cB;
        for (int t = 0; t < nt; t += 2) {
            const bool last = (t == nt - 2);
            const char* a1 = cA + (size_t)(t + 1) * kstep;
            const char* a2 = last ? nA : cA + (size_t)(t + 2) * kstep; const char* b2 = last ? nB : cB + (size_t)(t + 2) * kstep;
            const char* a3 = a2 + kstep; const char* b3 = b2 + kstep;
            if (last && has_next) S.a_ready(nxt);
            if constexpr (SP2) {
            PG8_LDB(B0, 0, 0); PG8_LDB(B1, 0, 1); PG8_SCHED; PG8_LDA(At, 0, 0); PG8_STAGE(PG8_SA(1, 1), a1 + hstep, voffA);
            PG8_WAIT_V(8); PG8_WAIT_L(0); PG8_BAR; PG8_MMA(0, 0, At, B0); PG8_MMA(0, 1, At, B1); PG8_BAR; PG8_SCHED;
            PG8_LDA(At, 0, 1); PG8_STAGE(PG8_SB(0, 0), b2, voffB); PG8_STAGE(PG8_SB(0, 1), b2 + hstep, voffB); PG8_STAGE(PG8_SA(0, 0), a2, voffA);
            PG8_WAIT_V(8); PG8_WAIT_L(0); PG8_BAR; PG8_MMA(1, 0, At, B0); PG8_MMA(1, 1, At, B1); PG8_BAR; PG8_SCHED;
            PG8_LDB(B0, 1, 0); PG8_LDB(B1, 1, 1); PG8_SCHED; PG8_LDA(At, 1, 0); PG8_STAGE(PG8_SA(0, 1), a2 + hstep, voffA);
            PG8_WAIT_V(8); PG8_WAIT_L(0); PG8_BAR; PG8_MMA(0, 0, At, B0); PG8_MMA(0, 1, At, B1); PG8_BAR; PG8_SCHED;
            PG8_LDA(At, 1, 1); PG8_STAGE(PG8_SB(1, 0), b3, voffB); PG8_STAGE(PG8_SB(1, 1), b3 + hstep, voffB); PG8_STAGE(PG8_SA(1, 0), a3, voffA);
            PG8_WAIT_V(8); PG8_WAIT_L(0); PG8_BAR; PG8_MMA(1, 0, At, B0); PG8_MMA(1, 1, At, B1); PG8_BAR; PG8_SCHED;
            } else {
            PG8_LDB(B0, 0, 0); PG8_SCHED; PG8_LDA(At, 0, 0); PG8_STAGE(PG8_SA(1, 1), a1 + hstep, voffA);
            PG8_WAIT_L(8); PG8_BAR; PG8_WAIT_L(0); PG8_MMA(0, 0, At, B0); PG8_BAR; PG8_SCHED;
            PG8_LDB(B1, 0, 1); PG8_STAGE(PG8_SB(0, 0), b2, voffB);
            PG8_BAR; PG8_WAIT_L(0); PG8_MMA(0, 1, At, B1); PG8_BAR;
            PG8_LDA(At, 0, 1); PG8_STAGE(PG8_SA(0, 0), a2, voffA);
            PG8_BAR; PG8_WAIT_L(0); PG8_MMA(1, 0, At, B0); PG8_BAR; PG8_SCHED;
            PG8_STAGE(PG8_SB(0, 1), b2 + hstep, voffB);
            PG8_WAIT_V(6); PG8_BAR; PG8_MMA(1, 1, At, B1); PG8_BAR;
            PG8_LDB(B0, 1, 0); PG8_SCHED; PG8_LDA(At, 1, 0); PG8_STAGE(PG8_SA(0, 1), a2 + hstep, voffA);
            PG8_WAIT_L(8); PG8_BAR; PG8_WAIT_L(0); PG8_MMA(0, 0, At, B0); PG8_BAR; PG8_SCHED;
            PG8_LDB(B1, 1, 1); PG8_STAGE(PG8_SB(1, 0), b3, voffB);
            PG8_BAR; PG8_WAIT_L(0); PG8_MMA(0, 1, At, B1); PG8_BAR;
            PG8_LDA(At, 1, 1); PG8_STAGE(PG8_SA(1, 0), a3, voffA);
            PG8_BAR; PG8_WAIT_L(0); PG8_MMA(1, 0, At, B0); PG8_BAR; PG8_SCHED;
            PG8_STAGE(PG8_SB(1, 1), b3 + hstep, voffB);
            PG8_WAIT_V(6); PG8_BAR; PG8_MMA(1, 1, At, B1); PG8_BAR;
            }
        }
        if constexpr (ALIGN_EPI) { if (wr == 0) PG8_BAR; }
        if constexpr (!Epi::AFTER_DRAIN) { E(acc, cur, wr, wc, fr, fq); S.done(cur); }
        if (!has_next) break;
#pragma unroll
        for (int a = 0; a < 2; ++a)
#pragma unroll
            for (int b = 0; b < 2; ++b)
#pragma unroll
                for (int m = 0; m < 4; ++m)
#pragma unroll
                    for (int n = 0; n < 2; ++n) acc[a][b][m][n] = (f32x4){0.f, 0.f, 0.f, 0.f};
        cur = nxt; cA = nA; cB = nB; ++ui;
        if constexpr (ALIGN_EPI) { if (wr == 1) PG8_BAR; }
    }
    PG8_WAIT_V(0);
    if constexpr (!ALIGN_EPI) { if (wr == 0) PG8_BAR; }
    PG8_BAR;
    if constexpr (Epi::AFTER_DRAIN) { E.fused(acc, cur, wr, wc, fr, fq, lds, wid, lane); S.done(cur); }
#undef PG8_SA
#undef PG8_SB
#undef PG8_STAGE
#undef PG8_LDA
#undef PG8_LDB
#undef PG8_MMA
#undef PG8_WAIT_V
#undef PG8_WAIT_L
#undef PG8_BAR
#undef PG8_SCHED
}
}
namespace att {
using bf16 = __hip_bfloat16;
constexpr int   D = 128, NW = 8, QBLK = 32, KVBLK = 64;
constexpr float SCALE = 0.088388347648318440f;
constexpr float THR = 8.f;
constexpr int SDEPTH = 1;
constexpr int LDQ = 1024, LDK = 256, LDO = 2048;
constexpr size_t SHM_V = KVBLK * D * 2, SHM_K = KVBLK * D * 2, SHM_ATTN = 2 * SHM_V + 2 * SHM_K + NW * 64 * 4;
using bf16x8 = __attribute__((ext_vector_type(8))) short;
using s16x4  = __attribute__((ext_vector_type(4))) short;
using f32x16 = __attribute__((ext_vector_type(16))) float;
using f32x8  = __attribute__((ext_vector_type(8))) float;
using u32x4  = __attribute__((ext_vector_type(4))) unsigned;
#define KSWZ(row, colB) ((row) * 256 + ((colB) ^ (((row) & 7) << 4)))
#define SBAR() __builtin_amdgcn_sched_barrier(0)
__device__ __forceinline__ int crow(int r, int hi) { return (r & 3) + 8 * (r >> 2) + 4 * hi; }
__device__ __forceinline__ unsigned cvtpk(float lo, float hi) {
  unsigned r; asm volatile("v_cvt_pk_bf16_f32 %0, %1, %2" : "=v"(r) : "v"(lo), "v"(hi)); return r;
}
template <typename TIn> struct Stage;
template <> struct Stage<bf16>  { using T = bf16x8;
  __device__ static __forceinline__ T ld8(const bf16* p) { return *reinterpret_cast<const bf16x8*>(p); }
  __device__ static __forceinline__ bf16x8 tobf(T x) { return x; } };
template <> struct Stage<float> { using T = f32x8;
  __device__ static __forceinline__ T ld8(const float* p) { return *reinterpret_cast<const f32x8*>(p); }
  __device__ static __forceinline__ bf16x8 tobf(T x) {
    u32x4 w = {cvtpk(x[0], x[1]), cvtpk(x[2], x[3]), cvtpk(x[4], x[5]), cvtpk(x[6], x[7])}; return *reinterpret_cast<bf16x8*>(&w); } };

__device__ __forceinline__ void partialSM(f32x16& p0, f32x16& p1, float& m_reg, f32x16& negm, float& alpha) {
  constexpr float THRL = THR * 1.4426950408889634f;
  float pmax = p0[0]; for (int r = 1; r < 16; ++r) pmax = fmaxf(pmax, p0[r]); for (int r = 0; r < 16; ++r) pmax = fmaxf(pmax, p1[r]);
  { auto rr = __builtin_amdgcn_permlane32_swap(__float_as_uint(pmax), __float_as_uint(pmax), false, false);
    pmax = fmaxf(__uint_as_float(rr[0]), __uint_as_float(rr[1])); }
  if (__builtin_expect(__all(pmax <= THRL), 1)) { alpha = 1.f; }
  else { const float dl = fmaxf(pmax, 0.f); m_reg += dl; alpha = __builtin_amdgcn_exp2f(-dl);
    for (int r = 0; r < 16; ++r) { p0[r] -= dl; p1[r] -= dl; }
    for (int r = 0; r < 16; ++r) negm[r] = -m_reg; asm volatile("" : "+v"(negm)); }
  for (int r = 0; r < 16; ++r) p0[r] = __builtin_amdgcn_exp2f(p0[r]);
}
__device__ __forceinline__ void exp_half(f32x16& p0) { for (int r = 0; r < 16; ++r) p0[r] = __builtin_amdgcn_exp2f(p0[r]); }
__device__ __forceinline__ void finishSM(f32x16& p0, f32x16& p1, float alpha, float& l_reg, bf16x8& pa0, bf16x8& pa1, bf16x8& pa2, bf16x8& pa3) {
  for (int r = 0; r < 16; ++r) p1[r] = __builtin_amdgcn_exp2f(p1[r]);
  float ps = 0; for (int r = 0; r < 16; ++r) ps += p0[r]; for (int r = 0; r < 16; ++r) ps += p1[r];
  { auto rr = __builtin_amdgcn_permlane32_swap(__float_as_uint(ps), __float_as_uint(ps), false, false);
    ps = __uint_as_float(rr[0]) + __uint_as_float(rr[1]); }
  l_reg = l_reg * alpha + ps;
#define PK4(P, BASE, OUT) do { unsigned a0 = cvtpk(P[BASE + 0], P[BASE + 1]), a1 = cvtpk(P[BASE + 2], P[BASE + 3]);   \
    unsigned b0 = cvtpk(P[BASE + 4], P[BASE + 5]), b1 = cvtpk(P[BASE + 6], P[BASE + 7]);                              \
      \
    u32x4 w = {a0, a1, b0, b1}; OUT = *reinterpret_cast<bf16x8*>(&w); } while (0)
  PK4(p0, 0, pa0); PK4(p0, 8, pa1); PK4(p1, 0, pa2); PK4(p1, 8, pa3);
#undef PK4
}
__device__ __forceinline__ void qkt(f32x16& p0, f32x16& p1, const bf16* Ks, const bf16x8* qr, int r32, int hi, const f32x16& negm) {
  for (int d0 = 0; d0 < 8; ++d0) { int cb = (d0 * 16 + hi * 8) * 2;
    bf16x8 b0 = *reinterpret_cast<const bf16x8*>((const char*)Ks + KSWZ(r32, cb));
    bf16x8 b1 = *reinterpret_cast<const bf16x8*>((const char*)Ks + KSWZ(32 + r32, cb));
    if (d0 == 0) { p0 = __builtin_amdgcn_mfma_f32_32x32x16_bf16(b0, qr[0], negm, 0, 0, 0); p1 = __builtin_amdgcn_mfma_f32_32x32x16_bf16(b1, qr[0], negm, 0, 0, 0); }
    else { p0 = __builtin_amdgcn_mfma_f32_32x32x16_bf16(b0, qr[d0], p0, 0, 0, 0); p1 = __builtin_amdgcn_mfma_f32_32x32x16_bf16(b1, qr[d0], p1, 0, 0, 0); } }
}
__device__ __forceinline__ int v_st(int k, int c) { const int kk = k;   return ((kk >> 3) * 4 + (c >> 5)) * 512 + ((kk & 7) * 32 + (c & 31)) * 2; }
__device__ __forceinline__ int v_rd_base(int lane) { return ((lane & 3) << 3) | (((lane >> 2) & 3) << 6) | (((lane >> 4) & 1) << 5) | (((lane >> 5) & 1) << 8); }
constexpr int v_rd_off(int d0, int ks, int half) { return d0 * 512 + ks * 4096 + half * 2048; }
template <int OFF> __device__ __forceinline__ s16x4 tr_read(int vb) {
  s16x4 r; asm volatile("ds_read_b64_tr_b16 %0, %1 offset:%2" : "=&v"(r) : "v"(vb), "i"(OFF) : "memory"); return r;
}
template <int D0> __device__ __forceinline__ void pv_one(f32x16& od, int vb, bf16x8 pa0, bf16x8 pa1, bf16x8 pa2, bf16x8 pa3) {
  const s16x4 l0 = tr_read<v_rd_off(D0, 0, 0)>(vb), h0 = tr_read<v_rd_off(D0, 0, 1)>(vb), l1 = tr_read<v_rd_off(D0, 1, 0)>(vb), h1 = tr_read<v_rd_off(D0, 1, 1)>(vb);
  const s16x4 l2 = tr_read<v_rd_off(D0, 2, 0)>(vb), h2 = tr_read<v_rd_off(D0, 2, 1)>(vb), l3 = tr_read<v_rd_off(D0, 3, 0)>(vb), h3 = tr_read<v_rd_off(D0, 3, 1)>(vb);
  asm volatile("s_waitcnt lgkmcnt(0)" ::: "memory"); SBAR();
#define PK(L, H) (bf16x8){L[0], L[1], L[2], L[3], H[0], H[1], H[2], H[3]}
  od = __builtin_amdgcn_mfma_f32_32x32x16_bf16(pa0, PK(l0, h0), od, 0, 0, 0);
  od = __builtin_amdgcn_mfma_f32_32x32x16_bf16(pa1, PK(l1, h1), od, 0, 0, 0);
  od = __builtin_amdgcn_mfma_f32_32x32x16_bf16(pa2, PK(l2, h2), od, 0, 0, 0);
  od = __builtin_amdgcn_mfma_f32_32x32x16_bf16(pa3, PK(l3, h3), od, 0, 0, 0);
#undef PK
}
__device__ __forceinline__ void pv_d0(f32x16* o, int vb, bf16x8 pa0, bf16x8 pa1, bf16x8 pa2, bf16x8 pa3) {
  pv_one<0>(o[0], vb, pa0, pa1, pa2, pa3); pv_one<1>(o[1], vb, pa0, pa1, pa2, pa3); pv_one<2>(o[2], vb, pa0, pa1, pa2, pa3); pv_one<3>(o[3], vb, pa0, pa1, pa2, pa3);
}
template <typename TQ>
__device__ __forceinline__ void attn_dense_body(const TQ* Qb, const bf16* Kh, const bf16* Vh,
                                                bf16* Ob, int seq, char* lds, float negB, const float* wq, const float* rope, int tok0) {
  using St = Stage<bf16>; using SQ = Stage<TQ>;
  int tid_ = threadIdx.x; asm volatile("" : "+v"(tid_)); const int tid = tid_, wid = tid >> 6, lane = tid & 63, r32 = lane & 31, hi = lane >> 5;
  bf16* V_lds = (bf16*)lds; bf16* K_lds = (bf16*)(lds + 2 * SHM_V);
  float* ws = (float*)(lds + 2 * SHM_V + 2 * SHM_K) + wid * 64; float* li_l = ws; float* al_l = ws + 32;
  float l_reg = 0; f32x16 o[4] = {}; bf16x8 qr[8];
  f32x16 negm; for (int r = 0; r < 16; ++r) negm[r] = negB; asm volatile("" : "+v"(negm));
  { const TQ* Qw = Qb + (long)(wid * QBLK + r32) * LDQ + hi * 8;
    f32x8 xr[8]; float ss = 0.f;
#pragma unroll
    for (int d0 = 0; d0 < 8; ++d0) { xr[d0] = *reinterpret_cast<const f32x8*>(Qw + d0 * 16);
#pragma unroll
      for (int e = 0; e < 8; ++e) ss += xr[d0][e] * xr[d0][e]; }
    { auto rr = __builtin_amdgcn_permlane32_swap(__float_as_uint(ss), __float_as_uint(ss), false, false); ss = __uint_as_float(rr[0]) + __uint_as_float(rr[1]); }
    const float rs = rsqrtf(ss * (1.f / 128.f) + 1e-6f) * 0.12751743f;
#pragma unroll
    for (int d0 = 0; d0 < 8; ++d0) { const f32x8 wv = *reinterpret_cast<const f32x8*>(wq + d0 * 16 + hi * 8);
#pragma unroll
      for (int e = 0; e < 8; ++e) xr[d0][e] = xr[d0][e] * rs * wv[e]; }
    if (tok0 >= 0) { const int tok = tok0 + wid * QBLK + r32;
#pragma unroll
      for (int h2 = 0; h2 < 2; ++h2) { const int pos = h2 == 0 ? (tok >> 6) : (tok & 63);
#pragma unroll
        for (int dd = 0; dd < 2; ++dd) { const float* rp = rope + ((size_t)pos * 32 + dd * 16 + hi * 8) * 2;
#pragma unroll
          for (int e = 0; e < 8; ++e) { const float c = rp[2 * e], s = rp[2 * e + 1]; const float a = xr[4 * h2 + dd][e], bq = xr[4 * h2 + dd + 2][e];
            xr[4 * h2 + dd][e] = a * c - bq * s; xr[4 * h2 + dd + 2][e] = bq * c + a * s; } } } }
#pragma unroll
    for (int d0 = 0; d0 < 8; ++d0) qr[d0] = Stage<float>::tobf(xr[d0]); }
  const int sr = tid >> 4, sc = (tid & 15) * 8, vst0 = v_st(sr, sc), vst1 = v_st(32 + sr, sc);
  const int vb0 = (int)(uintptr_t)V_lds + v_rd_base(lane);
  struct { typename St::T vs0, vs1, ks0, ks1; } sr_[SDEPTH];
#define SLOAD(i, k0) do { sr_[i].vs0 = St::ld8(&Vh[(long)((k0) + sr) * LDK + sc]); sr_[i].vs1 = St::ld8(&Vh[(long)((k0) + 32 + sr) * LDK + sc]); \
    sr_[i].ks0 = St::ld8(&Kh[(long)((k0) + sr) * LDK + sc]); sr_[i].ks1 = St::ld8(&Kh[(long)((k0) + 32 + sr) * LDK + sc]); } while (0)
#define SWRITE(b, i) do { *(bf16x8*)((char*)V_lds + (b) * SHM_V + vst0) = St::tobf(sr_[i].vs0);          \
    *(bf16x8*)((char*)V_lds + (b) * SHM_V + vst1) = St::tobf(sr_[i].vs1); int kc = sc * 2;               \
    *(bf16x8*)((char*)K_lds + (b) * SHM_K + KSWZ(sr, kc)) = St::tobf(sr_[i].ks0);                       \
    *(bf16x8*)((char*)K_lds + (b) * SHM_K + KSWZ(32 + sr, kc)) = St::tobf(sr_[i].ks1); } while (0)
#define SWAIT() do { if constexpr (SDEPTH == 2) asm volatile("s_waitcnt vmcnt(4)" ::: "memory"); else asm volatile("s_waitcnt vmcnt(0)" ::: "memory"); } while (0)
#define RESC(a) do { if (__any((a) < 1.f)) { if (hi == 0) al_l[r32] = (a); asm volatile("s_waitcnt lgkmcnt(0)" ::: "memory"); \
    for (int d = 0; d < 4; ++d) for (int r = 0; r < 16; ++r) o[d][r] *= al_l[crow(r, hi)]; } } while (0)
  f32x16 pA0, pA1, pB0, pB1; bf16x8 pa0, pa1, pa2, pa3; const int NT = seq / KVBLK;
  constexpr int SE = 0, SO = SDEPTH - 1;
  SLOAD(SE, 0); asm volatile("s_waitcnt vmcnt(0)" ::: "memory"); SWRITE(0, SE); __syncthreads();
  qkt(pA0, pA1, K_lds, qr, r32, hi, negm); exp_half(pA0);
  SLOAD(SO, KVBLK); if constexpr (SDEPTH == 2) { if (2 < NT) SLOAD(SE, 2 * KVBLK); }
  SWAIT(); SWRITE(1, SO); __syncthreads();
  for (int j = 1; j + 1 < NT; j += 2) {
    SBAR(); qkt(pB0, pB1, (bf16*)((char*)K_lds + SHM_K), qr, r32, hi, negm);
    finishSM(pA0, pA1, 1.f, l_reg, pa0, pa1, pa2, pa3); SBAR();
    SLOAD(SO, (j + SDEPTH) * KVBLK); SBAR();
    pv_d0(o, vb0, pa0, pa1, pa2, pa3); exp_half(pB0);
    __syncthreads(); SWAIT(); SWRITE(0, SE);
    __syncthreads();
    SBAR(); qkt(pA0, pA1, K_lds, qr, r32, hi, negm);
    finishSM(pB0, pB1, 1.f, l_reg, pa0, pa1, pa2, pa3); SBAR();
    if (SDEPTH == 1 || j + 3 < NT) SLOAD(SE, (j + 1 + SDEPTH) * KVBLK); SBAR();
    pv_d0(o, vb0 + (int)SHM_V, pa0, pa1, pa2, pa3); exp_half(pA0);
    __syncthreads(); SWAIT(); SWRITE(1, SO);
    __syncthreads();
  }
  SBAR(); qkt(pB0, pB1, (bf16*)((char*)K_lds + SHM_K), qr, r32, hi, negm);
  finishSM(pA0, pA1, 1.f, l_reg, pa0, pa1, pa2, pa3); SBAR();
  pv_d0(o, vb0, pa0, pa1, pa2, pa3); exp_half(pB0);
  __syncthreads();
  finishSM(pB0, pB1, 1.f, l_reg, pa0, pa1, pa2, pa3); SBAR();
  pv_d0(o, vb0 + (int)SHM_V, pa0, pa1, pa2, pa3);
  if (hi == 0) li_l[r32] = l_reg; asm volatile("s_waitcnt lgkmcnt(0)" ::: "memory");
  float rli[16];
#pragma unroll
  for (int r = 0; r < 16; ++r) rli[r] = __builtin_amdgcn_rcpf(li_l[crow(r, hi)]);
  bf16* Ow = Ob + (long)(wid * QBLK) * LDO;
#pragma unroll
  for (int r = 0; r < 16; ++r) { int orow = crow(r, hi);
    for (int d0 = 0; d0 < 4; ++d0) Ow[(long)orow * LDO + d0 * 32 + r32] = __float2bfloat16(o[d0][r] * rli[r]); }
#undef SLOAD
#undef SWRITE
#undef SWAIT
#undef RESC
}
}

#define LAS __attribute__((address_space(3)))
typedef unsigned short bf16_t;
typedef float f32x4 __attribute__((ext_vector_type(4)));
typedef float f32x2 __attribute__((ext_vector_type(2)));
typedef unsigned u32x4 __attribute__((ext_vector_type(4)));
typedef unsigned u32x2 __attribute__((ext_vector_type(2)));
typedef short bf16x8 __attribute__((ext_vector_type(8)));

constexpr int L = 16384, NCTX = 256, MT = L + NCTX, DM = 2048, INW = 2560, FF = 5632, NCH = 260;
constexpr float EPS = 1e-6f;

constexpr size_t al256(size_t x) { return (x + 255) / 256 * 256; }
constexpr size_t SZ_WIN = (size_t)INW * DM * 2, SZ_WOUT = (size_t)DM * DM * 2, SZ_WGU = (size_t)2 * FF * DM * 2, SZ_WDN = (size_t)DM * FF * 2,
                 SZ_WGLU = 512 * 512 * 2, SZ_WF = 512 * 1024 * 2;
constexpr size_t O_WIN = 0;
constexpr size_t O_WOUT = O_WIN + 2 * SZ_WIN;
constexpr size_t O_WGU = O_WOUT + 2 * SZ_WOUT;
constexpr size_t O_WDN = O_WGU + 2 * SZ_WGU;
constexpr size_t O_WGLU = O_WDN + 2 * SZ_WDN;
constexpr size_t O_WF = O_WGLU + 2 * SZ_WGLU;
constexpr size_t O_MODP = O_WF + 2 * SZ_WF;
constexpr size_t O_MOD = O_MODP + (size_t)16 * 4 * 12288 * 4;
constexpr size_t O_ROPE = O_MOD + (size_t)4 * 12288 * 4;
constexpr size_t O_AB = O_ROPE + 65536;
constexpr size_t O_BB = O_AB + 8192 * 16;
constexpr size_t O_CB = O_BB + (size_t)8192 * 16 * 8;
constexpr size_t O_W1 = O_CB + (size_t)128 * 16 * 128 * 2;
constexpr size_t O_W2 = O_W1 + 65536;
constexpr size_t O_WC = O_W2 + 131072;
constexpr size_t O_TW = O_WC + 262144;
constexpr size_t O_XC = O_TW + 131072;
constexpr size_t SZ_S = (size_t)2 * NCH * 32 * 128 * 4;
constexpr size_t O_S = O_XC + (size_t)NCTX * DM * 4;
constexpr size_t O_HIN = O_S + SZ_S;
constexpr size_t O_BBT = al256(O_HIN + SZ_S);
constexpr size_t O_BAR = O_BBT + (size_t)128 * 128 * 16 * 2;
constexpr size_t O_H = O_BAR + 16384;
constexpr size_t O_Y = O_H + (size_t)MT * DM * 2;
constexpr size_t O_YP = O_Y + (size_t)72 * 1024 * 1024;
constexpr size_t O_OV = O_Y + (size_t)MT * DM * 4;
static_assert((size_t)MT * DM * 2 <= (size_t)72 * 1024 * 1024 && O_YP + (size_t)4 * 256 * DM * 4 <= O_OV, "YP inside the Y region");
constexpr size_t O_QRAW = O_OV;
constexpr size_t O_KRAW = O_QRAW + (size_t)MT * 1024 * 4;
constexpr size_t O_QB = O_KRAW + (size_t)MT * 256 * 4;
constexpr size_t O_KB = O_QB + (size_t)MT * 1024 * 2;
constexpr size_t O_VB = O_KB + (size_t)MT * 256 * 2;
constexpr size_t O_US = O_VB + (size_t)MT * 256 * 2;
constexpr size_t O_UF = O_US + (size_t)MT * 512 * 4;
constexpr size_t O_TB = O_UF + (size_t)MT * 512 * 2;
constexpr size_t O_XF = O_TB + (size_t)2 * 128 * 128 * 512 * 2;
constexpr size_t O_G = O_XF + (size_t)MT * 1024 * 2;
constexpr size_t O_CAT = O_G + (size_t)MT * 512 * 2;
constexpr size_t O_OVEND = O_CAT + (size_t)MT * DM * 2;
constexpr size_t O_HID = O_OV;
constexpr size_t WS_END = (O_OVEND > O_HID + (size_t)MT * FF * 2) ? O_OVEND : O_HID + (size_t)MT * FF * 2;
static_assert(WS_END <= (size_t)768 * 1024 * 1024, "d_ws map exceeds 768 MiB");

constexpr int LDS_BYTES = 147456;

struct Params { const float* in[28]; float* out; unsigned char* ws; };

__device__ __forceinline__ unsigned pk2(float lo, float hi) { typedef __bf16 bf2_t __attribute__((ext_vector_type(2))); f32x2 v = {lo, hi}; bf2_t b = __builtin_convertvector(v, bf2_t); return __builtin_bit_cast(unsigned, b); }
__device__ __forceinline__ bf16_t f2bf(float f) { return (bf16_t)(pk2(f, 0.f) & 0xffffu); }
__device__ __forceinline__ float bf2f(unsigned b) { return __uint_as_float(b << 16); }
__device__ __forceinline__ float wave_sum(float v) {
#pragma unroll
    for (int o = 1; o < 64; o <<= 1) v += __shfl_xor(v, o);
    return v;
}
__device__ __forceinline__ float sigmoidf_(float x) { return 1.0f / (1.0f + __expf(-x)); }
__device__ __forceinline__ float gelu_tanh(float x) { const float u = 0.7978845608028654f * (x + 0.044715f * x * x * x); return x * sigmoidf_(2.f * u); }
#define LDS_WAIT() asm volatile("s_waitcnt lgkmcnt(0)" ::: "memory")

struct EpiIn {
    static constexpr bool PERM = true, AFTER_DRAIN = false;
    float* qraw; float* kraw; bf16_t* vb; float* us; bf16_t* uf;
    __device__ __forceinline__ void operator()(const pg8::f32x4 (&acc)[2][2][4][2], const pg8::Unit& u, int wr, int wc, int fr, int fq) const {
        const int row0 = u.pm * 256 + wr * 64 + fr, cl = wc * 32 + 8 * fq, pn = u.pn;
        float* fbase = nullptr; bf16_t* bbase = nullptr; int ldc = 0;
        if (pn < 4) { fbase = qraw + pn * 256; ldc = 1024; } else if (pn == 4) { fbase = kraw; ldc = 256; } else if (pn == 5) { bbase = vb; ldc = 256; }
        else if (pn < 8) { fbase = us + (pn - 6) * 256; ldc = 512; } else { bbase = uf + (pn - 8) * 256; ldc = 512; }
#pragma unroll
        for (int ai = 0; ai < 2; ++ai)
#pragma unroll
            for (int m = 0; m < 4; ++m) { const size_t ro = (size_t)(row0 + ai * 128 + m * 16) * ldc + cl;
#pragma unroll
                for (int bj = 0; bj < 2; ++bj) { const pg8::f32x4 v0 = acc[ai][bj][m][0], v1 = acc[ai][bj][m][1];
                    if (fbase) { float* p = fbase + ro + bj * 128; *(f32x4*)p = (f32x4){v0[0], v0[1], v0[2], v0[3]}; *(f32x4*)(p + 4) = (f32x4){v1[0], v1[1], v1[2], v1[3]}; }
                    else { u32x4 w; w.x = pk2(v0[0], v0[1]); w.y = pk2(v0[2], v0[3]); w.z = pk2(v1[0], v1[1]); w.w = pk2(v1[2], v1[3]); *(u32x4*)(bbase + ro + bj * 128) = w; } } }
    }
};
struct EpiF32 {
    static constexpr bool PERM = true, AFTER_DRAIN = false;
    bf16_t* O; int ldc;
    __device__ __forceinline__ void operator()(const pg8::f32x4 (&acc)[2][2][4][2], const pg8::Unit& u, int wr, int wc, int fr, int fq) const {
        const int row0 = u.pm * 256 + wr * 64 + fr, col0 = u.pn * 256 + wc * 32 + 8 * fq;
#pragma unroll
        for (int ai = 0; ai < 2; ++ai)
#pragma unroll
            for (int m = 0; m < 4; ++m) { bf16_t* rowp = O + (size_t)(row0 + ai * 128 + m * 16) * ldc + col0;
#pragma unroll
                for (int bj = 0; bj < 2; ++bj) { const pg8::f32x4 v0 = acc[ai][bj][m][0], v1 = acc[ai][bj][m][1];
                    u32x4 w; w.x = pk2(v0[0], v0[1]); w.y = pk2(v0[2], v0[3]); w.z = pk2(v1[0], v1[1]); w.w = pk2(v1[2], v1[3]); *(u32x4*)(rowp + bj * 128) = w; } }
    }
};
struct EpiP32 {
    static constexpr bool PERM = true, AFTER_DRAIN = false;
    float* O; int ldc;
    __device__ __forceinline__ void operator()(const pg8::f32x4 (&acc)[2][2][4][2], const pg8::Unit& u, int wr, int wc, int fr, int fq) const {
        const int row0 = u.pm * 256 + wr * 64 + fr, col0 = u.pn * 256 + wc * 32 + 8 * fq;
#pragma unroll
        for (int ai = 0; ai < 2; ++ai)
#pragma unroll
            for (int m = 0; m < 4; ++m) { float* rowp = O + (size_t)(row0 + ai * 128 + m * 16) * ldc + col0;
#pragma unroll
                for (int bj = 0; bj < 2; ++bj) { const pg8::f32x4 v0 = acc[ai][bj][m][0], v1 = acc[ai][bj][m][1];
                    *(f32x4*)(rowp + bj * 128) = (f32x4){v0[0], v0[1], v0[2], v0[3]}; *(f32x4*)(rowp + bj * 128 + 4) = (f32x4){v1[0], v1[1], v1[2], v1[3]}; } }
    }
};
struct EpiUp {
    static constexpr bool PERM = true, AFTER_DRAIN = false;
    bf16_t* hid;
    __device__ __forceinline__ void operator()(const pg8::f32x4 (&acc)[2][2][4][2], const pg8::Unit& u, int wr, int wc, int fr, int fq) const {
        const int row0 = u.pm * 256 + wr * 64 + fr, col0 = u.pn * 128 + wc * 32 + 8 * fq;
#pragma unroll
        for (int ai = 0; ai < 2; ++ai)
#pragma unroll
            for (int m = 0; m < 4; ++m) { bf16_t* rowp = hid + (size_t)(row0 + ai * 128 + m * 16) * FF + col0;
                float o[8];
#pragma unroll
                for (int n = 0; n < 2; ++n)
#pragma unroll
                    for (int e = 0; e < 4; ++e) { const float g = acc[ai][0][m][n][e], up = acc[ai][1][m][n][e]; o[4 * n + e] = g * sigmoidf_(g) * up; }
                u32x4 w; w.x = pk2(o[0], o[1]); w.y = pk2(o[2], o[3]); w.z = pk2(o[4], o[5]); w.w = pk2(o[6], o[7]); *(u32x4*)rowp = w; }
    }
};
struct EpiMix {
    static constexpr bool PERM = true, AFTER_DRAIN = false;
    bf16_t* cat; const bf16_t* gbuf; const float* bias; int mode;
    __device__ __forceinline__ void operator()(const pg8::f32x4 (&acc)[2][2][4][2], const pg8::Unit& u, int wr, int wc, int fr, int fq) const {
        const int row0 = u.pm * 256 + wr * 64 + fr, col0 = u.pn * 256 + wc * 32 + 8 * fq;
#pragma unroll
        for (int ai = 0; ai < 2; ++ai)
#pragma unroll
            for (int m = 0; m < 4; ++m) { const size_t row = (size_t)(row0 + ai * 128 + m * 16);
#pragma unroll
                for (int bj = 0; bj < 2; ++bj) { const int col = col0 + bj * 128; float o[8];
#pragma unroll
                    for (int n = 0; n < 2; ++n)
#pragma unroll
                        for (int e = 0; e < 4; ++e) o[4 * n + e] = acc[ai][bj][m][n][e];
                    if (mode == 0) { const u32x4 gv = *(const u32x4*)(gbuf + row * 512 + col); const f32x4 b0 = *(const f32x4*)(bias + col), b1 = *(const f32x4*)(bias + col + 4);
                        const unsigned gw_[4] = {gv.x, gv.y, gv.z, gv.w};
#pragma unroll
                        for (int q = 0; q < 4; ++q) { const float g0 = bf2f(gw_[q] & 0xffffu), g1 = bf2f(gw_[q] >> 16);
                            const float z0 = o[2 * q] + (q < 2 ? b0[2 * q] : b1[2 * q - 4]), z1 = o[2 * q + 1] + (q < 2 ? b0[2 * q + 1] : b1[2 * q - 3]);
                            o[2 * q] = g0 * sigmoidf_(z0); o[2 * q + 1] = g1 * sigmoidf_(z1); } }
                    u32x4 w; w.x = pk2(o[0], o[1]); w.y = pk2(o[2], o[3]); w.z = pk2(o[4], o[5]); w.w = pk2(o[6], o[7]);
                    *(u32x4*)(cat + row * 2048 + (mode == 0 ? 1024 : 1536) + col) = w; } }
    }
};

__device__ __forceinline__ void tr_item(const float* W, int K, int N, bf16_t* WT, int mode, LAS float* scr, int item, int lane) {
    const int nblk = N / 64, kb = item / nblk, nb = item - kb * nblk, k0 = 64 * kb, n0 = 64 * nb;
    const int drow0 = (mode == 0) ? n0 : ((n0 >> 7) * 256 + (mode == 2 ? 128 : 0) + (n0 & 127));
    const int c4 = lane & 15, kr = lane >> 4;
    f32x4 v[16];
#pragma unroll
    for (int i = 0; i < 16; ++i) v[i] = *(const f32x4*)(W + (size_t)(k0 + 4 * i + kr) * N + n0 + 4 * c4);
#pragma unroll
    for (int i = 0; i < 16; ++i) { LAS float* d = scr + (4 * i + kr) * 65 + 4 * c4; d[0] = v[i].x; d[1] = v[i].y; d[2] = v[i].z; d[3] = v[i].w; }
    LDS_WAIT(); asm volatile("" ::: "memory");
    const int c = lane & 7;
#pragma unroll
    for (int j = 0; j < 8; ++j) { const int n = (lane >> 3) + 8 * j; const LAS float* sp = scr + (8 * c) * 65 + n;
        u32x4 o; o.x = pk2(sp[0 * 65], sp[1 * 65]); o.y = pk2(sp[2 * 65], sp[3 * 65]); o.z = pk2(sp[4 * 65], sp[5 * 65]); o.w = pk2(sp[6 * 65], sp[7 * 65]);
        *(u32x4*)(WT + (size_t)(drow0 + n) * K + k0 + 8 * c) = o; }
    LDS_WAIT(); asm volatile("" ::: "memory");
}

__device__ __forceinline__ void prenorm_rows(const float* xl, const float* xc, bf16_t* H, const float* g, const float* modl, const float* modc, int sh_off, int sc_off,
                                             int nrows, int gw, int NGW, int lane) {
    f32x4 v[8], vn[8];
    if (gw < nrows) { const float* src = gw < L ? xl + (size_t)gw * DM : xc + (size_t)(gw - L) * DM;
#pragma unroll
        for (int j = 0; j < 8; ++j) v[j] = *(const f32x4*)(src + 4 * lane + 256 * j); }
    for (int row = gw; row < nrows; row += NGW) {
        const int nrow = row + NGW;
        if (nrow < nrows) { const float* src = nrow < L ? xl + (size_t)nrow * DM : xc + (size_t)(nrow - L) * DM;
#pragma unroll
            for (int j = 0; j < 8; ++j) vn[j] = *(const f32x4*)(src + 4 * lane + 256 * j); }
        const float* md = row < L ? modl : modc;
        float ss = 0.f;
#pragma unroll
        for (int j = 0; j < 8; ++j) ss += (v[j].x * v[j].x + v[j].y * v[j].y) + (v[j].z * v[j].z + v[j].w * v[j].w);
        const float rstd = rsqrtf(wave_sum(ss) * (1.f / DM) + EPS);
#pragma unroll
        for (int j = 0; j < 8; ++j) { const int col = 4 * lane + 256 * j;
            const f32x4 g4 = *(const f32x4*)(g + col), s4 = *(const f32x4*)(md + sc_off + col), h4 = *(const f32x4*)(md + sh_off + col);
            const f32x4 o = v[j] * rstd * g4 * (1.f + s4) + h4;
            u32x2 w; w.x = pk2(o.x, o.y); w.y = pk2(o.z, o.w); *(u32x2*)(H + (size_t)row * DM + col) = w; }
#pragma unroll
        for (int j = 0; j < 8; ++j) v[j] = vn[j];
    }
}
template <bool PL> __device__ __forceinline__ void post_rows(const float* xl_src, const float* xc_src, float* xl_dst, float* xc_dst, const bf16_t* Y, const float* wpost, const float* modl, const float* modc, int gate_off,
                                          bool do_next, bf16_t* H, const float* wpre, const float* nmodl, const float* nmodc, int sh_off, int sc_off,
                                          int row0, int nrows, int gw, int NGW, int lane, LAS float* pl, int tid, const float* yp4 = nullptr) {
    if (PL) { const int c = 4 * tid;
        *(LAS f32x4*)(pl + c) = *(const f32x4*)(wpost + c); *(LAS f32x4*)(pl + 2048 + c) = *(const f32x4*)(modl + gate_off + c);
        if (do_next) { *(LAS f32x4*)(pl + 4096 + c) = *(const f32x4*)(wpre + c); *(LAS f32x4*)(pl + 6144 + c) = *(const f32x4*)(nmodl + sc_off + c); *(LAS f32x4*)(pl + 8192 + c) = *(const f32x4*)(nmodl + sh_off + c); }
        __syncthreads(); }
    f32x4 x[8], y[8], xn[8], yn[8];
    gw += row0;
    if (gw < nrows) { const float* src = gw < L ? xl_src + (size_t)gw * DM : xc_src + (size_t)(gw - L) * DM; const bf16_t* yr = Y + (size_t)gw * DM;
#pragma unroll
        for (int j = 0; j < 8; ++j) { { if (yp4) { const float* yq = yp4 + (size_t)(gw - L) * DM + 4 * lane + 256 * j; y[j] = (*(const f32x4*)yq + *(const f32x4*)(yq + 256 * DM)) + (*(const f32x4*)(yq + 2 * 256 * DM) + *(const f32x4*)(yq + 3 * 256 * DM)); }
              else { const u32x2 yw = *(const u32x2*)(yr + 4 * lane + 256 * j); y[j] = (f32x4){bf2f(yw.x & 0xffffu), bf2f(yw.x >> 16), bf2f(yw.y & 0xffffu), bf2f(yw.y >> 16)}; } } x[j] = *(const f32x4*)(src + 4 * lane + 256 * j); } }
    for (int row = gw; row < nrows; row += NGW) {
        const bool lat = row < L;
        const int nrow = row + NGW;
        if (nrow < nrows) { const float* src = nrow < L ? xl_src + (size_t)nrow * DM : xc_src + (size_t)(nrow - L) * DM; const bf16_t* yr = Y + (size_t)nrow * DM;
#pragma unroll
            for (int j = 0; j < 8; ++j) { { if (yp4) { const float* yq = yp4 + (size_t)(nrow - L) * DM + 4 * lane + 256 * j; yn[j] = (*(const f32x4*)yq + *(const f32x4*)(yq + 256 * DM)) + (*(const f32x4*)(yq + 2 * 256 * DM) + *(const f32x4*)(yq + 3 * 256 * DM)); }
                  else { const u32x2 yw = *(const u32x2*)(yr + 4 * lane + 256 * j); yn[j] = (f32x4){bf2f(yw.x & 0xffffu), bf2f(yw.x >> 16), bf2f(yw.y & 0xffffu), bf2f(yw.y >> 16)}; } } xn[j] = *(const f32x4*)(src + 4 * lane + 256 * j); } }
        float* dst = lat ? xl_dst + (size_t)row * DM : xc_dst + (size_t)(row - L) * DM;
        const float* md = lat ? modl : modc;
        float ss = 0.f;
#pragma unroll
        for (int j = 0; j < 8; ++j) ss += (y[j].x * y[j].x + y[j].y * y[j].y) + (y[j].z * y[j].z + y[j].w * y[j].w);
        const float rstd = rsqrtf(wave_sum(ss) * (1.f / DM) + EPS);
        float s2 = 0.f;
#pragma unroll
        for (int j = 0; j < 8; ++j) { const int col = 4 * lane + 256 * j;
            const f32x4 w4 = PL ? *(const LAS f32x4*)(pl + col) : *(const f32x4*)(wpost + col), g4 = PL ? *(const LAS f32x4*)(pl + 2048 + col) : *(const f32x4*)(md + gate_off + col);
            x[j] = x[j] + g4 * (y[j] * rstd * w4);
            *(f32x4*)(dst + col) = x[j];
            s2 += (x[j].x * x[j].x + x[j].y * x[j].y) + (x[j].z * x[j].z + x[j].w * x[j].w); }
        if (do_next) {
            const float* nmd = lat ? nmodl : nmodc;
            const float rstd2 = rsqrtf(wave_sum(s2) * (1.f / DM) + EPS);
#pragma unroll
            for (int j = 0; j < 8; ++j) { const int col = 4 * lane + 256 * j;
                const f32x4 g4 = PL ? *(const LAS f32x4*)(pl + 4096 + col) : *(const f32x4*)(wpre + col), s4 = PL ? *(const LAS f32x4*)(pl + 6144 + col) : *(const f32x4*)(nmd + sc_off + col),
                            h4 = PL ? *(const LAS f32x4*)(pl + 8192 + col) : *(const f32x4*)(nmd + sh_off + col);
                const f32x4 o = x[j] * rstd2 * g4 * (1.f + s4) + h4;
                u32x2 w; w.x = pk2(o.x, o.y); w.y = pk2(o.z, o.w); *(u32x2*)(H + (size_t)row * DM + col) = w; }
        }
#pragma unroll
        for (int j = 0; j < 8; ++j) { x[j] = xn[j]; y[j] = yn[j]; }
    }
}

__device__ __forceinline__ void kq_post(const float* qraw, const float* kraw, bf16_t* qb, bf16_t* kb, const float* qn, const float* kn, const float* rope, int gw, int NGW, int lane) {
    const int j = lane & 31, hsel = lane >> 5;
    const f32x4 wq4 = *(const f32x4*)(qn + 4 * j), wk4 = *(const f32x4*)(kn + 4 * j);
    for (int it0 = gw; it0 < MT; it0 += 9 * NGW) {
        f32x4 v[9]; int rows[9], heads[9]; bool ok[9];
#pragma unroll
        for (int q = 0; q < 9; ++q) { const int it = it0 + q * NGW; ok[q] = it < MT; const int itc = ok[q] ? it : it0;
            const int row = itc, head = 8 + hsel; rows[q] = row; heads[q] = head;
            const float* src = head < 8 ? qraw + (size_t)row * 1024 + head * 128 + 4 * j : kraw + (size_t)row * 256 + (head - 8) * 128 + 4 * j;
            v[q] = *(const f32x4*)src; }
#pragma unroll
        for (int q = 0; q < 9; ++q) { const int row = rows[q], head = heads[q]; f32x4 x = v[q];
            float ss = (x.x * x.x + x.y * x.y) + (x.z * x.z + x.w * x.w);
#pragma unroll
            for (int o = 1; o < 32; o <<= 1) ss += __shfl_xor(ss, o);
            const float rstd = rsqrtf(ss * (1.f / 128.f) + EPS);
            x = x * rstd * wk4;
            f32x4 pt; pt.x = __shfl_xor(x.x, 8); pt.y = __shfl_xor(x.y, 8); pt.z = __shfl_xor(x.z, 8); pt.w = __shfl_xor(x.w, 8);
            if (row < L) {
                const int pos = (j < 16) ? (row >> 6) : (row & 63), fi = (4 * j) & 31;
                const f32x4 t0 = *(const f32x4*)(rope + (pos * 32 + fi) * 2), t1 = *(const f32x4*)(rope + (pos * 32 + fi) * 2 + 4);
                const float sg = (j & 8) ? 1.f : -1.f;
                x.x = x.x * t0.x + sg * pt.x * t0.y; x.y = x.y * t0.z + sg * pt.y * t0.w; x.z = x.z * t1.x + sg * pt.z * t1.y; x.w = x.w * t1.z + sg * pt.w * t1.w;
            }
            bf16_t* dst = head < 8 ? qb + (size_t)row * 1024 + head * 128 + 4 * j : kb + (size_t)row * 256 + (head - 8) * 128 + 4 * j;
            u32x2 o; o.x = pk2(x.x, x.y); o.y = pk2(x.z, x.w); if (ok[q]) *(u32x2*)dst = o; }
    }
}

__device__ __forceinline__ void ssm_stage_u(const float* US, LAS float* us, int k, int g, int lane) {
    const float* src = US + (size_t)(64 * k + lane) * 512 + 16 * g;
#pragma unroll
    for (int q = 0; q < 4; ++q) *(LAS f32x4*)(us + lane * 16 + 4 * q) = *(const f32x4*)(src + 4 * q);
}
__device__ __forceinline__ void ssm_bu_tile(const LAS float* us, LAS float* bu, const bf16x8 (&bfr)[8], int t0, int lane) {
    const int fr = lane & 15, fq = lane >> 4;
    const LAS float* up = us + (2 * (fq & 1)) * 256 + (t0 + fr) * 4;
    const f32x4 ua = *(const LAS f32x4*)up, ub = *(const LAS f32x4*)(up + 256);
    u32x4 aw; aw.x = pk2(ua.x, ua.y); aw.y = pk2(ua.z, ua.w); aw.z = pk2(ub.x, ub.y); aw.w = pk2(ub.z, ub.w);
    if (fq >= 2) aw = (u32x4){0u, 0u, 0u, 0u};
    const bf16x8 af = __builtin_bit_cast(bf16x8, aw);
#pragma unroll
    for (int nt = 0; nt < 8; ++nt) {
        const pg8::f32x4 d = __builtin_amdgcn_mfma_f32_16x16x32_bf16(af, bfr[nt], (pg8::f32x4){0.f, 0.f, 0.f, 0.f}, 0, 0, 0);
#pragma unroll
        for (int e = 0; e < 4; ++e) bu[(4 * fq + e) * 132 + 16 * nt + fr] = d[e];
    }
}
__device__ __forceinline__ void ssm_load_bfr(const bf16_t* BBT, bf16x8 (&bfr)[8], int ldg, int lane) {
    const int fr = lane & 15, fq = lane >> 4;
#pragma unroll
    for (int nt = 0; nt < 8; ++nt) { u32x4 w = *(const u32x4*)(BBT + ((size_t)ldg * 128 + 16 * nt + fr) * 16 + 8 * (fq & 1)); if (fq >= 2) w = (u32x4){0u, 0u, 0u, 0u}; bfr[nt] = __builtin_bit_cast(bf16x8, w); }
}
template <int DIR, bool WR> __device__ __forceinline__ void ssm_rec16(float ar, float ai, f32x2& hh, const LAS float* bu, LAS unsigned* st, int lane) {
    f32x2 b[16];
#pragma unroll
    for (int tt = 0; tt < 16; ++tt) { const int t = DIR == 0 ? tt : 15 - tt; b[tt] = (f32x2){bu[t * 132 + lane], bu[t * 132 + 64 + lane]}; }
#pragma unroll
    for (int tt = 0; tt < 16; ++tt) { const int t = DIR == 0 ? tt : 15 - tt;
        const f32x2 hs_ = {-hh.y, hh.x}; hh = b[tt] + (hh * ar + hs_ * ai);
        if (WR) st[t * 68 + lane] = pk2(hh.x, hh.y); }
}
__device__ __forceinline__ void ssm_dma_u(const float* US, LAS float* us, int k, int g, int lane) {
    const float* src = US + (size_t)(64 * k + lane) * 512 + 16 * g;
#pragma unroll
    for (int q = 0; q < 4; ++q) __builtin_amdgcn_global_load_lds((const unsigned*)(src + 4 * q), (LAS unsigned*)(us + q * 256), 16, 0, 0);
}
typedef float f32x16_t __attribute__((ext_vector_type(16)));
__device__ __forceinline__ void ssm_load_bf4(const bf16_t* BBT, bf16x8 (&bf4)[4], int ldg, int lane) {
    const int r32 = lane & 31, hi = lane >> 5;
#pragma unroll
    for (int n = 0; n < 4; ++n) bf4[n] = *(const bf16x8*)(BBT + ((size_t)ldg * 128 + 32 * n + r32) * 16 + 8 * hi);
}
#define SSM_SWAP32(a, b) { auto rr_ = __builtin_amdgcn_permlane32_swap(__float_as_uint(a), __float_as_uint(b), false, false); a = __uint_as_float(rr_[0]); b = __uint_as_float(rr_[1]); }
template <int DIR, bool WR> __device__ __forceinline__ void ssm_tile32(const LAS float* us, const bf16x8 (&bf4)[4], float ar, float ai, f32x2& hh, LAS unsigned* st, int t0, int lane) {
    const int r32 = lane & 31, hi = lane >> 5;
    const LAS float* up = us + (2 * hi) * 256 + (t0 + r32) * 4;
    const f32x4 ua = *(const LAS f32x4*)up, ub = *(const LAS f32x4*)(up + 256);
    u32x4 aw; aw.x = pk2(ua.x, ua.y); aw.y = pk2(ua.z, ua.w); aw.z = pk2(ub.x, ub.y); aw.w = pk2(ub.z, ub.w);
    const bf16x8 af = __builtin_bit_cast(bf16x8, aw);
    const f32x16_t z = {0.f, 0.f, 0.f, 0.f, 0.f, 0.f, 0.f, 0.f, 0.f, 0.f, 0.f, 0.f, 0.f, 0.f, 0.f, 0.f};
    f32x16_t dre0 = __builtin_amdgcn_mfma_f32_32x32x16_bf16(af, bf4[0], z, 0, 0, 0), dre1 = __builtin_amdgcn_mfma_f32_32x32x16_bf16(af, bf4[1], z, 0, 0, 0);
    f32x16_t dim0 = __builtin_amdgcn_mfma_f32_32x32x16_bf16(af, bf4[2], z, 0, 0, 0), dim1 = __builtin_amdgcn_mfma_f32_32x32x16_bf16(af, bf4[3], z, 0, 0, 0);
#pragma unroll
    for (int r = 0; r < 16; ++r) { SSM_SWAP32(dre0[r], dre1[r]) SSM_SWAP32(dim0[r], dim1[r]) }
#pragma unroll
    for (int tt = 0; tt < 32; ++tt) { const int t = DIR == 0 ? tt : 31 - tt; const int ri = 4 * (t >> 3) + (t & 3);
        const f32x2 b = ((t >> 2) & 1) ? (f32x2){dre1[ri], dim1[ri]} : (f32x2){dre0[ri], dim0[ri]};
        const f32x2 hs_ = {-hh.y, hh.x}; hh = b + (hh * ar + hs_ * ai);
        if (WR) st[t * 68 + lane] = pk2(hh.x, hh.y); }
}
template <int DIR> __device__ __forceinline__ void ssm_s1_run(float ar, float ai, const bf16x8 (&bf4)[4], const LAS float* us, float* o, int lane) {
    f32x2 hh = {0.f, 0.f};
    if (DIR == 0) { ssm_tile32<0, false>(us, bf4, ar, ai, hh, nullptr, 0, lane); ssm_tile32<0, false>(us, bf4, ar, ai, hh, nullptr, 32, lane); }
    else          { ssm_tile32<1, false>(us, bf4, ar, ai, hh, nullptr, 32, lane); ssm_tile32<1, false>(us, bf4, ar, ai, hh, nullptr, 0, lane); }
    o[lane] = hh.x; o[64 + lane] = hh.y;
}
template <int DIR, int T> __device__ __forceinline__ void ssm_s3_tile(float ar, float ai, const bf16x8 (&bf4)[4], const bf16x8 (&cb)[4], f32x2& hh, const LAS float* us, LAS unsigned* st, pg8::f32x4 (&yacc)[4], int lane) {
    const int fr = lane & 15, fq = lane >> 4;
    ssm_tile32<DIR, true>(us, bf4, ar, ai, hh, st, 32 * T, lane);
#pragma unroll
    for (int mt = 0; mt < 2; ++mt)
#pragma unroll
        for (int ks = 0; ks < 4; ++ks) { const bf16x8 a0 = *(const LAS bf16x8*)((const LAS unsigned char*)st + (16 * mt + fr) * 272 + (32 * ks + 8 * fq) * 2);
            yacc[2 * T + mt] = __builtin_amdgcn_mfma_f32_16x16x32_bf16(cb[ks], a0, yacc[2 * T + mt], 0, 0, 0); }
}
template <int DIR> __device__ __forceinline__ void ssm_s3_run(float ar, float ai, const bf16x8 (&bf4)[4], const bf16x8 (&cb)[4], f32x2 hh, const LAS float* us, LAS unsigned* st, pg8::f32x4 (&yacc)[4], int lane) {
    if (DIR == 0) { ssm_s3_tile<0, 0>(ar, ai, bf4, cb, hh, us, st, yacc, lane); ssm_s3_tile<0, 1>(ar, ai, bf4, cb, hh, us, st, yacc, lane); }
    else          { ssm_s3_tile<1, 1>(ar, ai, bf4, cb, hh, us, st, yacc, lane); ssm_s3_tile<1, 0>(ar, ai, bf4, cb, hh, us, st, yacc, lane); }
}
__device__ __forceinline__ void cmul_add(float& dr, float& di, float ar, float ai, float br, float bi, float cr, float ci) { dr = ar * br - ai * bi + cr; di = ar * bi + ai * br + ci; }
__device__ __forceinline__ void ssm_s2_task(const f32x4* AB, const float* S, float* HIN, int layer, int task, int lane) {
    const int p = task & 63, g = (task >> 6) & 31, dir = task >> 11;
    const f32x4 ab = AB[((layer * 2 + dir) * 32 + g) * 64 + p]; const float ar = ab.z, ai = ab.w;
    const size_t dbase = (size_t)dir * NCH * 32 * 128 + (size_t)g * 128 + p;
#define CH_OF(q) (dir == 0 ? (((q) + 256) % NCH) : (NCH - 1 - (q)))
    float h4r = 0.f, h4i = 0.f;
    for (int q = 0; q < 4; ++q) { const size_t o = dbase + (size_t)CH_OF(q) * 4096; if (lane == 0) { HIN[o] = h4r; HIN[o + 64] = h4i; }
        const float sr = S[o], si = S[o + 64]; float nr, ni; cmul_add(nr, ni, ar, ai, h4r, h4i, sr, si); h4r = nr; h4i = ni; }
    float sr[4], si[4];
#pragma unroll
    for (int i = 0; i < 4; ++i) { const size_t o = dbase + (size_t)CH_OF(4 + 4 * lane + i) * 4096; sr[i] = S[o]; si[i] = S[o + 64]; }
    float er = sr[0], ei = si[0];
#pragma unroll
    for (int i = 1; i < 4; ++i) { float nr, ni; cmul_add(nr, ni, ar, ai, er, ei, sr[i], si[i]); er = nr; ei = ni; }
    float mr, mi; { const float a2r = ar * ar - ai * ai, a2i = 2.f * ar * ai; mr = a2r * a2r - a2i * a2i; mi = 2.f * a2r * a2i; }
#pragma unroll
    for (int d = 1; d < 64; d <<= 1) {
        const float pr = __shfl_up(er, d), pi = __shfl_up(ei, d), qr = __shfl_up(mr, d), qi = __shfl_up(mi, d);
        if (lane >= d) { float nr, ni; cmul_add(nr, ni, mr, mi, pr, pi, er, ei); er = nr; ei = ni; const float tr = mr * qr - mi * qi, ti = mr * qi + mi * qr; mr = tr; mi = ti; }
    }
    float outr, outi; cmul_add(outr, outi, mr, mi, h4r, h4i, er, ei);
    float inr = __shfl_up(outr, 1), ini = __shfl_up(outi, 1);
    if (lane == 0) { inr = h4r; ini = h4i; }
#pragma unroll
    for (int i = 0; i < 4; ++i) { const size_t o = dbase + (size_t)CH_OF(4 + 4 * lane + i) * 4096; HIN[o] = inr; HIN[o + 64] = ini; float nr, ni; cmul_add(nr, ni, ar, ai, inr, ini, sr[i], si[i]); inr = nr; ini = ni; }
#undef CH_OF
}

#define MFMA16(a, b, c) __builtin_amdgcn_mfma_f32_16x16x32_bf16(a, b, c, 0, 0, 0)
__device__ __forceinline__ void fft1_task(const bf16_t* UF, bf16_t* TB, const f32x2* TW, const LAS unsigned char* w1, int task, int lane) {
    const int fr = lane & 15, fq = lane >> 4, n2 = task >> 5, cb = task & 31;
    bf16x8 xb[4];
#pragma unroll
    for (int ks = 0; ks < 4; ++ks)
#pragma unroll
        for (int i = 0; i < 8; ++i) xb[ks][i] = (short)UF[(size_t)(128 * (32 * ks + 8 * fq + i) + n2) * 512 + 16 * cb + fr];
    f32x2 twc = TW[fr * 128 + n2];
    bf16_t* tbp = TB + ((size_t)fr * 128 + n2) * 512 + 16 * cb + 4 * fq;
#pragma unroll 1
    for (int mt = 0; mt < 8; ++mt) {
        const int mn = mt < 7 ? mt + 1 : mt; const f32x2 twn = TW[(16 * mn + fr) * 128 + n2];
        pg8::f32x4 accr = {0.f, 0.f, 0.f, 0.f}, acci = {0.f, 0.f, 0.f, 0.f};
#pragma unroll
        for (int ks = 0; ks < 4; ++ks) {
            const bf16x8 wre = *(const LAS bf16x8*)(w1 + (16 * mt + fr) * 272 + (32 * ks + 8 * fq) * 2);
            const bf16x8 wim = *(const LAS bf16x8*)(w1 + (128 + 16 * mt + fr) * 272 + (32 * ks + 8 * fq) * 2);
            accr = MFMA16(xb[ks], wre, accr); acci = MFMA16(xb[ks], wim, acci);
        }
        float tr[4], ti[4];
#pragma unroll
        for (int e = 0; e < 4; ++e) { tr[e] = accr[e] * twc.x + acci[e] * twc.y; ti[e] = acci[e] * twc.x - accr[e] * twc.y; }
        u32x2 wr_; wr_.x = pk2(tr[0], tr[1]); wr_.y = pk2(tr[2], tr[3]); u32x2 wi_; wi_.x = pk2(ti[0], ti[1]); wi_.y = pk2(ti[2], ti[3]);
        *(u32x2*)tbp = wr_; *(u32x2*)(tbp + (size_t)128 * 65536) = wi_;
        tbp += (size_t)16 * 65536;
        twc = twn;
    }
}
__device__ __forceinline__ void fft2_task(const bf16_t* TB, bf16_t* XF, const LAS unsigned char* w2, int task, int lane) {
    const int fr = lane & 15, fq = lane >> 4, k1 = task >> 5, cb = task & 31, c = 16 * cb + fr, hh = cb >> 3, cc4 = (16 * cb & 127) + 4 * fq;
    bf16x8 tb[8];
#pragma unroll
    for (int ks = 0; ks < 8; ++ks)
#pragma unroll
        for (int i = 0; i < 8; ++i) { const int kk = 32 * ks + 8 * fq + i; tb[ks][i] = (short)TB[((size_t)((kk >> 7) * 128 + k1) * 128 + (kk & 127)) * 512 + c]; }
    for (int mt = 0; mt < 16; ++mt) {
        pg8::f32x4 acc = {0.f, 0.f, 0.f, 0.f};
#pragma unroll
        for (int ks = 0; ks < 8; ++ks) { const bf16x8 w = *(const LAS bf16x8*)(w2 + (16 * mt + fr) * 528 + (32 * ks + 8 * fq) * 2); acc = MFMA16(tb[ks], w, acc); }
        const int r = 16 * mt + fr, po = r >> 7, k2 = r & 127;
        u32x2 o; o.x = pk2(acc[0], acc[1]); o.y = pk2(acc[2], acc[3]);
        *(u32x2*)(XF + (size_t)(k1 + 128 * k2) * 1024 + hh * 256 + po * 128 + cc4) = o;
    }
}
__device__ __forceinline__ void fftc_task(const bf16_t* UF, bf16_t* XF, const bf16_t* WC, int task, int lane) {
    const int fr = lane & 15, fq = lane >> 4, cb = task & 31, mtg = task >> 5, c = 16 * cb + fr, hh = cb >> 3, cc4 = (16 * cb & 127) + 4 * fq;
    bf16x8 xb[8];
#pragma unroll
    for (int ks = 0; ks < 8; ++ks)
#pragma unroll
        for (int i = 0; i < 8; ++i) xb[ks][i] = (short)UF[(size_t)(L + 32 * ks + 8 * fq + i) * 512 + c];
    for (int mt = 8 * mtg; mt < 8 * mtg + 8; ++mt) {
        pg8::f32x4 acc = {0.f, 0.f, 0.f, 0.f};
#pragma unroll
        for (int ks = 0; ks < 8; ++ks) { const bf16x8 w = *(const bf16x8*)(WC + (size_t)(16 * mt + fr) * 256 + 32 * ks + 8 * fq); acc = MFMA16(xb[ks], w, acc); }
        const int r = 16 * mt + fr, po = r >> 8, kk = r & 255;
        u32x2 o; o.x = pk2(acc[0], acc[1]); o.y = pk2(acc[2], acc[3]);
        *(u32x2*)(XF + (size_t)(L + kk) * 1024 + hh * 256 + po * 128 + cc4) = o;
    }
}

#define XB_TMO      128
#define XB_XCNT(j)  (256  + 64 * (j))
#define XB_XSUB(j)  (1280 + 64 * (j))
#define XB_XGEN(j)  (2304 + 64 * (j))
#define XB_TOP      3328
#define XB_TOPGEN   3392
#define XCD_BAR_WORDS 3456
#define XB_SPIN_CAP (1u << 18)

__device__ __forceinline__ unsigned xb_ld(unsigned* p)              { return __hip_atomic_load(p, __ATOMIC_RELAXED, __HIP_MEMORY_SCOPE_AGENT); }
__device__ __forceinline__ unsigned xb_add(unsigned* p, unsigned v) { return __hip_atomic_fetch_add(p, v, __ATOMIC_RELAXED, __HIP_MEMORY_SCOPE_AGENT); }
__device__ __forceinline__ unsigned xb_xcc_id() { return (unsigned)__builtin_amdgcn_s_getreg((3 << 11) | 20) & 0xFu; }
#define XB_SPIN(cond, bar) do { unsigned _sp = 0; while (cond) { __builtin_amdgcn_s_sleep(1); \
    if ((++_sp & 255u) == 0u) { if (xb_ld(&(bar)[XB_TMO])) break; if (_sp > XB_SPIN_CAP) { atomicAdd(&(bar)[XB_TMO], 1u); break; } } } } while (0)

struct XcdBarrier {
    unsigned* bar; unsigned x;
    volatile LAS unsigned* st;
};

__device__ __forceinline__ XcdBarrier xcd_barrier_post(unsigned* bar, volatile LAS unsigned* st) {
    XcdBarrier b; b.bar = bar; b.x = xb_xcc_id(); b.st = st;
    if (threadIdx.x == 0) (void)xb_add(&bar[XB_XCNT(b.x)], 1u);
    return b;
}
__device__ __forceinline__ void xcd_barrier_complete(unsigned* bar, unsigned x, unsigned& nloc, unsigned& nx) {
    const unsigned G = gridDim.x * gridDim.y * gridDim.z;
    unsigned sum, cnt, mine, sp = 0u;
    for (;;) {
        sum = 0u; cnt = 0u; mine = 0u;
#pragma unroll
        for (unsigned j = 0; j < 16; ++j) { const unsigned c = xb_ld(&bar[XB_XCNT(j)]); sum += c; cnt += (c > 0u) ? 1u : 0u; mine = (j == x) ? c : mine; }
        if (sum == G) break;
        __builtin_amdgcn_s_sleep(1);
        if ((++sp & 255u) == 0u) { if (xb_ld(&bar[XB_TMO])) break; if (sp > XB_SPIN_CAP) { atomicAdd(&bar[XB_TMO], 1u); break; } }
    }
    nloc = mine > 0u ? mine : 1u; nx = cnt > 0u ? cnt : 1u;
}

__device__ __forceinline__ void xcd_barrier(const XcdBarrier& b) {
    asm volatile("s_waitcnt vmcnt(0)" ::: "memory");
    __syncthreads();
    if (threadIdx.x == 0) {
        unsigned* bar = b.bar;
        __builtin_amdgcn_s_waitcnt(0);
        unsigned nloc = b.st[0], nx = b.st[1];
        if (nloc == 0u) { xcd_barrier_complete(bar, b.x, nloc, nx); b.st[0] = nloc; b.st[1] = nx; }
        const unsigned old = xb_add(&bar[XB_XSUB(b.x)], 1u);
        const unsigned gen = old / nloc;
        if (old + 1u == (gen + 1u) * nloc) {
            __builtin_amdgcn_fence(__ATOMIC_RELEASE, "agent");
            asm volatile("s_waitcnt vmcnt(0)" ::: "memory");
            const unsigned og = xb_add(&bar[XB_TOP], 1u);
            const unsigned tg = og / nx;
            if (og + 1u == (tg + 1u) * nx) xb_add(&bar[XB_TOPGEN], 1u);
            else XB_SPIN(xb_ld(&bar[XB_TOPGEN]) == tg, bar);
            __builtin_amdgcn_fence(__ATOMIC_ACQUIRE, "agent");
            xb_add(&bar[XB_XGEN(b.x)], 1u);
            asm volatile("s_waitcnt vmcnt(0)" ::: "memory");
        } else {
            XB_SPIN(xb_ld(&bar[XB_XGEN(b.x)]) == gen, bar);
            __builtin_amdgcn_fence(__ATOMIC_ACQUIRE, "agent");
            asm volatile("s_waitcnt vmcnt(0)" ::: "memory");
        }
    }
    __syncthreads();
}

constexpr int TAB_OFF = LDS_BYTES - 256;
__device__ __forceinline__ const void* tabptr(LAS unsigned char* lds, int i) {
    const LAS unsigned* t = (const LAS unsigned*)(lds + TAB_OFF) + 2 * i;
    const unsigned lo = __builtin_amdgcn_readfirstlane(t[0]), hi = __builtin_amdgcn_readfirstlane(t[1]);
    return (const void*)(((unsigned long long)hi << 32) | lo);
}
#define INP(i) ((const float*)tabptr(lds, (i)))
#define PH_IDS \
    int tid = threadIdx.x; asm volatile("" : "+v"(tid)); const int lane = tid & 63, wave = __builtin_amdgcn_readfirstlane(tid >> 6); \
    int bx = blockIdx.x, G = gridDim.x; asm volatile("" : "+s"(bx), "+s"(G)); \
    const int gw = bx * 8 + wave, NGW = G * 8, gt = bx * 512 + tid, NTH = G * 512; (void)lane; (void)gw; (void)NGW; (void)gt; (void)NTH; \
    unsigned char* ws = (unsigned char*)tabptr(lds, 29); (void)ws;
#define WSP(T, off) ((T*)(ws + (off)))
__device__ __forceinline__ void conv_item(LAS unsigned char* lds, unsigned char* ws, int it, LAS float* scr, int lane) {
    const int layer = it / 10816; int r = it - layer * 10816;
    if (r < 1280) { tr_item(INP(10) + (size_t)layer * DM * INW, DM, INW, WSP(bf16_t, O_WIN) + (size_t)layer * INW * DM, 0, scr, r, lane); return; } r -= 1280;
    if (r < 1024) { tr_item(INP(24) + (size_t)layer * DM * DM, DM, DM, WSP(bf16_t, O_WOUT) + (size_t)layer * DM * DM, 0, scr, r, lane); return; } r -= 1024;
    if (r < 2816) { tr_item(INP(25) + (size_t)layer * DM * FF, DM, FF, WSP(bf16_t, O_WGU) + (size_t)layer * 2 * FF * DM, 1, scr, r, lane); return; } r -= 2816;
    if (r < 2816) { tr_item(INP(26) + (size_t)layer * DM * FF, DM, FF, WSP(bf16_t, O_WGU) + (size_t)layer * 2 * FF * DM, 2, scr, r, lane); return; } r -= 2816;
    if (r < 2816) { tr_item(INP(27) + (size_t)layer * FF * DM, FF, DM, WSP(bf16_t, O_WDN) + (size_t)layer * DM * FF, 0, scr, r, lane); return; } r -= 2816;
    tr_item(INP(21) + (size_t)layer * 512 * 512, 512, 512, WSP(bf16_t, O_WGLU) + (size_t)layer * 512 * 512, 0, scr, r, lane);
}
constexpr int CONV_P0 = 6552;
constexpr int CONV_B = 6616;
constexpr int CONV_A = 4200;

#define GSYNC() do { XcdBarrier b_; b_.bar = (unsigned*)((unsigned char*)tabptr(lds, 29) + O_BAR); b_.x = xb_xcc_id(); b_.st = (volatile LAS unsigned*)(lds + TAB_OFF - 16); xcd_barrier(b_); } while (0)

#ifndef PROBE_CAT
#define PROBE_CAT 0
#endif
#if PROBE_CAT
#define PB(cat) do { if (PROBE_CAT == (cat)) t_st = __builtin_amdgcn_s_memrealtime(); } while (0)
#define PE(cat) do { if (PROBE_CAT == (cat)) t_acc += __builtin_amdgcn_s_memrealtime() - t_st; } while (0)
#else
#define PB(cat) do {} while (0)
#define PE(cat) do {} while (0)
#endif
__global__ void __launch_bounds__(512, 2) hybrid_fwd(Params P) {
    extern __shared__ __attribute__((aligned(16))) unsigned char lds_raw[];
    cg::grid_group grid = cg::this_grid();
#if PROBE_CAT
    unsigned long long t_acc = 0, t_st = 0;
#endif
    LAS unsigned char* lds = (LAS unsigned char*)lds_raw;
    if (threadIdx.x == 0) {
        LAS unsigned long long* t = (LAS unsigned long long*)(lds + TAB_OFF);
#pragma unroll
        for (int i = 0; i < 28; ++i) t[i] = (unsigned long long)P.in[i];
        t[28] = (unsigned long long)P.out; t[29] = (unsigned long long)P.ws;
        LAS unsigned* xst = (LAS unsigned*)(lds + TAB_OFF - 16); xst[0] = 0u; xst[1] = 0u;
        (void)xb_add((unsigned*)(P.ws + O_BAR) + XB_XCNT(xb_xcc_id()), 1u);
    }
    __syncthreads();

    PB(5);
    {
        PH_IDS
        LAS float* sl = (LAS float*)lds;
        LAS float* ct = (LAS float*)(lds + 16384);
        { const float* cin = INP(1); const float* cctx = INP(3);
          for (int i = tid; i < 2048; i += 512) { const float a = cin[i], b = cctx[i]; sl[i] = a / (1.f + expf(-a)); sl[2048 + i] = b / (1.f + expf(-b)); } }
        if (tid < 128) ct[tid] = cospif((float)tid * (1.f / 64.f));
        __syncthreads();
        { const float* adaw = INP(4); float* MODP = WSP(float, O_MODP);
          for (int it = gt; it < 98304; it += NTH) {
            const int kc = it / 6144, r = it - kc * 6144, layer = r / 3072, c4 = r - layer * 3072;
            const float* w = adaw + ((size_t)layer * 2048 + kc * 128) * 12288 + 4 * c4;
            f32x4 a0 = {0.f, 0.f, 0.f, 0.f}, a1 = {0.f, 0.f, 0.f, 0.f};
#pragma unroll 8
            for (int k = 0; k < 128; ++k) { const f32x4 wv = *(const f32x4*)(w + (size_t)k * 12288); const float s0 = sl[kc * 128 + k], s1 = sl[2048 + kc * 128 + k]; a0 += wv * s0; a1 += wv * s1; }
            float* o = MODP + ((size_t)(kc * 2 + layer) * 2) * 12288 + 4 * c4;
            *(f32x4*)o = a0; *(f32x4*)(o + 12288) = a1;
          } }
        { float* ROPE = WSP(float, O_ROPE);
          for (int it = gt; it < 8192; it += NTH) { const int pos = it >> 5, i = it & 31; const float freq = powf(10000.f, -(float)i * (1.f / 32.f)); const float ang = (float)pos * freq;
            const double a = (double)ang, kq = rint(a * 0.15915494309189535), rr = a - kq * 6.283185307179586; const float rf = (float)rr; ROPE[2 * it] = cosf(rf); ROPE[2 * it + 1] = sinf(rf); } }
        { const float* lamre = INP(13); const float* lamim = INP(14); const float* logdt = INP(15); const float* bre = INP(16); const float* bim = INP(17); const float* cre = INP(18); const float* cim = INP(19);
          f32x4* AB = WSP(f32x4, O_AB); unsigned* BBT32 = WSP(unsigned, O_BBT); unsigned* CB32 = WSP(unsigned, O_CB);
          for (int it = gt; it < 8192; it += NTH) {
            const int p = it & 63;
            const float lr = lamre[it], li = lamim[it], ldt = logdt[it >> 6];
            const float dt = expf(ldt), mag = expf(lr * dt), th = li * dt;
            const float ar = mag * cosf(th), ai = mag * sinf(th);
            const float den = lr * lr + li * li, cr = ((ar - 1.f) * lr + ai * li) / den, ci = (ai * lr - (ar - 1.f) * li) / den;
            float pr = ar, pi = ai;
#pragma unroll
            for (int s = 0; s < 6; ++s) { const float nr = pr * pr - pi * pi, ni = 2.f * pr * pi; pr = nr; pi = ni; }
            AB[it] = (f32x4){ar, ai, pr, pi};
#pragma unroll
            for (int h = 0; h < 16; h += 2) { const float br0 = bre[(size_t)it * 16 + h], bi0 = bim[(size_t)it * 16 + h], br1 = bre[(size_t)it * 16 + h + 1], bi1 = bim[(size_t)it * 16 + h + 1];
                BBT32[((size_t)(it >> 6) * 128 + p) * 8 + (h >> 1)] = pk2(cr * br0 - ci * bi0, cr * br1 - ci * bi1);
                BBT32[((size_t)(it >> 6) * 128 + 64 + p) * 8 + (h >> 1)] = pk2(cr * bi0 + ci * br0, cr * bi1 + ci * br1); }
#pragma unroll
            for (int h = 0; h < 16; ++h) { const size_t ci_ = ((size_t)(it >> 6) * 16 + h) * 64 + p; CB32[ci_] = pk2(cre[ci_], -cim[ci_]); }
          } }
        { bf16_t* W1 = WSP(bf16_t, O_W1); bf16_t* W2 = WSP(bf16_t, O_W2); bf16_t* WC = WSP(bf16_t, O_WC); f32x2* TW = WSP(f32x2, O_TW);
          for (int it = gt; it < 32768; it += NTH) { const int r = it >> 7, n1 = it & 127, m = ((r & 127) * n1) & 127; const float x = (float)m * (1.f / 64.f); W1[it] = f2bf(r < 128 ? cospif(x) : -sinpif(x)); }
          for (int it = gt; it < 65536; it += NTH) { const int r = it >> 8, kk = it & 255, po = r >> 7, k2 = r & 127, pi_ = kk >> 7, n2 = kk & 127, m = (k2 * n2) & 127; const float x = (float)m * (1.f / 64.f);
            const float cv = cospif(x), sv = sinpif(x); W2[it] = f2bf(po == pi_ ? cv : (po == 0 ? sv : -sv)); }
          for (int it = gt; it < 131072; it += NTH) { const int r = it >> 8, n = it & 255, part = r >> 8, k = r & 255, m = (k * n) & 255; const float x = (float)m * (1.f / 128.f); WC[it] = f2bf(8.f * (part == 0 ? cospif(x) : -sinpif(x))); }
          for (int it = gt; it < 16384; it += NTH) { const int k1 = it >> 7, n2 = it & 127; const float x = (float)(k1 * n2) * (1.f / 8192.f); TW[it] = (f32x2){cospif(x), sinpif(x)}; } }
        { const float* fwp = INP(23); bf16_t* WF = WSP(bf16_t, O_WF);
          for (int it = gt; it < 2 * 524288; it += NTH) { const int layer = it >> 19, r = it & 524287, n = r & 511, kk = r >> 9, hh = kk >> 8, part = (kk >> 7) & 1, c = kk & 127;
            const float* fw = fwp + (size_t)layer * 262144 + (size_t)(hh * 128) * 512 + n; float acc = 0.f;
            for (int j = 0; j < 128; ++j) { const int m = (c * j) & 127; const float t = part ? ct[(m + 96) & 127] : ct[m]; acc += t * fw[(size_t)j * 512]; }
            WF[(size_t)layer * 524288 + (size_t)n * 1024 + kk] = f2bf(acc * 6.9053396600248786e-4f); } }
        __syncthreads();
        { LAS float* scr = (LAS float*)(lds + wave * 16640);
          if (G == 256) { for (int it = gw; it < CONV_P0 + 64; it += NGW) conv_item(lds, ws, it < CONV_P0 ? it : 10752 + (it - CONV_P0), scr, lane); }
          else { for (int it = gw; it < 2 * 10816; it += NGW) conv_item(lds, ws, it, scr, lane); } }
    }
    grid.sync();
    {
        PH_IDS
        const float* adab = INP(5); const float* MODP = WSP(float, O_MODP); float* MOD = WSP(float, O_MOD);
        for (int it = gt; it < 49152; it += NTH) { const int layer = it / 24576, v = (it / 12288) & 1, col = it % 12288; float s = adab[layer * 12288 + col];
#pragma unroll
            for (int kc = 0; kc < 16; ++kc) s += MODP[((size_t)(kc * 2 + layer) * 2 + v) * 12288 + col];
            MOD[it] = s; }
    }
    GSYNC();
    PE(5); PB(4);
    {
        PH_IDS
        const float* MOD = WSP(float, O_MOD);
        prenorm_rows(INP(0), INP(2), WSP(bf16_t, O_H), INP(6), MOD, MOD + 12288, 0, 2048, MT, gw, NGW, lane);
    }
    GSYNC();

    PE(4);
#pragma unroll 1
    for (int layer = 0; layer < 2; ++layer) {
        PB(1);
        { PH_IDS
          pg8::Gemm g{WSP(bf16_t, O_H), WSP(bf16_t, O_WIN) + (size_t)layer * INW * DM, MT, INW, DM}; pg8::StaticOrder S; S.init(MT, INW, G, bx);
          EpiIn E{WSP(float, O_QRAW), WSP(float, O_KRAW), WSP(bf16_t, O_VB), WSP(float, O_US), WSP(bf16_t, O_UF)};
          pg8::gemm_phase<EpiIn, pg8::StaticOrder, true, true>(lds, g, S, E);
          if (G == 256 && bx >= 138) { LAS float* scr = (LAS float*)(lds + wave * 16640);
              if (layer == 0) { for (int r = CONV_P0 + (bx - 138) * 8 + wave; r < 10752; r += 118 * 8) conv_item(lds, ws, r, scr, lane); }
              else            { for (int r = CONV_B + (bx - 138) * 8 + wave; r < 10816; r += 118 * 8) conv_item(lds, ws, 10816 + r, scr, lane); } } }
        GSYNC();
        PE(1); PB(3); PB(31);
        {
            PH_IDS
            { const bf16_t* W1 = WSP(bf16_t, O_W1);
              for (int i = tid; i < 256 * 16; i += 512) { const int r = i >> 4, ch = i & 15; *(LAS u32x4*)(lds + r * 272 + ch * 16) = *(const u32x4*)(W1 + r * 128 + ch * 8); } }
            __syncthreads();
            { const bf16_t* UF = WSP(bf16_t, O_UF); bf16_t* TB = WSP(bf16_t, O_TB); const f32x2* TW = WSP(f32x2, O_TW);
              for (int task = gw; task < 4096; task += NGW) fft1_task(UF, TB, TW, lds, task, lane); }
            { LAS float* usb = (LAS float*)(lds + 69632 + wave * 8192);
              const float* US = WSP(float, O_US); const f32x4* AB = WSP(f32x4, O_AB); const bf16_t* BBT = WSP(bf16_t, O_BBT); float* SS = WSP(float, O_S);
              int cur = 0;
              if (gw < NCH * 32) ssm_dma_u(US, usb, gw >> 5, gw & 31, lane);
              for (int task = gw; task < NCH * 32; task += NGW) { const int k = task >> 5, g = task & 31, nxt = task + NGW;
                asm volatile("s_waitcnt vmcnt(0)" ::: "memory");
                if (nxt < NCH * 32) ssm_dma_u(US, usb + (cur ^ 1) * 1024, nxt >> 5, nxt & 31, lane);
                const int ldg0 = (layer * 2) * 32 + g, ldg1 = ldg0 + 32;
                const f32x4 ab0 = AB[ldg0 * 64 + lane], ab1 = AB[ldg1 * 64 + lane];
                const LAS float* us = usb + cur * 1024;
                bf16x8 bf0[4], bf1[4]; ssm_load_bf4(BBT, bf0, ldg0, lane); ssm_load_bf4(BBT, bf1, ldg1, lane);
                ssm_s1_run<0>(ab0.x, ab0.y, bf0, us, SS + ((size_t)(0 * NCH + k) * 32 + g) * 128, lane);
                ssm_s1_run<1>(ab1.x, ab1.y, bf1, us, SS + ((size_t)(1 * NCH + k) * 32 + g) * 128, lane);
                cur ^= 1; } }
            kq_post(WSP(float, O_QRAW), WSP(float, O_KRAW), WSP(bf16_t, O_QB), WSP(bf16_t, O_KB), INP(11) + layer * 128, INP(12) + layer * 128, WSP(float, O_ROPE), gw, NGW, lane);
        }
        GSYNC();
        PE(31); PB(32);
        {
            PH_IDS
            { const bf16_t* W2 = WSP(bf16_t, O_W2);
              for (int i = tid; i < 256 * 32; i += 512) { const int r = i >> 5, ch = i & 31; *(LAS u32x4*)(lds + r * 528 + ch * 16) = *(const u32x4*)(W2 + r * 256 + ch * 8); } }
            __syncthreads();
            { const f32x4* AB = WSP(f32x4, O_AB); const float* SS = WSP(float, O_S); float* HIN = WSP(float, O_HIN);
              for (int task = gw; task < 4096; task += NGW) ssm_s2_task(AB, SS, HIN, layer, task, lane); }
            { const bf16_t* TB = WSP(bf16_t, O_TB); bf16_t* XF = WSP(bf16_t, O_XF);
              for (int task = gw; task < 4096; task += NGW) fft2_task(TB, XF, lds, task, lane); }
            if (layer == 0) { const bf16_t* UF = WSP(bf16_t, O_UF); bf16_t* XF = WSP(bf16_t, O_XF); const bf16_t* WC = WSP(bf16_t, O_WC);
              for (int task = gw; task < 128; task += NGW) fftc_task(UF, XF, WC, task, lane); }
        }
        GSYNC();
        PE(32); PB(33);
        {
            PH_IDS
            LAS float* usb = (LAS float*)(lds + wave * 16896);
            LAS unsigned* st = (LAS unsigned*)(lds + wave * 16896 + 8192);
            const int fr = lane & 15, fq = lane >> 4;
            const int ntask = (layer == 0 ? NCH : 256) * 32;
            const float* US = WSP(float, O_US); const f32x4* AB = WSP(f32x4, O_AB); const bf16_t* BBT = WSP(bf16_t, O_BBT); const bf16_t* CB = WSP(bf16_t, O_CB); const float* HIN = WSP(float, O_HIN);
            bf16_t* GB = WSP(bf16_t, O_G); const float* dvp = INP(20) + layer * 512;
            int cur = 0;
            if (gw < ntask) ssm_dma_u(US, usb, gw >> 5, gw & 31, lane);
            for (int task = gw; task < ntask; task += NGW) { const int k = task >> 5, g = task & 31, nxt = task + NGW;
                asm volatile("s_waitcnt vmcnt(0)" ::: "memory");
                if (nxt < ntask) ssm_dma_u(US, usb + (cur ^ 1) * 1024, nxt >> 5, nxt & 31, lane);
                const int ldg0 = (layer * 2) * 32 + g, ldg1 = ldg0 + 32;
                const f32x4 ab0 = AB[ldg0 * 64 + lane], ab1 = AB[ldg1 * 64 + lane];
                const float* hin0 = HIN + ((size_t)(0 * NCH + k) * 32 + g) * 128; const float* hin1 = HIN + ((size_t)(1 * NCH + k) * 32 + g) * 128;
                const f32x2 hh0 = {hin0[lane], hin0[64 + lane]}, hh1 = {hin1[lane], hin1[64 + lane]};
                const f32x4 dv4 = *(const f32x4*)(dvp + 16 * g + 4 * fq);
                bf16x8 cb0[4], cb1[4];
#pragma unroll
                for (int ks = 0; ks < 4; ++ks) { cb0[ks] = *(const bf16x8*)(CB + ((size_t)(ldg0 * 16 + fr)) * 128 + 32 * ks + 8 * fq); cb1[ks] = *(const bf16x8*)(CB + ((size_t)(ldg1 * 16 + fr)) * 128 + 32 * ks + 8 * fq); }
                const LAS float* us = usb + cur * 1024;
                pg8::f32x4 yacc[4];
#pragma unroll
                for (int q = 0; q < 4; ++q) yacc[q] = (pg8::f32x4){0.f, 0.f, 0.f, 0.f};
                bf16x8 bf0[4], bf1[4]; ssm_load_bf4(BBT, bf0, ldg0, lane); ssm_load_bf4(BBT, bf1, ldg1, lane);
                ssm_s3_run<0>(ab0.x, ab0.y, bf0, cb0, hh0, us, st, yacc, lane);
                ssm_s3_run<1>(ab1.x, ab1.y, bf1, cb1, hh1, us, st, yacc, lane);
#pragma unroll
                for (int q = 0; q < 4; ++q) { const int tok = 16 * q + fr; const f32x4 u4 = *(const LAS f32x4*)(us + fq * 256 + tok * 4);
                    const float y0 = gelu_tanh(yacc[q][0] + dv4.x * u4.x), y1 = gelu_tanh(yacc[q][1] + dv4.y * u4.y), y2 = gelu_tanh(yacc[q][2] + dv4.z * u4.z), y3 = gelu_tanh(yacc[q][3] + dv4.w * u4.w);
                    u32x2 o; o.x = pk2(y0, y1); o.y = pk2(y2, y3); *(u32x2*)(GB + (size_t)(64 * k + tok) * 512 + 16 * g + 4 * fq) = o; }
                cur ^= 1;
            }
        }
        GSYNC();
        PE(3); PE(33); PB(6);
        { PH_IDS
          const int MR = layer == 0 ? MT : L;
          pg8::Gemm g{WSP(bf16_t, O_G), WSP(bf16_t, O_WGLU) + (size_t)layer * 512 * 512, MR, 512, 512}; pg8::StaticOrder S; S.init(MR, 512, G, bx);
          EpiMix E{WSP(bf16_t, O_CAT), WSP(bf16_t, O_G), INP(22) + layer * 512, 0};
          pg8::gemm_phase<EpiMix, pg8::StaticOrder, true, true>(lds, g, S, E); }
        __syncthreads();
        { PH_IDS
          const int MR = layer == 0 ? MT : L;
          pg8::Gemm g{WSP(bf16_t, O_XF), WSP(bf16_t, O_WF) + (size_t)layer * 524288, MR, 512, 1024}; pg8::StaticOrder S; S.init(MR, 512, G, (bx + 128) % G);
          EpiMix E{WSP(bf16_t, O_CAT), WSP(bf16_t, O_G), INP(22) + layer * 512, 1};
          pg8::gemm_phase<EpiMix, pg8::StaticOrder, true, true>(lds, g, S, E); }
        __syncthreads();
        PE(6); PB(2);
        { PH_IDS
          const float* q_ = WSP(const float, O_QRAW); const att::bf16* k_ = WSP(const att::bf16, O_KB); const att::bf16* v_ = WSP(const att::bf16, O_VB); att::bf16* o_ = WSP(att::bf16, O_CAT);
          const float* wqn = INP(11) + layer * 128; const float* ropet = WSP(float, O_ROPE);
          float negB;
          { const float* qn = INP(11) + layer * 128; const float* kn = INP(12) + layer * 128;
            float wq = fmaxf(fabsf(qn[lane]), fabsf(qn[64 + lane])), wk = fmaxf(fabsf(kn[lane]), fabsf(kn[64 + lane]));
#pragma unroll
            for (int o = 1; o < 64; o <<= 1) { wq = fmaxf(wq, __shfl_xor(wq, o)); wk = fmaxf(wk, __shfl_xor(wk, o)); }
            negB = -(16.32212f * wq * wk * 1.02f + 0.25f); }
          for (int u = bx; u < 512; u += G) { const int xcd = u & 7, j = (u >> 3) & 31, rr = u >> 8, kvh = xcd & 1, head = 4 * kvh + (xcd >> 1), qb = j + 32 * rr;
              att::attn_dense_body<float>(q_ + (size_t)qb * 256 * 1024 + head * 128, k_ + kvh * 128, v_ + kvh * 128, o_ + (size_t)qb * 256 * 2048 + head * 128, MT, (char*)lds_raw, negB, wqn, ropet, qb * 256);
              __syncthreads(); }
          if (layer == 0 && bx >= 8 && bx < 16) { const int head = bx - 8, kvh = head >> 2;
              att::attn_dense_body<float>(q_ + (size_t)L * 1024 + head * 128, k_ + (size_t)L * 256 + kvh * 128, v_ + (size_t)L * 256 + kvh * 128, o_ + (size_t)L * 2048 + head * 128, 256, (char*)lds_raw, negB, wqn, ropet, -1);
              __syncthreads(); }
        }
        GSYNC();
        PE(2); PB(1);
        { PH_IDS
          pg8::Gemm g{WSP(bf16_t, O_CAT), WSP(bf16_t, O_WOUT) + (size_t)layer * DM * DM, L, DM, DM}; pg8::StaticOrder S; S.init(L, DM, G, bx);
          EpiF32 E{WSP(bf16_t, O_Y), DM};
          pg8::gemm_phase<EpiF32, pg8::StaticOrder, true, true>(lds, g, S, E); }
        GSYNC();
        PE(1); PB(4);
        { PH_IDS
          const bool ctxl = (layer == 0) && (G > 16);
          if (ctxl && bx < 8) {
              pg8::Gemm g{WSP(bf16_t, O_CAT) + (size_t)L * DM, WSP(bf16_t, O_WOUT) + (size_t)layer * DM * DM, 256, DM, DM}; pg8::StaticOrder S; S.init(256, DM, 8, bx);
              EpiF32 E{WSP(bf16_t, O_Y) + (size_t)L * DM, DM};
              pg8::gemm_phase<EpiF32, pg8::StaticOrder, true, true>(lds, g, S, E);
          } else {
              const float* modl = WSP(float, O_MOD) + (size_t)layer * 24576; const float* modc = modl + 12288;
              float* outp = (float*)tabptr(lds, 28); float* XC = WSP(float, O_XC);
              const float* xl_src = layer == 0 ? INP(0) : outp; const float* xc_src = layer == 0 ? INP(2) : XC;
              const int gwp = ctxl ? gw - 64 : gw, ngwp = ctxl ? NGW - 64 : NGW;
              post_rows<true>(xl_src, xc_src, outp, XC, WSP(bf16_t, O_Y), INP(7) + layer * DM, modl, modc, 2 * 2048, true, WSP(bf16_t, O_H), INP(8) + layer * DM, modl, modc, 3 * 2048, 4 * 2048,
                        0, L, gwp, ngwp, lane, (LAS float*)lds, tid);
          } }
        GSYNC();
        if (layer == 0 && gridDim.x > 16) {
            { PH_IDS
              const float* modl = WSP(float, O_MOD); const float* modc = modl + 12288; float* outp = (float*)tabptr(lds, 28); float* XC = WSP(float, O_XC);
              post_rows<false>(INP(0), INP(2), outp, XC, WSP(bf16_t, O_Y), INP(7), modl, modc, 2 * 2048, true, WSP(bf16_t, O_H), INP(8), modl, modc, 3 * 2048, 4 * 2048, L, MT, gw, NGW, lane, (LAS float*)lds, tid); }
            GSYNC();
        }
        PE(4); PB(1);
        { PH_IDS
          const int MR = layer == 0 ? MT : L;
          pg8::Gemm g{WSP(bf16_t, O_H), WSP(bf16_t, O_WGU) + (size_t)layer * 2 * FF * DM, MR, 2 * FF, DM}; pg8::StaticOrder S; S.init(MR, 2 * FF, G, bx);
          EpiUp E{WSP(bf16_t, O_HID)};
          pg8::gemm_phase<EpiUp, pg8::StaticOrder, true, true>(lds, g, S, E);
          if (layer == 0 && G == 256 && bx >= 44) { LAS float* scr = (LAS float*)(lds + wave * 16640);
              for (int r = (bx - 44) * 8 + wave; r < CONV_B; r += 212 * 8) conv_item(lds, ws, 10816 + r, scr, lane); } }
        GSYNC();
        { PH_IDS
          pg8::Gemm g{WSP(bf16_t, O_HID), WSP(bf16_t, O_WDN) + (size_t)layer * DM * FF, L, DM, FF}; pg8::StaticOrder S; S.init(L, DM, G, bx);
          EpiF32 E{WSP(bf16_t, O_Y), DM};
          pg8::gemm_phase<EpiF32, pg8::StaticOrder, true, true>(lds, g, S, E); }
        GSYNC();
        PE(1); PB(4);
        { PH_IDS
          const bool ctxl = (layer == 0) && (G > 16);
          if (ctxl && bx < 32) {
              const int kp = bx >> 3;
              pg8::Gemm g{WSP(bf16_t, O_HID) + (size_t)L * FF + kp * (FF / 4), WSP(bf16_t, O_WDN) + (size_t)layer * DM * FF + kp * (FF / 4), 256, DM, FF / 4, FF}; pg8::StaticOrder S; S.init(256, DM, 8, bx & 7);
              EpiP32 E{WSP(float, O_YP) + (size_t)kp * 256 * DM, DM};
              pg8::gemm_phase<EpiP32, pg8::StaticOrder, true, true>(lds, g, S, E);
          } else {
              const float* modl = WSP(float, O_MOD) + (size_t)layer * 24576; const float* modc = modl + 12288; const float* nmodl = modl + 24576;
              float* outp = (float*)tabptr(lds, 28); float* XC = WSP(float, O_XC);
              const int gwp = ctxl ? gw - 256 : gw, ngwp = ctxl ? NGW - 256 : NGW;
              post_rows<true>(outp, XC, outp, XC, WSP(bf16_t, O_Y), INP(9) + layer * DM, modl, modc, 5 * 2048, layer == 0, WSP(bf16_t, O_H), INP(6) + (layer + 1) * DM, nmodl, nmodl + 12288, 0, 2048,
                        0, L, gwp, ngwp, lane, (LAS float*)lds, tid);
          } }
        GSYNC();
        if (layer == 0 && gridDim.x > 16) {
            { PH_IDS
              const float* modl = WSP(float, O_MOD); const float* modc = modl + 12288; const float* nmodl = modl + 24576; float* outp = (float*)tabptr(lds, 28); float* XC = WSP(float, O_XC);
              post_rows<false>(outp, XC, outp, XC, WSP(bf16_t, O_Y), INP(9), modl, modc, 5 * 2048, true, WSP(bf16_t, O_H), INP(6) + DM, nmodl, nmodl + 12288, 0, 2048, L, MT, gw, NGW, lane, (LAS float*)lds, tid, WSP(float, O_YP)); }
            GSYNC();
        }
        PE(4);
    }
#if PROBE_CAT == 9
    for (int i = 0; i < 40; ++i) grid.sync();
#endif
#if PROBE_CAT
    if (blockIdx.x == 0) { const unsigned long long t0 = __builtin_amdgcn_s_memrealtime(); while (__builtin_amdgcn_s_memrealtime() - t0 < t_acc) __builtin_amdgcn_s_sleep(8); }
#endif
}

extern "C" void kernel_launch(void* const* d_in, const int* in_sizes, int n_in, void* d_out, int out_size, void* d_ws, size_t ws_size, hipStream_t stream) {
    static int grid = 0;
    if (grid == 0) {
        if (n_in != 28 || ws_size < WS_END) { fprintf(stderr, "kernel_launch: n_in %d (want 28), ws %zu (want >= %zu)\n", n_in, ws_size, (size_t)WS_END); grid = -1; return; }
        int dev = 0, cus = 0, per_cu = 0;
        (void)hipGetDevice(&dev); (void)hipDeviceGetAttribute(&cus, hipDeviceAttributeMultiprocessorCount, dev);
        if (hipFuncSetAttribute((const void*)hybrid_fwd, hipFuncAttributeMaxDynamicSharedMemorySize, LDS_BYTES) != hipSuccess) { fprintf(stderr, "kernel_launch: hipFuncSetAttribute failed\n"); grid = -1; return; }
        if (hipOccupancyMaxActiveBlocksPerMultiprocessor(&per_cu, (const void*)hybrid_fwd, 512, LDS_BYTES) != hipSuccess || per_cu < 1) { fprintf(stderr, "kernel_launch: occupancy query gave %d\n", per_cu); per_cu = 1; }
        (void)hipGetLastError();
        grid = cus * 1;
        if (grid <= 0) grid = 256;
    }
    if (grid < 0) return;
    Params p{};
    for (int i = 0; i < 28; ++i) p.in[i] = (const float*)d_in[i];
    p.out = (float*)d_out; p.ws = (unsigned char*)d_ws;
    (void)hipMemsetAsync((unsigned char*)d_ws + O_BAR, 0, 16384, stream);
    void* args[] = {&p};
    hipError_t e = hipLaunchCooperativeKernel((const void*)hybrid_fwd, dim3(grid), dim3(512), args, LDS_BYTES, stream);
    if (e != hipSuccess) fprintf(stderr, "kernel_launch: cooperative launch failed: %s (grid %d)\n", hipGetErrorString(e), grid);
}
```

```cpp
#include <hip/hip_runtime.h>
#include <hip/hip_cooperative_groups.h>
#include <hip/hip_bf16.h>
#include <cstdio>
#include <cstdint>
#include <cmath>
namespace cg = cooperative_groups;
namespace pg8 {
#define PG8_LAS __attribute__((address_space(3)))
typedef unsigned short bf16_t;
typedef short bf16x8 __attribute__((ext_vector_type(8)));
typedef float f32x4 __attribute__((ext_vector_type(4)));
typedef unsigned u32x4 __attribute__((ext_vector_type(4)));
constexpr int BM = 256, BK = 64, HALF = 128, HTB = HALF * BK * 2  , STAGE_BYTES = 8 * HTB, NXCD = 8, WGM = 8;

__host__ __device__ __forceinline__ int lds_byte(int r, int c) { const int st = (r >> 4) * 2 + (c >> 5), rr = r & 15, cc = c & 31, ob = rr * 64 + cc * 2; return st * 1024 + (ob ^ (((ob >> 9) & 1) << 5)); }
__host__ __device__ __forceinline__ void stage_rc(int b, int& R, int& C) { const int st = b / 1024, sb = b % 1024, swz = sb ^ (((sb >> 9) & 1) << 5); R = (st >> 1) * 16 + swz / 64; C = (st & 1) * 32 + (swz % 64) / 2; }
__host__ __device__ __forceinline__ int perm32(int rho) { const int n = rho >> 4, i = rho & 15; return 8 * (i >> 2) + 4 * n + (i & 3); }

struct Unit { int pm, pn; };
struct Gemm { const bf16_t* A; const bf16_t* Bt; int M, N, K; int ld = 0; };

struct StaticOrder {
    int nM, nN, nwg, G, c;
    __host__ __device__ void init(int M, int N, int G_, int c_) { nM = M / BM; nN = N / BM; nwg = nM * nN; G = G_; c = c_; }
    __host__ __device__ bool next(int i, Unit& u) const {
        const long L = (long)i * G + c; if (L >= nwg) return false;
        int wgid = (int)L; { const int q = nwg / NXCD, r = nwg % NXCD, xcd = wgid % NXCD, off = wgid / NXCD; wgid = (xcd < r ? xcd * (q + 1) : r * (q + 1) + (xcd - r) * q) + off; }
        const int nig = WGM * nN, gid = wgid / nig, fm = gid * WGM, gsz = (nM - fm) < WGM ? (nM - fm) : WGM;
        u.pm = fm + ((wgid % nig) % gsz); u.pn = (wgid % nig) / gsz; return true;
    }
    __device__ __forceinline__ void a_ready(const Unit&) const {}
    __device__ __forceinline__ void done(const Unit&) const {}
};

__device__ __forceinline__ unsigned cvt_pk_bf16(float lo, float hi) { unsigned r; asm volatile("v_cvt_pk_bf16_f32 %0, %1, %2" : "=v"(r) : "v"(lo), "v"(hi)); return r; }
typedef float f32x2 __attribute__((ext_vector_type(2)));
template <class Epi, class Sched, bool ALIGN_EPI = false, bool SP2 = false>
__device__ __forceinline__ void gemm_phase(PG8_LAS unsigned char* lds, const Gemm g, const Sched& S, const Epi& E) {
    int tid_ = threadIdx.x; asm volatile("" : "+v"(tid_)); const int tid = tid_, wid = __builtin_amdgcn_readfirstlane(tid >> 6), lane = tid & 63, wr = wid >> 2, wc = wid & 3, fr = lane & 15, fq = lane >> 4;
    const int nt = g.K / BK, K = g.ld ? g.ld : g.K;
    unsigned voffA[2], voffB[2];
#pragma unroll
    for (int i = 0; i < 2; ++i) { int R, C; stage_rc(tid * 16 + i * 8192, R, C); const int Rb = Epi::PERM ? ((R & ~31) + perm32(R & 31)) : R;
        voffA[i] = (unsigned)(R * K + C) * 2u; voffB[i] = (unsigned)(Rb * K + C) * 2u; }
    const size_t kstep = (size_t)(BK * 2);
    const size_t hstep = (size_t)HALF * K * 2;
    const size_t tstep = 2 * hstep;
    const unsigned ldsw = (unsigned)wid * 1024u;
    const int aoff = lds_byte(wr * 64 + fr, fq * 8), boff = lds_byte(wc * 32 + fr, fq * 8);
#define PG8_SA(b, h) (((b) * 2 + (h)) * HTB)
#define PG8_SB(b, h) ((4 + (b) * 2 + (h)) * HTB)
#define PG8_STAGE(bufoff, gbase, voff) do { _Pragma("unroll") for (int _i = 0; _i < 2; ++_i) \
        __builtin_amdgcn_global_load_lds((const unsigned*)((const char*)(gbase) + (voff)[_i]), (PG8_LAS unsigned*)(lds + (bufoff) + ldsw + _i * 8192), 16, 0, 0); } while (0)
#define PG8_LDA(dst, b, h) do { _Pragma("unroll") for (int m = 0; m < 4; ++m) _Pragma("unroll") for (int k = 0; k < 2; ++k) dst[m][k] = *(const PG8_LAS bf16x8*)(lds + PG8_SA(b, h) + aoff + m * 2048 + k * 1024); } while (0)
#define PG8_LDB(dst, b, h) do { _Pragma("unroll") for (int n = 0; n < 2; ++n) _Pragma("unroll") for (int k = 0; k < 2; ++k) dst[n][k] = *(const PG8_LAS bf16x8*)(lds + PG8_SB(b, h) + boff + n * 2048 + k * 1024); } while (0)
#define PG8_MMA(ai, bj, At, Bt) do { __builtin_amdgcn_s_setprio(1); _Pragma("unroll") for (int m = 0; m < 4; ++m) _Pragma("unroll") for (int n = 0; n < 2; ++n) _Pragma("unroll") for (int k = 0; k < 2; ++k) \
        acc[ai][bj][m][n] = __builtin_amdgcn_mfma_f32_16x16x32_bf16(Bt[n][k], At[m][k], acc[ai][bj][m][n], 0, 0, 0); __builtin_amdgcn_s_setprio(0); } while (0)
#define PG8_WAIT_V(n) asm volatile("s_waitcnt vmcnt(" #n ")" ::: "memory")
#define PG8_WAIT_L(n) asm volatile("s_waitcnt lgkmcnt(" #n ")" ::: "memory")
#define PG8_BAR __builtin_amdgcn_s_barrier()
#define PG8_SCHED __builtin_amdgcn_sched_barrier(0)
    Unit cur, nxt; int ui = 0;
    if (!S.next(0, cur)) return;
    f32x4 acc[2][2][4][2];
#pragma unroll
    for (int a = 0; a < 2; ++a)
#pragma unroll
        for (int b = 0; b < 2; ++b)
#pragma unroll
            for (int m = 0; m < 4; ++m)
#pragma unroll
                for (int n = 0; n < 2; ++n) acc[a][b][m][n] = (f32x4){0.f, 0.f, 0.f, 0.f};
    bf16x8 At[4][2], B0[2][2], B1[2][2];
    const char* cA = (const char*)g.A + (size_t)cur.pm * tstep; const char* cB = (const char*)g.Bt + (size_t)cur.pn * tstep;
    S.a_ready(cur);
    if constexpr (SP2) {
        PG8_STAGE(PG8_SB(0, 0), cB, voffB); PG8_STAGE(PG8_SB(0, 1), cB + hstep, voffB); PG8_STAGE(PG8_SA(0, 0), cA, voffA); PG8_STAGE(PG8_SA(0, 1), cA + hstep, voffA);
        if (wr == 1) PG8_BAR;
        PG8_WAIT_V(2); PG8_BAR;
        PG8_STAGE(PG8_SB(1, 0), cB + kstep, voffB); PG8_STAGE(PG8_SA(1, 0), cA + kstep, voffA); PG8_STAGE(PG8_SB(1, 1), cB + hstep + kstep, voffB);
        PG8_WAIT_V(6); PG8_BAR;
    } else {
        PG8_STAGE(PG8_SB(0, 0), cB, voffB); PG8_STAGE(PG8_SA(0, 0), cA, voffA); PG8_STAGE(PG8_SB(0, 1), cB + hstep, voffB); PG8_STAGE(PG8_SA(0, 1), cA + hstep, voffA);
        if (wr == 1) PG8_BAR;
        PG8_WAIT_V(4); PG8_BAR;
        PG8_STAGE(PG8_SB(1, 0), cB + kstep, voffB); PG8_STAGE(PG8_SA(1, 0), cA + kstep, voffA); PG8_STAGE(PG8_SB(1, 1), cB + hstep + kstep, voffB);
        PG8_WAIT_V(6); PG8_BAR;
    }
    for (;;) {
        const bool has_next = S.next(ui + 1, nxt);
        const char* nA = has_next ? (const char*)g.A + (size_t)nxt.pm * tstep : cA; const char* nB = has_next ? (const char*)g.Bt + (size_t)nxt.pn * tstep : cB;
        for (int t = 0; t < nt; t += 2) {
            const bool last = (t == nt - 2);
            const char* a1 = cA + (size_t)(t + 1) * kstep;
            const char* a2 = last ? nA : cA + (size_t)(t + 2) * kstep; const char* b2 = last ? nB : cB + (size_t)(t + 2) * kstep;
            const char* a3 = a2 + kstep; const char* b3 = b2 + kstep;
            if (last && has_next) S.a_ready(nxt);
            if constexpr (SP2) {
            PG8_LDB(B0, 0, 0); PG8_LDB(B1, 0, 1); PG8_SCHED; PG8_LDA(At, 0, 0); PG8_STAGE(PG8_SA(1, 1), a1 + hstep, voffA);
            PG8_WAIT_V(8); PG8_WAIT_L(0); PG8_BAR; PG8_MMA(0, 0, At, B0); PG8_MMA(0, 1, At, B1); PG8_BAR; PG8_SCHED;
            PG8_LDA(At, 0, 1); PG8_STAGE(PG8_SB(0, 0), b2, voffB); PG8_STAGE(PG8_SB(0, 1), b2 + hstep, voffB); PG8_STAGE(PG8_SA(0, 0), a2, voffA);
            PG8_WAIT_V(8); PG8_WAIT_L(0); PG8_BAR; PG8_MMA(1, 0, At, B0); PG8_MMA(1, 1, At, B1); PG8_BAR; PG8_SCHED;
            PG8_LDB(B0, 1, 0); PG8_LDB(B1, 1, 1); PG8_SCHED; PG8_LDA(At, 1, 0); PG8_STAGE(PG8_SA(0, 1), a2 + hstep, voffA);
            PG8_WAIT_V(8); PG8_WAIT_L(0); PG8_BAR; PG8_MMA(0, 0, At, B0); PG8_MMA(0, 1, At, B1); PG8_BAR; PG8_SCHED;
            PG8_LDA(At, 1, 1); PG8_STAGE(PG8_SB(1, 0), b3, voffB); PG8_STAGE(PG8_SB(1, 1), b3 + hstep, voffB); PG8_STAGE(PG8_SA(1, 0), a3, voffA);
            PG8_WAIT_V(8); PG8_WAIT_L(0); PG8_BAR; PG8_MMA(1, 0, At, B0); PG8_MMA(1, 1, At, B1); PG8_BAR; PG8_SCHED;
            } else {
            PG8_LDB(B0, 0, 0); PG8_SCHED; PG8_LDA(At, 0, 0); PG8_STAGE(PG8_SA(1, 1), a1 + hstep, voffA);
            PG8_WAIT_L(8); PG8_BAR; PG8_WAIT_L(0); PG8_MMA(0, 0, At, B0); PG8_BAR; PG8_SCHED;
            PG8_LDB(B1, 0, 1); PG8_STAGE(PG8_SB(0, 0), b2, voffB);
            PG8_BAR; PG8_WAIT_L(0); PG8_MMA(0, 1, At, B1); PG8_BAR;
            PG8_LDA(At, 0, 1); PG8_STAGE(PG8_SA(0, 0), a2, voffA);
            PG8_BAR; PG8_WAIT_L(0); PG8_MMA(1, 0, At, B0); PG8_BAR; PG8_SCHED;
            PG8_STAGE(PG8_SB(0, 1), b2 + hstep, voffB);
            PG8_WAIT_V(6); PG8_BAR; PG8_MMA(1, 1, At, B1); PG8_BAR;
            PG8_LDB(B0, 1, 0); PG8_SCHED; PG8_LDA(At, 1, 0); PG8_STAGE(PG8_SA(0, 1), a2 + hstep, voffA);
            PG8_WAIT_L(8); PG8_BAR; PG8_WAIT_L(0); PG8_MMA(0, 0, At, B0); PG8_BAR; PG8_SCHED;
            PG8_LDB(B1, 1, 1); PG8_STAGE(PG8_SB(1, 0), b3, voffB);
            PG8_BAR; PG8_WAIT_L(0); PG8_MMA(0, 1, At, B1); PG8_BAR;
            PG8_LDA(At, 1, 1); PG8_STAGE(PG8_SA(1, 0), a3, voffA);
            PG8_BAR; PG8_WAIT_L(0); PG8_MMA(1, 0, At, B0); PG8_BAR; PG8_SCHED;
            PG8_STAGE(PG8_SB(1, 1), b3 + hstep, voffB);
            PG8_WAIT_V(6); PG8_BAR; PG8_MMA(1, 1, At, B1); PG8_BAR;
            }
        }
        if constexpr (ALIGN_EPI) { if (wr == 0) PG8_BAR; }
        if constexpr (!Epi::AFTER_DRAIN) { E(acc, cur, wr, wc, fr, fq); S.done(cur); }
        if (!has_next) break;
#pragma unroll
        for (int a = 0; a < 2; ++a)
#pragma unroll
            for (int b = 0; b < 2; ++b)
#pragma unroll
                for (int m = 0; m < 4; ++m)
#pragma unroll
                    for (int n = 0; n < 2; ++n) acc[a][b][m][n] = (f32x4){0.f, 0.f, 0.f, 0.f};
        cur = nxt; cA = nA; cB = nB; ++ui;
        if constexpr (ALIGN_EPI) { if (wr == 1) PG8_BAR; }
    }
    PG8_WAIT_V(0);
    if constexpr (!ALIGN_EPI) { if (wr == 0) PG8_BAR; }
    PG8_BAR;
    if constexpr (Epi::AFTER_DRAIN) { E.fused(acc, cur, wr, wc, fr, fq, lds, wid, lane); S.done(cur); }
#undef PG8_SA
#undef PG8_SB
#undef PG8_STAGE
#undef PG8_LDA
#undef PG8_LDB
#undef PG8_MMA
#undef PG8_WAIT_V
#undef PG8_WAIT_L
#undef PG8_BAR
#undef PG8_SCHED
}
}
namespace att {
using bf16 = __hip_bfloat16;
constexpr int   D = 128, NW = 8, QBLK = 32, KVBLK = 64;
constexpr float SCALE = 0.088388347648318440f;
constexpr float THR = 8.f;
constexpr int SDEPTH = 1;
constexpr int LDQ = 1024, LDK = 256, LDO = 2048;
constexpr size_t SHM_V = KVBLK * D * 2, SHM_K = KVBLK * D * 2, SHM_ATTN = 2 * SHM_V + 2 * SHM_K + NW * 64 * 4;
using bf16x8 = __attribute__((ext_vector_type(8))) short;
using s16x4  = __attribute__((ext_vector_type(4))) short;
using f32x16 = __attribute__((ext_vector_type(16))) float;
using f32x8  = __attribute__((ext_vector_type(8))) float;
using u32x4  = __attribute__((ext_vector_type(4))) unsigned;
#define KSWZ(row, colB) ((row) * 256 + ((colB) ^ (((row) & 7) << 4)))
#define SBAR() __builtin_amdgcn_sched_barrier(0)
__device__ __forceinline__ int crow(int r, int hi) { return (r & 3) + 8 * (r >> 2) + 4 * hi; }
__device__ __forceinline__ unsigned cvtpk(float lo, float hi) {
  unsigned r; asm volatile("v_cvt_pk_bf16_f32 %0, %1, %2" : "=v"(r) : "v"(lo), "v"(hi)); return r;
}
template <typename TIn> struct Stage;
template <> struct Stage<bf16>  { using T = bf16x8;
  __device__ static __forceinline__ T ld8(const bf16* p) { return *reinterpret_cast<const bf16x8*>(p); }
  __device__ static __forceinline__ bf16x8 tobf(T x) { return x; } };
template <> struct Stage<float> { using T = f32x8;
  __device__ static __forceinline__ T ld8(const float* p) { return *reinterpret_cast<const f32x8*>(p); }
  __device__ static __forceinline__ bf16x8 tobf(T x) {
    u32x4 w = {cvtpk(x[0], x[1]), cvtpk(x[2], x[3]), cvtpk(x[4], x[5]), cvtpk(x[6], x[7])}; return *reinterpret_cast<bf16x8*>(&w); } };

__device__ __forceinline__ void partialSM(f32x16& p0, f32x16& p1, float& m_reg, f32x16& negm, float& alpha) {
  constexpr float THRL = THR * 1.4426950408889634f;
  float pmax = p0[0]; for (int r = 1; r < 16; ++r) pmax = fmaxf(pmax, p0[r]); for (int r = 0; r < 16; ++r) pmax = fmaxf(pmax, p1[r]);
  { auto rr = __builtin_amdgcn_permlane32_swap(__float_as_uint(pmax), __float_as_uint(pmax), false, false);
    pmax = fmaxf(__uint_as_float(rr[0]), __uint_as_float(rr[1])); }
  if (__builtin_expect(__all(pmax <= THRL), 1)) { alpha = 1.f; }
  else { const float dl = fmaxf(pmax, 0.f); m_reg += dl; alpha = __builtin_amdgcn_exp2f(-dl);
    for (int r = 0; r < 16; ++r) { p0[r] -= dl; p1[r] -= dl; }
    for (int r = 0; r < 16; ++r) negm[r] = -m_reg; asm volatile("" : "+v"(negm)); }
  for (int r = 0; r < 16; ++r) p0[r] = __builtin_amdgcn_exp2f(p0[r]);
}
__device__ __forceinline__ void exp_half(f32x16& p0) { for (int r = 0; r < 16; ++r) p0[r] = __builtin_amdgcn_exp2f(p0[r]); }
__device__ __forceinline__ void finishSM(f32x16& p0, f32x16& p1, float alpha, float& l_reg, bf16x8& pa0, bf16x8& pa1, bf16x8& pa2, bf16x8& pa3) {
  for (int r = 0; r < 16; ++r) p1[r] = __builtin_amdgcn_exp2f(p1[r]);
  float ps = 0; for (int r = 0; r < 16; ++r) ps += p0[r]; for (int r = 0; r < 16; ++r) ps += p1[r];
  { auto rr = __builtin_amdgcn_permlane32_swap(__float_as_uint(ps), __float_as_uint(ps), false, false);
    ps = __uint_as_float(rr[0]) + __uint_as_float(rr[1]); }
  l_reg = l_reg * alpha + ps;
#define PK4(P, BASE, OUT) do { unsigned a0 = cvtpk(P[BASE + 0], P[BASE + 1]), a1 = cvtpk(P[BASE + 2], P[BASE + 3]);   \
    unsigned b0 = cvtpk(P[BASE + 4], P[BASE + 5]), b1 = cvtpk(P[BASE + 6], P[BASE + 7]);                              \
      \
    u32x4 w = {a0, a1, b0, b1}; OUT = *reinterpret_cast<bf16x8*>(&w); } while (0)
  PK4(p0, 0, pa0); PK4(p0, 8, pa1); PK4(p1, 0, pa2); PK4(p1, 8, pa3);
#undef PK4
}
__device__ __forceinline__ void qkt(f32x16& p0, f32x16& p1, const bf16* Ks, const bf16x8* qr, int r32, int hi, const f32x16& negm) {
  for (int d0 = 0; d0 < 8; ++d0) { int cb = (d0 * 16 + hi * 8) * 2;
    bf16x8 b0 = *reinterpret_cast<const bf16x8*>((const char*)Ks + KSWZ(r32, cb));
    bf16x8 b1 = *reinterpret_cast<const bf16x8*>((const char*)Ks + KSWZ(32 + r32, cb));
    if (d0 == 0) { p0 = __builtin_amdgcn_mfma_f32_32x32x16_bf16(b0, qr[0], negm, 0, 0, 0); p1 = __builtin_amdgcn_mfma_f32_32x32x16_bf16(b1, qr[0], negm, 0, 0, 0); }
    else { p0 = __builtin_amdgcn_mfma_f32_32x32x16_bf16(b0, qr[d0], p0, 0, 0, 0); p1 = __builtin_amdgcn_mfma_f32_32x32x16_bf16(b1, qr[d0], p1, 0, 0, 0); } }
}
__device__ __forceinline__ int v_st(int k, int c) { const int kk = k;   return ((kk >> 3) * 4 + (c >> 5)) * 512 + ((kk & 7) * 32 + (c & 31)) * 2; }
__device__ __forceinline__ int v_rd_base(int lane) { return ((lane & 3) << 3) | (((lane >> 2) & 3) << 6) | (((lane >> 4) & 1) << 5) | (((lane >> 5) & 1) << 8); }
constexpr int v_rd_off(int d0, int ks, int half) { return d0 * 512 + ks * 4096 + half * 2048; }
template <int OFF> __device__ __forceinline__ s16x4 tr_read(int vb) {
  s16x4 r; asm volatile("ds_read_b64_tr_b16 %0, %1 offset:%2" : "=&v"(r) : "v"(vb), "i"(OFF) : "memory"); return r;
}
template <int D0> __device__ __forceinline__ void pv_one(f32x16& od, int vb, bf16x8 pa0, bf16x8 pa1, bf16x8 pa2, bf16x8 pa3) {
  const s16x4 l0 = tr_read<v_rd_off(D0, 0, 0)>(vb), h0 = tr_read<v_rd_off(D0, 0, 1)>(vb), l1 = tr_read<v_rd_off(D0, 1, 0)>(vb), h1 = tr_read<v_rd_off(D0, 1, 1)>(vb);
  const s16x4 l2 = tr_read<v_rd_off(D0, 2, 0)>(vb), h2 = tr_read<v_rd_off(D0, 2, 1)>(vb), l3 = tr_read<v_rd_off(D0, 3, 0)>(vb), h3 = tr_read<v_rd_off(D0, 3, 1)>(vb);
  asm volatile("s_waitcnt lgkmcnt(0)" ::: "memory"); SBAR();
#define PK(L, H) (bf16x8){L[0], L[1], L[2], L[3], H[0], H[1], H[2], H[3]}
  od = __builtin_amdgcn_mfma_f32_32x32x16_bf16(pa0, PK(l0, h0), od, 0, 0, 0);
  od = __builtin_amdgcn_mfma_f32_32x32x16_bf16(pa1, PK(l1, h1), od, 0, 0, 0);
  od = __builtin_amdgcn_mfma_f32_32x32x16_bf16(pa2, PK(l2, h2), od, 0, 0, 0);
  od = __builtin_amdgcn_mfma_f32_32x32x16_bf16(pa3, PK(l3, h3), od, 0, 0, 0);
#undef PK
}
__device__ __forceinline__ void pv_d0(f32x16* o, int vb, bf16x8 pa0, bf16x8 pa1, bf16x8 pa2, bf16x8 pa3) {
  pv_one<0>(o[0], vb, pa0, pa1, pa2, pa3); pv_one<1>(o[1], vb, pa0, pa1, pa2, pa3); pv_one<2>(o[2], vb, pa0, pa1, pa2, pa3); pv_one<3>(o[3], vb, pa0, pa1, pa2, pa3);
}
template <typename TQ>
__device__ __forceinline__ void attn_dense_body(const TQ* Qb, const bf16* Kh, const bf16* Vh,
                                                bf16* Ob, int seq, char* lds, float negB, const float* wq, const float* rope, int tok0) {
  using St = Stage<bf16>; using SQ = Stage<TQ>;
  int tid_ = threadIdx.x; asm volatile("" : "+v"(tid_)); const int tid = tid_, wid = tid >> 6, lane = tid & 63, r32 = lane & 31, hi = lane >> 5;
  bf16* V_lds = (bf16*)lds; bf16* K_lds = (bf16*)(lds + 2 * SHM_V);
  float* ws = (float*)(lds + 2 * SHM_V + 2 * SHM_K) + wid * 64; float* li_l = ws; float* al_l = ws + 32;
  float l_reg = 0; f32x16 o[4] = {}; bf16x8 qr[8];
  f32x16 negm; for (int r = 0; r < 16; ++r) negm[r] = negB; asm volatile("" : "+v"(negm));
  { const TQ* Qw = Qb + (long)(wid * QBLK + r32) * LDQ + hi * 8;
    f32x8 xr[8]; float ss = 0.f;
#pragma unroll
    for (int d0 = 0; d0 < 8; ++d0) { xr[d0] = *reinterpret_cast<const f32x8*>(Qw + d0 * 16);
#pragma unroll
      for (int e = 0; e < 8; ++e) ss += xr[d0][e] * xr[d0][e]; }
    { auto rr = __builtin_amdgcn_permlane32_swap(__float_as_uint(ss), __float_as_uint(ss), false, false); ss = __uint_as_float(rr[0]) + __uint_as_float(rr[1]); }
    const float rs = rsqrtf(ss * (1.f / 128.f) + 1e-6f) * 0.12751743f;
#pragma unroll
    for (int d0 = 0; d0 < 8; ++d0) { const f32x8 wv = *reinterpret_cast<const f32x8*>(wq + d0 * 16 + hi * 8);
#pragma unroll
      for (int e = 0; e < 8; ++e) xr[d0][e] = xr[d0][e] * rs * wv[e]; }
    if (tok0 >= 0) { const int tok = tok0 + wid * QBLK + r32;
#pragma unroll
      for (int h2 = 0; h2 < 2; ++h2) { const int pos = h2 == 0 ? (tok >> 6) : (tok & 63);
#pragma unroll
        for (int dd = 0; dd < 2; ++dd) { const float* rp = rope + ((size_t)pos * 32 + dd * 16 + hi * 8) * 2;
#pragma unroll
          for (int e = 0; e < 8; ++e) { const float c = rp[2 * e], s = rp[2 * e + 1]; const float a = xr[4 * h2 + dd][e], bq = xr[4 * h2 + dd + 2][e];
            xr[4 * h2 + dd][e] = a * c - bq * s; xr[4 * h2 + dd + 2][e] = bq * c + a * s; } } } }
#pragma unroll
    for (int d0 = 0; d0 < 8; ++d0) qr[d0] = Stage<float>::tobf(xr[d0]); }
  const int sr = tid >> 4, sc = (tid & 15) * 8, vst0 = v_st(sr, sc), vst1 = v_st(32 + sr, sc);
  const int vb0 = (int)(uintptr_t)V_lds + v_rd_base(lane);
  struct { typename St::T vs0, vs1, ks0, ks1; } sr_[SDEPTH];
#define SLOAD(i, k0) do { sr_[i].vs0 = St::ld8(&Vh[(long)((k0) + sr) * LDK + sc]); sr_[i].vs1 = St::ld8(&Vh[(long)((k0) + 32 + sr) * LDK + sc]); \
    sr_[i].ks0 = St::ld8(&Kh[(long)((k0) + sr) * LDK + sc]); sr_[i].ks1 = St::ld8(&Kh[(long)((k0) + 32 + sr) * LDK + sc]); } while (0)
#define SWRITE(b, i) do { *(bf16x8*)((char*)V_lds + (b) * SHM_V + vst0) = St::tobf(sr_[i].vs0);          \
    *(bf16x8*)((char*)V_lds + (b) * SHM_V + vst1) = St::tobf(sr_[i].vs1); int kc = sc * 2;               \
    *(bf16x8*)((char*)K_lds + (b) * SHM_K + KSWZ(sr, kc)) = St::tobf(sr_[i].ks0);                       \
    *(bf16x8*)((char*)K_lds + (b) * SHM_K + KSWZ(32 + sr, kc)) = St::tobf(sr_[i].ks1); } while (0)
#define SWAIT() do { if constexpr (SDEPTH == 2) asm volatile("s_waitcnt vmcnt(4)" ::: "memory"); else asm volatile("s_waitcnt vmcnt(0)" ::: "memory"); } while (0)
#define RESC(a) do { if (__any((a) < 1.f)) { if (hi == 0) al_l[r32] = (a); asm volatile("s_waitcnt lgkmcnt(0)" ::: "memory"); \
    for (int d = 0; d < 4; ++d) for (int r = 0; r < 16; ++r) o[d][r] *= al_l[crow(r, hi)]; } } while (0)
  f32x16 pA0, pA1, pB0, pB1; bf16x8 pa0, pa1, pa2, pa3; const int NT = seq / KVBLK;
  constexpr int SE = 0, SO = SDEPTH - 1;
  SLOAD(SE, 0); asm volatile("s_waitcnt vmcnt(0)" ::: "memory"); SWRITE(0, SE); __syncthreads();
  qkt(pA0, pA1, K_lds, qr, r32, hi, negm); exp_half(pA0);
  SLOAD(SO, KVBLK); if constexpr (SDEPTH == 2) { if (2 < NT) SLOAD(SE, 2 * KVBLK); }
  SWAIT(); SWRITE(1, SO); __syncthreads();
  for (int j = 1; j + 1 < NT; j += 2) {
    SBAR(); qkt(pB0, pB1, (bf16*)((char*)K_lds + SHM_K), qr, r32, hi, negm);
    finishSM(pA0, pA1, 1.f, l_reg, pa0, pa1, pa2, pa3); SBAR();
    SLOAD(SO, (j + SDEPTH) * KVBLK); SBAR();
    pv_d0(o, vb0, pa0, pa1, pa2, pa3); exp_half(pB0);
    __syncthreads(); SWAIT(); SWRITE(0, SE);
    __syncthreads();
    SBAR(); qkt(pA0, pA1, K_lds, qr, r32, hi, negm);
    finishSM(pB0, pB1, 1.f, l_reg, pa0, pa1, pa2, pa3); SBAR();
    if (SDEPTH == 1 || j + 3 < NT) SLOAD(SE, (j + 1 + SDEPTH) * KVBLK); SBAR();
    pv_d0(o, vb0 + (int)SHM_V, pa0, pa1, pa2, pa3); exp_half(pA0);
    __syncthreads(); SWAIT(); SWRITE(1, SO);
    __syncthreads();
  }
  SBAR(); qkt(pB0, pB1, (bf16*)((char*)K_lds + SHM_K), qr, r32, hi, negm);
  finishSM(pA0, pA1, 1.f, l_reg, pa0, pa1, pa2, pa3); SBAR();
  pv_d0(o, vb0, pa0, pa1, pa2, pa3); exp_half(pB0);
  __syncthreads();
  finishSM(pB0, pB1, 1.f, l_reg, pa0, pa1, pa2, pa3); SBAR();
  pv_d0(o, vb0 + (int)SHM_V, pa0, pa1, pa2, pa3);
  if (hi == 0) li_l[r32] = l_reg; asm volatile("s_waitcnt lgkmcnt(0)" ::: "memory");
  float rli[16];
#pragma unroll
  for (int r = 0; r < 16; ++r) rli[r] = __builtin_amdgcn_rcpf(li_l[crow(r, hi)]);
  bf16* Ow = Ob + (long)(wid * QBLK) * LDO;
#pragma unroll
  for (int r = 0; r < 16; ++r) { int orow = crow(r, hi);
    for (int d0 = 0; d0 < 4; ++d0) Ow[(long)orow * LDO + d0 * 32 + r32] = __float2bfloat16(o[d0][r] * rli[r]); }
#undef SLOAD
#undef SWRITE
#undef SWAIT
#undef RESC
}
}

#define LAS __attribute__((address_space(3)))
typedef unsigned short bf16_t;
typedef float f32x4 __attribute__((ext_vector_type(4)));
typedef float f32x2 __attribute__((ext_vector_type(2)));
typedef unsigned u32x4 __attribute__((ext_vector_type(4)));
typedef unsigned u32x2 __attribute__((ext_vector_type(2)));
typedef short bf16x8 __attribute__((ext_vector_type(8)));

constexpr int L = 16384, NCTX = 256, MT = L + NCTX, DM = 2048, INW = 2560, FF = 5632, NCH = 260;
constexpr float EPS = 1e-6f;

constexpr size_t al256(size_t x) { return (x + 255) / 256 * 256; }
constexpr size_t SZ_WIN = (size_t)INW * DM * 2, SZ_WOUT = (size_t)DM * DM * 2, SZ_WGU = (size_t)2 * FF * DM * 2, SZ_WDN = (size_t)DM * FF * 2,
                 SZ_WGLU = 512 * 512 * 2, SZ_WF = 512 * 1024 * 2;
constexpr size_t O_WIN = 0;
constexpr size_t O_WOUT = O_WIN + 2 * SZ_WIN;
constexpr size_t O_WGU = O_WOUT + 2 * SZ_WOUT;
constexpr size_t O_WDN = O_WGU + 2 * SZ_WGU;
constexpr size_t O_WGLU = O_WDN + 2 * SZ_WDN;
constexpr size_t O_WF = O_WGLU + 2 * SZ_WGLU;
constexpr size_t O_MODP = O_WF + 2 * SZ_WF;
constexpr size_t O_MOD = O_MODP + (size_t)16 * 4 * 12288 * 4;
constexpr size_t O_ROPE = O_MOD + (size_t)4 * 12288 * 4;
constexpr size_t O_AB = O_ROPE + 65536;
constexpr size_t O_BB = O_AB + 8192 * 16;
constexpr size_t O_CB = O_BB + (size_t)8192 * 16 * 8;
constexpr size_t O_W1 = O_CB + (size_t)128 * 16 * 128 * 2;
constexpr size_t O_W2 = O_W1 + 65536;
constexpr size_t O_WC = O_W2 + 131072;
constexpr size_t O_TW = O_WC + 262144;
constexpr size_t O_XC = O_TW + 131072;
constexpr size_t SZ_S = (size_t)2 * NCH * 32 * 128 * 4;
constexpr size_t O_S = O_XC + (size_t)NCTX * DM * 4;
constexpr size_t O_HIN = O_S + SZ_S;
constexpr size_t O_BBT = al256(O_HIN + SZ_S);
constexpr size_t O_BAR = O_BBT + (size_t)128 * 128 * 16 * 2;
constexpr size_t O_H = O_BAR + 16384;
constexpr size_t O_Y = O_H + (size_t)MT * DM * 2;
constexpr size_t O_YP = O_Y + (size_t)72 * 1024 * 1024;
constexpr size_t O_OV = O_Y + (size_t)MT * DM * 4;
static_assert((size_t)MT * DM * 2 <= (size_t)72 * 1024 * 1024 && O_YP + (size_t)4 * 256 * DM * 4 <= O_OV, "YP inside the Y region");
constexpr size_t O_QRAW = O_OV;
constexpr size_t O_KRAW = O_QRAW + (size_t)MT * 1024 * 4;
constexpr size_t O_QB = O_KRAW + (size_t)MT * 256 * 4;
constexpr size_t O_KB = O_QB + (size_t)MT * 1024 * 2;
constexpr size_t O_VB = O_KB + (size_t)MT * 256 * 2;
constexpr size_t O_US = O_VB + (size_t)MT * 256 * 2;
constexpr size_t O_UF = O_US + (size_t)MT * 512 * 4;
constexpr size_t O_TB = O_UF + (size_t)MT * 512 * 2;
constexpr size_t O_XF = O_TB + (size_t)2 * 128 * 128 * 512 * 2;
constexpr size_t O_G = O_XF + (size_t)MT * 1024 * 2;
constexpr size_t O_CAT = O_G + (size_t)MT * 512 * 2;
constexpr size_t O_OVEND = O_CAT + (size_t)MT * DM * 2;
constexpr size_t O_HID = O_OV;
constexpr size_t WS_END = (O_OVEND > O_HID + (size_t)MT * FF * 2) ? O_OVEND : O_HID + (size_t)MT * FF * 2;
static_assert(WS_END <= (size_t)768 * 1024 * 1024, "d_ws map exceeds 768 MiB");

constexpr int LDS_BYTES = 147456;

struct Params { const float* in[28]; float* out; unsigned char* ws; };

__device__ __forceinline__ unsigned pk2(float lo, float hi) { typedef __bf16 bf2_t __attribute__((ext_vector_type(2))); f32x2 v = {lo, hi}; bf2_t b = __builtin_convertvector(v, bf2_t); return __builtin_bit_cast(unsigned, b); }
__device__ __forceinline__ bf16_t f2bf(float f) { return (bf16_t)(pk2(f, 0.f) & 0xffffu); }
__device__ __forceinline__ float bf2f(unsigned b) { return __uint_as_float(b << 16); }
__device__ __forceinline__ float wave_sum(float v) {
#pragma unroll
    for (int o = 1; o < 64; o <<= 1) v += __shfl_xor(v, o);
    return v;
}
__device__ __forceinline__ float sigmoidf_(float x) { return 1.0f / (1.0f + __expf(-x)); }
__device__ __forceinline__ float gelu_tanh(float x) { const float u = 0.7978845608028654f * (x + 0.044715f * x * x * x); return x * sigmoidf_(2.f * u); }
#define LDS_WAIT() asm volatile("s_waitcnt lgkmcnt(0)" ::: "memory")

struct EpiIn {
    static constexpr bool PERM = true, AFTER_DRAIN = false;
    float* qraw; float* kraw; bf16_t* vb; float* us; bf16_t* uf;
    __device__ __forceinline__ void operator()(const pg8::f32x4 (&acc)[2][2][4][2], const pg8::Unit& u, int wr, int wc, int fr, int fq) const {
        const int row0 = u.pm * 256 + wr * 64 + fr, cl = wc * 32 + 8 * fq, pn = u.pn;
        float* fbase = nullptr; bf16_t* bbase = nullptr; int ldc = 0;
        if (pn < 4) { fbase = qraw + pn * 256; ldc = 1024; } else if (pn == 4) { fbase = kraw; ldc = 256; } else if (pn == 5) { bbase = vb; ldc = 256; }
        else if (pn < 8) { fbase = us + (pn - 6) * 256; ldc = 512; } else { bbase = uf + (pn - 8) * 256; ldc = 512; }
#pragma unroll
        for (int ai = 0; ai < 2; ++ai)
#pragma unroll
            for (int m = 0; m < 4; ++m) { const size_t ro = (size_t)(row0 + ai * 128 + m * 16) * ldc + cl;
#pragma unroll
                for (int bj = 0; bj < 2; ++bj) { const pg8::f32x4 v0 = acc[ai][bj][m][0], v1 = acc[ai][bj][m][1];
                    if (fbase) { float* p = fbase + ro + bj * 128; *(f32x4*)p = (f32x4){v0[0], v0[1], v0[2], v0[3]}; *(f32x4*)(p + 4) = (f32x4){v1[0], v1[1], v1[2], v1[3]}; }
                    else { u32x4 w; w.x = pk2(v0[0], v0[1]); w.y = pk2(v0[2], v0[3]); w.z = pk2(v1[0], v1[1]); w.w = pk2(v1[2], v1[3]); *(u32x4*)(bbase + ro + bj * 128) = w; } } }
    }
};
struct EpiF32 {
    static constexpr bool PERM = true, AFTER_DRAIN = false;
    bf16_t* O; int ldc;
    __device__ __forceinline__ void operator()(const pg8::f32x4 (&acc)[2][2][4][2], const pg8::Unit& u, int wr, int wc, int fr, int fq) const {
        const int row0 = u.pm * 256 + wr * 64 + fr, col0 = u.pn * 256 + wc * 32 + 8 * fq;
#pragma unroll
        for (int ai = 0; ai < 2; ++ai)
#pragma unroll
            for (int m = 0; m < 4; ++m) { bf16_t* rowp = O + (size_t)(row0 + ai * 128 + m * 16) * ldc + col0;
#pragma unroll
                for (int bj = 0; bj < 2; ++bj) { const pg8::f32x4 v0 = acc[ai][bj][m][0], v1 = acc[ai][bj][m][1];
                    u32x4 w; w.x = pk2(v0[0], v0[1]); w.y = pk2(v0[2], v0[3]); w.z = pk2(v1[0], v1[1]); w.w = pk2(v1[2], v1[3]); *(u32x4*)(rowp + bj * 128) = w; } }
    }
};
struct EpiP32 {
    static constexpr bool PERM = true, AFTER_DRAIN = false;
    float* O; int ldc;
    __device__ __forceinline__ void operator()(const pg8::f32x4 (&acc)[2][2][4][2], const pg8::Unit& u, int wr, int wc, int fr, int fq) const {
        const int row0 = u.pm * 256 + wr * 64 + fr, col0 = u.pn * 256 + wc * 32 + 8 * fq;
#pragma unroll
        for (int ai = 0; ai < 2; ++ai)
#pragma unroll
            for (int m = 0; m < 4; ++m) { float* rowp = O + (size_t)(row0 + ai * 128 + m * 16) * ldc + col0;
#pragma unroll
                for (int bj = 0; bj < 2; ++bj) { const pg8::f32x4 v0 = acc[ai][bj][m][0], v1 = acc[ai][bj][m][1];
                    *(f32x4*)(rowp + bj * 128) = (f32x4){v0[0], v0[1], v0[2], v0[3]}; *(f32x4*)(rowp + bj * 128 + 4) = (f32x4){v1[0], v1[1], v1[2], v1[3]}; } }
    }
};
struct EpiUp {
    static constexpr bool PERM = true, AFTER_DRAIN = false;
    bf16_t* hid;
    __device__ __forceinline__ void operator()(const pg8::f32x4 (&acc)[2][2][4][2], const pg8::Unit& u, int wr, int wc, int fr, int fq) const {
        const int row0 = u.pm * 256 + wr * 64 + fr, col0 = u.pn * 128 + wc * 32 + 8 * fq;
#pragma unroll
        for (int ai = 0; ai < 2; ++ai)
#pragma unroll
            for (int m = 0; m < 4; ++m) { bf16_t* rowp = hid + (size_t)(row0 + ai * 128 + m * 16) * FF + col0;
                float o[8];
#pragma unroll
                for (int n = 0; n < 2; ++n)
#pragma unroll
                    for (int e = 0; e < 4; ++e) { const float g = acc[ai][0][m][n][e], up = acc[ai][1][m][n][e]; o[4 * n + e] = g * sigmoidf_(g) * up; }
                u32x4 w; w.x = pk2(o[0], o[1]); w.y = pk2(o[2], o[3]); w.z = pk2(o[4], o[5]); w.w = pk2(o[6], o[7]); *(u32x4*)rowp = w; }
    }
};
struct EpiMix {
    static constexpr bool PERM = true, AFTER_DRAIN = false;
    bf16_t* cat; const bf16_t* gbuf; const float* bias; int mode;
    __device__ __forceinline__ void operator()(const pg8::f32x4 (&acc)[2][2][4][2], const pg8::Unit& u, int wr, int wc, int fr, int fq) const {
        const int row0 = u.pm * 256 + wr * 64 + fr, col0 = u.pn * 256 + wc * 32 + 8 * fq;
#pragma unroll
        for (int ai = 0; ai < 2; ++ai)
#pragma unroll
            for (int m = 0; m < 4; ++m) { const size_t row = (size_t)(row0 + ai * 128 + m * 16);
#pragma unroll
                for (int bj = 0; bj < 2; ++bj) { const int col = col0 + bj * 128; float o[8];
#pragma unroll
                    for (int n = 0; n < 2; ++n)
#pragma unroll
                        for (int e = 0; e < 4; ++e) o[4 * n + e] = acc[ai][bj][m][n][e];
                    if (mode == 0) { const u32x4 gv = *(const u32x4*)(gbuf + row * 512 + col); const f32x4 b0 = *(const f32x4*)(bias + col), b1 = *(const f32x4*)(bias + col + 4);
                        const unsigned gw_[4] = {gv.x, gv.y, gv.z, gv.w};
#pragma unroll
                        for (int q = 0; q < 4; ++q) { const float g0 = bf2f(gw_[q] & 0xffffu), g1 = bf2f(gw_[q] >> 16);
                            const float z0 = o[2 * q] + (q < 2 ? b0[2 * q] : b1[2 * q - 4]), z1 = o[2 * q + 1] + (q < 2 ? b0[2 * q + 1] : b1[2 * q - 3]);
                            o[2 * q] = g0 * sigmoidf_(z0); o[2 * q + 1] = g1 * sigmoidf_(z1); } }
                    u32x4 w; w.x = pk2(o[0], o[1]); w.y = pk2(o[2], o[3]); w.z = pk2(o[4], o[5]); w.w = pk2(o[6], o[7]);
                    *(u32x4*)(cat + row * 2048 + (mode == 0 ? 1024 : 1536) + col) = w; } }
    }
};

__device__ __forceinline__ void tr_item(const float* W, int K, int N, bf16_t* WT, int mode, LAS float* scr, int item, int lane) {
    const int nblk = N / 64, kb = item / nblk, nb = item - kb * nblk, k0 = 64 * kb, n0 = 64 * nb;
    const int drow0 = (mode == 0) ? n0 : ((n0 >> 7) * 256 + (mode == 2 ? 128 : 0) + (n0 & 127));
    const int c4 = lane & 15, kr = lane >> 4;
    f32x4 v[16];
#pragma unroll
    for (int i = 0; i < 16; ++i) v[i] = *(const f32x4*)(W + (size_t)(k0 + 4 * i + kr) * N + n0 + 4 * c4);
#pragma unroll
    for (int i = 0; i < 16; ++i) { LAS float* d = scr + (4 * i + kr) * 65 + 4 * c4; d[0] = v[i].x; d[1] = v[i].y; d[2] = v[i].z; d[3] = v[i].w; }
    LDS_WAIT(); asm volatile("" ::: "memory");
    const int c = lane & 7;
#pragma unroll
    for (int j = 0; j < 8; ++j) { const int n = (lane >> 3) + 8 * j; const LAS float* sp = scr + (8 * c) * 65 + n;
        u32x4 o; o.x = pk2(sp[0 * 65], sp[1 * 65]); o.y = pk2(sp[2 * 65], sp[3 * 65]); o.z = pk2(sp[4 * 65], sp[5 * 65]); o.w = pk2(sp[6 * 65], sp[7 * 65]);
        *(u32x4*)(WT + (size_t)(drow0 + n) * K + k0 + 8 * c) = o; }
    LDS_WAIT(); asm volatile("" ::: "memory");
}

__device__ __forceinline__ void prenorm_rows(const float* xl, const float* xc, bf16_t* H, const float* g, const float* modl, const float* modc, int sh_off, int sc_off,
                                             int nrows, int gw, int NGW, int lane) {
    f32x4 v[8], vn[8];
    if (gw < nrows) { const float* src = gw < L ? xl + (size_t)gw * DM : xc + (size_t)(gw - L) * DM;
#pragma unroll
        for (int j = 0; j < 8; ++j) v[j] = *(const f32x4*)(src + 4 * lane + 256 * j); }
    for (int row = gw; row < nrows; row += NGW) {
        const int nrow = row + NGW;
        if (nrow < nrows) { const float* src = nrow < L ? xl + (size_t)nrow * DM : xc + (size_t)(nrow - L) * DM;
#pragma unroll
            for (int j = 0; j < 8; ++j) vn[j] = *(const f32x4*)(src + 4 * lane + 256 * j); }
        const float* md = row < L ? modl : modc;
        float ss = 0.f;
#pragma unroll
        for (int j = 0; j < 8; ++j) ss += (v[j].x * v[j].x + v[j].y * v[j].y) + (v[j].z * v[j].z + v[j].w * v[j].w);
        const float rstd = rsqrtf(wave_sum(ss) * (1.f / DM) + EPS);
#pragma unroll
        for (int j = 0; j < 8; ++j) { const int col = 4 * lane + 256 * j;
            const f32x4 g4 = *(const f32x4*)(g + col), s4 = *(const f32x4*)(md + sc_off + col), h4 = *(const f32x4*)(md + sh_off + col);
            const f32x4 o = v[j] * rstd * g4 * (1.f + s4) + h4;
            u32x2 w; w.x = pk2(o.x, o.y); w.y = pk2(o.z, o.w); *(u32x2*)(H + (size_t)row * DM + col) = w; }
#pragma unroll
        for (int j = 0; j < 8; ++j) v[j] = vn[j];
    }
}
template <bool PL> __device__ __forceinline__ void post_rows(const float* xl_src, const float* xc_src, float* xl_dst, float* xc_dst, const bf16_t* Y, const float* wpost, const float* modl, const float* modc, int gate_off,
                                          bool do_next, bf16_t* H, const float* wpre, const float* nmodl, const float* nmodc, int sh_off, int sc_off,
                                          int row0, int nrows, int gw, int NGW, int lane, LAS float* pl, int tid, const float* yp4 = nullptr) {
    if (PL) { const int c = 4 * tid;
        *(LAS f32x4*)(pl + c) = *(const f32x4*)(wpost + c); *(LAS f32x4*)(pl + 2048 + c) = *(const f32x4*)(modl + gate_off + c);
        if (do_next) { *(LAS f32x4*)(pl + 4096 + c) = *(const f32x4*)(wpre + c); *(LAS f32x4*)(pl + 6144 + c) = *(const f32x4*)(nmodl + sc_off + c); *(LAS f32x4*)(pl + 8192 + c) = *(const f32x4*)(nmodl + sh_off + c); }
        __syncthreads(); }
    f32x4 x[8], y[8], xn[8], yn[8];
    gw += row0;
    if (gw < nrows) { const float* src = gw < L ? xl_src + (size_t)gw * DM : xc_src + (size_t)(gw - L) * DM; const bf16_t* yr = Y + (size_t)gw * DM;
#pragma unroll
        for (int j = 0; j < 8; ++j) { { if (yp4) { const float* yq = yp4 + (size_t)(gw - L) * DM + 4 * lane + 256 * j; y[j] = (*(const f32x4*)yq + *(const f32x4*)(yq + 256 * DM)) + (*(const f32x4*)(yq + 2 * 256 * DM) + *(const f32x4*)(yq + 3 * 256 * DM)); }
              else { const u32x2 yw = *(const u32x2*)(yr + 4 * lane + 256 * j); y[j] = (f32x4){bf2f(yw.x & 0xffffu), bf2f(yw.x >> 16), bf2f(yw.y & 0xffffu), bf2f(yw.y >> 16)}; } } x[j] = *(const f32x4*)(src + 4 * lane + 256 * j); } }
    for (int row = gw; row < nrows; row += NGW) {
        const bool lat = row < L;
        const int nrow = row + NGW;
        if (nrow < nrows) { const float* src = nrow < L ? xl_src + (size_t)nrow * DM : xc_src + (size_t)(nrow - L) * DM; const bf16_t* yr = Y + (size_t)nrow * DM;
#pragma unroll
            for (int j = 0; j < 8; ++j) { { if (yp4) { const float* yq = yp4 + (size_t)(nrow - L) * DM + 4 * lane + 256 * j; yn[j] = (*(const f32x4*)yq + *(const f32x4*)(yq + 256 * DM)) + (*(const f32x4*)(yq + 2 * 256 * DM) + *(const f32x4*)(yq + 3 * 256 * DM)); }
                  else { const u32x2 yw = *(const u32x2*)(yr + 4 * lane + 256 * j); yn[j] = (f32x4){bf2f(yw.x & 0xffffu), bf2f(yw.x >> 16), bf2f(yw.y & 0xffffu), bf2f(yw.y >> 16)}; } } xn[j] = *(const f32x4*)(src + 4 * lane + 256 * j); } }
        float* dst = lat ? xl_dst + (size_t)row * DM : xc_dst + (size_t)(row - L) * DM;
        const float* md = lat ? modl : modc;
        float ss = 0.f;
#pragma unroll
        for (int j = 0; j < 8; ++j) ss += (y[j].x * y[j].x + y[j].y * y[j].y) + (y[j].z * y[j].z + y[j].w * y[j].w);
        const float rstd = rsqrtf(wave_sum(ss) * (1.f / DM) + EPS);
        float s2 = 0.f;
#pragma unroll
        for (int j = 0; j < 8; ++j) { const int col = 4 * lane + 256 * j;
            const f32x4 w4 = PL ? *(const LAS f32x4*)(pl + col) : *(const f32x4*)(wpost + col), g4 = PL ? *(const LAS f32x4*)(pl + 2048 + col) : *(const f32x4*)(md + gate_off + col);
            x[j] = x[j] + g4 * (y[j] * rstd * w4);
            *(f32x4*)(dst + col) = x[j];
            s2 += (x[j].x * x[j].x + x[j].y * x[j].y) + (x[j].z * x[j].z + x[j].w * x[j].w); }
        if (do_next) {
            const float* nmd = lat ? nmodl : nmodc;
            const float rstd2 = rsqrtf(wave_sum(s2) * (1.f / DM) + EPS);
#pragma unroll
            for (int j = 0; j < 8; ++j) { const int col = 4 * lane + 256 * j;
                const f32x4 g4 = PL ? *(const LAS f32x4*)(pl + 4096 + col) : *(const f32x4*)(wpre + col), s4 = PL ? *(const LAS f32x4*)(pl + 6144 + col) : *(const f32x4*)(nmd + sc_off + col),
                            h4 = PL ? *(const LAS f32x4*)(pl + 8192 + col) : *(const f32x4*)(nmd + sh_off + col);
                const f32x4 o = x[j] * rstd2 * g4 * (1.f + s4) + h4;
                u32x2 w; w.x = pk2(o.x, o.y); w.y = pk2(o.z, o.w); *(u32x2*)(H + (size_t)row * DM + col) = w; }
        }
#pragma unroll
        for (int j = 0; j < 8; ++j) { x[j] = xn[j]; y[j] = yn[j]; }
    }
}

__device__ __forceinline__ void kq_post(const float* qraw, const float* kraw, bf16_t* qb, bf16_t* kb, const float* qn, const float* kn, const float* rope, int gw, int NGW, int lane) {
    const int j = lane & 31, hsel = lane >> 5;
    const f32x4 wq4 = *(const f32x4*)(qn + 4 * j), wk4 = *(const f32x4*)(kn + 4 * j);
    for (int it0 = gw; it0 < MT; it0 += 8 * NGW) {
        f32x4 v[8]; int rows[8], heads[8]; bool ok[8];
#pragma unroll
        for (int q = 0; q < 8; ++q) { const int it = it0 + q * NGW; ok[q] = it < MT; const int itc = ok[q] ? it : it0;
            const int row = itc, head = 8 + hsel; rows[q] = row; heads[q] = head;
            const float* src = head < 8 ? qraw + (size_t)row * 1024 + head * 128 + 4 * j : kraw + (size_t)row * 256 + (head - 8) * 128 + 4 * j;
            v[q] = *(const f32x4*)src; }
#pragma unroll
        for (int q = 0; q < 8; ++q) { const int row = rows[q], head = heads[q]; f32x4 x = v[q];
            float ss = (x.x * x.x + x.y * x.y) + (x.z * x.z + x.w * x.w);
#pragma unroll
            for (int o = 1; o < 32; o <<= 1) ss += __shfl_xor(ss, o);
            const float rstd = rsqrtf(ss * (1.f / 128.f) + EPS);
            x = x * rstd * wk4;
            f32x4 pt; pt.x = __shfl_xor(x.x, 8); pt.y = __shfl_xor(x.y, 8); pt.z = __shfl_xor(x.z, 8); pt.w = __shfl_xor(x.w, 8);
            if (row < L) {
                const int pos = (j < 16) ? (row >> 6) : (row & 63), fi = (4 * j) & 31;
                const f32x4 t0 = *(const f32x4*)(rope + (pos * 32 + fi) * 2), t1 = *(const f32x4*)(rope + (pos * 32 + fi) * 2 + 4);
                const float sg = (j & 8) ? 1.f : -1.f;
                x.x = x.x * t0.x + sg * pt.x * t0.y; x.y = x.y * t0.z + sg * pt.y * t0.w; x.z = x.z * t1.x + sg * pt.z * t1.y; x.w = x.w * t1.z + sg * pt.w * t1.w;
            }
            bf16_t* dst = head < 8 ? qb + (size_t)row * 1024 + head * 128 + 4 * j : kb + (size_t)row * 256 + (head - 8) * 128 + 4 * j;
            u32x2 o; o.x = pk2(x.x, x.y); o.y = pk2(x.z, x.w); if (ok[q]) *(u32x2*)dst = o; }
    }
}

__device__ __forceinline__ void ssm_stage_u(const float* US, LAS float* us, int k, int g, int lane) {
    const float* src = US + (size_t)(64 * k + lane) * 512 + 16 * g;
#pragma unroll
    for (int q = 0; q < 4; ++q) *(LAS f32x4*)(us + lane * 16 + 4 * q) = *(const f32x4*)(src + 4 * q);
}
__device__ __forceinline__ void ssm_bu_tile(const LAS float* us, LAS float* bu, const bf16x8 (&bfr)[8], int t0, int lane) {
    const int fr = lane & 15, fq = lane >> 4;
    const LAS float* up = us + (2 * (fq & 1)) * 256 + (t0 + fr) * 4;
    const f32x4 ua = *(const LAS f32x4*)up, ub = *(const LAS f32x4*)(up + 256);
    u32x4 aw; aw.x = pk2(ua.x, ua.y); aw.y = pk2(ua.z, ua.w); aw.z = pk2(ub.x, ub.y); aw.w = pk2(ub.z, ub.w);
    if (fq >= 2) aw = (u32x4){0u, 0u, 0u, 0u};
    const bf16x8 af = __builtin_bit_cast(bf16x8, aw);
#pragma unroll
    for (int nt = 0; nt < 8; ++nt) {
        const pg8::f32x4 d = __builtin_amdgcn_mfma_f32_16x16x32_bf16(af, bfr[nt], (pg8::f32x4){0.f, 0.f, 0.f, 0.f}, 0, 0, 0);
#pragma unroll
        for (int e = 0; e < 4; ++e) bu[(4 * fq + e) * 132 + 16 * nt + fr] = d[e];
    }
}
__device__ __forceinline__ void ssm_load_bfr(const bf16_t* BBT, bf16x8 (&bfr)[8], int ldg, int lane) {
    const int fr = lane & 15, fq = lane >> 4;
#pragma unroll
    for (int nt = 0; nt < 8; ++nt) { u32x4 w = *(const u32x4*)(BBT + ((size_t)ldg * 128 + 16 * nt + fr) * 16 + 8 * (fq & 1)); if (fq >= 2) w = (u32x4){0u, 0u, 0u, 0u}; bfr[nt] = __builtin_bit_cast(bf16x8, w); }
}
template <int DIR, bool WR> __device__ __forceinline__ void ssm_rec16(float ar, float ai, f32x2& hh, const LAS float* bu, LAS unsigned* st, int lane) {
    f32x2 b[16];
#pragma unroll
    for (int tt = 0; tt < 16; ++tt) { const int t = DIR == 0 ? tt : 15 - tt; b[tt] = (f32x2){bu[t * 132 + lane], bu[t * 132 + 64 + lane]}; }
#pragma unroll
    for (int tt = 0; tt < 16; ++tt) { const int t = DIR == 0 ? tt : 15 - tt;
        const f32x2 hs_ = {-hh.y, hh.x}; hh = b[tt] + (hh * ar + hs_ * ai);
        if (WR) st[t * 68 + lane] = pk2(hh.x, hh.y); }
}
__device__ __forceinline__ void ssm_dma_u(const float* US, LAS float* us, int k, int g, int lane) {
    const float* src = US + (size_t)(64 * k + lane) * 512 + 16 * g;
#pragma unroll
    for (int q = 0; q < 4; ++q) __builtin_amdgcn_global_load_lds((const unsigned*)(src + 4 * q), (LAS unsigned*)(us + q * 256), 16, 0, 0);
}
typedef float f32x16_t __attribute__((ext_vector_type(16)));
__device__ __forceinline__ void ssm_load_bf4(const bf16_t* BBT, bf16x8 (&bf4)[4], int ldg, int lane) {
    const int r32 = lane & 31, hi = lane >> 5;
#pragma unroll
    for (int n = 0; n < 4; ++n) bf4[n] = *(const bf16x8*)(BBT + ((size_t)ldg * 128 + 32 * n + r32) * 16 + 8 * hi);
}
#define SSM_SWAP32(a, b) { auto rr_ = __builtin_amdgcn_permlane32_swap(__float_as_uint(a), __float_as_uint(b), false, false); a = __uint_as_float(rr_[0]); b = __uint_as_float(rr_[1]); }
template <int DIR, bool WR> __device__ __forceinline__ void ssm_tile32(const LAS float* us, const bf16x8 (&bf4)[4], float ar, float ai, f32x2& hh, LAS unsigned* st, int t0, int lane) {
    const int r32 = lane & 31, hi = lane >> 5;
    const LAS float* up = us + (2 * hi) * 256 + (t0 + r32) * 4;
    const f32x4 ua = *(const LAS f32x4*)up, ub = *(const LAS f32x4*)(up + 256);
    u32x4 aw; aw.x = pk2(ua.x, ua.y); aw.y = pk2(ua.z, ua.w); aw.z = pk2(ub.x, ub.y); aw.w = pk2(ub.z, ub.w);
    const bf16x8 af = __builtin_bit_cast(bf16x8, aw);
    const f32x16_t z = {0.f, 0.f, 0.f, 0.f, 0.f, 0.f, 0.f, 0.f, 0.f, 0.f, 0.f, 0.f, 0.f, 0.f, 0.f, 0.f};
    f32x16_t dre0 = __builtin_amdgcn_mfma_f32_32x32x16_bf16(af, bf4[0], z, 0, 0, 0), dre1 = __builtin_amdgcn_mfma_f32_32x32x16_bf16(af, bf4[1], z, 0, 0, 0);
    f32x16_t dim0 = __builtin_amdgcn_mfma_f32_32x32x16_bf16(af, bf4[2], z, 0, 0, 0), dim1 = __builtin_amdgcn_mfma_f32_32x32x16_bf16(af, bf4[3], z, 0, 0, 0);
#pragma unroll
    for (int r = 0; r < 16; ++r) { SSM_SWAP32(dre0[r], dre1[r]) SSM_SWAP32(dim0[r], dim1[r]) }
#pragma unroll
    for (int tt = 0; tt < 32; ++tt) { const int t = DIR == 0 ? tt : 31 - tt; const int ri = 4 * (t >> 3) + (t & 3);
        const f32x2 b = ((t >> 2) & 1) ? (f32x2){dre1[ri], dim1[ri]} : (f32x2){dre0[ri], dim0[ri]};
        const f32x2 hs_ = {-hh.y, hh.x}; hh = b + (hh * ar + hs_ * ai);
        if (WR) st[t * 68 + lane] = pk2(hh.x, hh.y); }
}
template <int DIR> __device__ __forceinline__ void ssm_s1_run(float ar, float ai, const bf16x8 (&bf4)[4], const LAS float* us, float* o, int lane) {
    f32x2 hh = {0.f, 0.f};
    if (DIR == 0) { ssm_tile32<0, false>(us, bf4, ar, ai, hh, nullptr, 0, lane); ssm_tile32<0, false>(us, bf4, ar, ai, hh, nullptr, 32, lane); }
    else          { ssm_tile32<1, false>(us, bf4, ar, ai, hh, nullptr, 32, lane); ssm_tile32<1, false>(us, bf4, ar, ai, hh, nullptr, 0, lane); }
    o[lane] = hh.x; o[64 + lane] = hh.y;
}
template <int DIR, int T> __device__ __forceinline__ void ssm_s3_tile(float ar, float ai, const bf16x8 (&bf4)[4], const bf16x8 (&cb)[4], f32x2& hh, const LAS float* us, LAS unsigned* st, pg8::f32x4 (&yacc)[4], int lane) {
    const int fr = lane & 15, fq = lane >> 4;
    ssm_tile32<DIR, true>(us, bf4, ar, ai, hh, st, 32 * T, lane);
#pragma unroll
    for (int mt = 0; mt < 2; ++mt)
#pragma unroll
        for (int ks = 0; ks < 4; ++ks) { const bf16x8 a0 = *(const LAS bf16x8*)((const LAS unsigned char*)st + (16 * mt + fr) * 272 + (32 * ks + 8 * fq) * 2);
            yacc[2 * T + mt] = __builtin_amdgcn_mfma_f32_16x16x32_bf16(cb[ks], a0, yacc[2 * T + mt], 0, 0, 0); }
}
template <int DIR> __device__ __forceinline__ void ssm_s3_run(float ar, float ai, const bf16x8 (&bf4)[4], const bf16x8 (&cb)[4], f32x2 hh, const LAS float* us, LAS unsigned* st, pg8::f32x4 (&yacc)[4], int lane) {
    if (DIR == 0) { ssm_s3_tile<0, 0>(ar, ai, bf4, cb, hh, us, st, yacc, lane); ssm_s3_tile<0, 1>(ar, ai, bf4, cb, hh, us, st, yacc, lane); }
    else          { ssm_s3_tile<1, 1>(ar, ai, bf4, cb, hh, us, st, yacc, lane); ssm_s3_tile<1, 0>(ar, ai, bf4, cb, hh, us, st, yacc, lane); }
}
__device__ __forceinline__ void cmul_add(float& dr, float& di, float ar, float ai, float br, float bi, float cr, float ci) { dr = ar * br - ai * bi + cr; di = ar * bi + ai * br + ci; }
__device__ __forceinline__ void ssm_s2_task(const f32x4* AB, const float* S, float* HIN, int layer, int task, int lane) {
    const int p = task & 63, g = (task >> 6) & 31, dir = task >> 11;
    const f32x4 ab = AB[((layer * 2 + dir) * 32 + g) * 64 + p]; const float ar = ab.z, ai = ab.w;
    const size_t dbase = (size_t)dir * NCH * 32 * 128 + (size_t)g * 128 + p;
#define CH_OF(q) (dir == 0 ? (((q) + 256) % NCH) : (NCH - 1 - (q)))
    float h4r = 0.f, h4i = 0.f;
    for (int q = 0; q < 4; ++q) { const size_t o = dbase + (size_t)CH_OF(q) * 4096; if (lane == 0) { HIN[o] = h4r; HIN[o + 64] = h4i; }
        const float sr = S[o], si = S[o + 64]; float nr, ni; cmul_add(nr, ni, ar, ai, h4r, h4i, sr, si); h4r = nr; h4i = ni; }
    float sr[4], si[4];
#pragma unroll
    for (int i = 0; i < 4; ++i) { const size_t o = dbase + (size_t)CH_OF(4 + 4 * lane + i) * 4096; sr[i] = S[o]; si[i] = S[o + 64]; }
    float er = sr[0], ei = si[0];
#pragma unroll
    for (int i = 1; i < 4; ++i) { float nr, ni; cmul_add(nr, ni, ar, ai, er, ei, sr[i], si[i]); er = nr; ei = ni; }
    float mr, mi; { const float a2r = ar * ar - ai * ai, a2i = 2.f * ar * ai; mr = a2r * a2r - a2i * a2i; mi = 2.f * a2r * a2i; }
#pragma unroll
    for (int d = 1; d < 64; d <<= 1) {
        const float pr = __shfl_up(er, d), pi = __shfl_up(ei, d), qr = __shfl_up(mr, d), qi = __shfl_up(mi, d);
        if (lane >= d) { float nr, ni; cmul_add(nr, ni, mr, mi, pr, pi, er, ei); er = nr; ei = ni; const float tr = mr * qr - mi * qi, ti = mr * qi + mi * qr; mr = tr; mi = ti; }
    }
    float outr, outi; cmul_add(outr, outi, mr, mi, h4r, h4i, er, ei);
    float inr = __shfl_up(outr, 1), ini = __shfl_up(outi, 1);
    if (lane == 0) { inr = h4r; ini = h4i; }
#pragma unroll
    for (int i = 0; i < 4; ++i) { const size_t o = dbase + (size_t)CH_OF(4 + 4 * lane + i) * 4096; HIN[o] = inr; HIN[o + 64] = ini; float nr, ni; cmul_add(nr, ni, ar, ai, inr, ini, sr[i], si[i]); inr = nr; ini = ni; }
#undef CH_OF
}

#define MFMA16(a, b, c) __builtin_amdgcn_mfma_f32_16x16x32_bf16(a, b, c, 0, 0, 0)
__device__ __forceinline__ void fft1_task(const bf16_t* UF, bf16_t* TB, const f32x2* TW, const LAS unsigned char* w1, int task, int lane) {
    const int fr = lane & 15, fq = lane >> 4, n2 = task >> 5, cb = task & 31;
    bf16x8 xb[4];
#pragma unroll
    for (int ks = 0; ks < 4; ++ks)
#pragma unroll
        for (int i = 0; i < 8; ++i) xb[ks][i] = (short)UF[(size_t)(128 * (32 * ks + 8 * fq + i) + n2) * 512 + 16 * cb + fr];
    f32x2 twc = TW[fr * 128 + n2];
    bf16_t* tbp = TB + ((size_t)fr * 128 + n2) * 512 + 16 * cb + 4 * fq;
#pragma unroll 1
    for (int mt = 0; mt < 8; ++mt) {
        const int mn = mt < 7 ? mt + 1 : mt; const f32x2 twn = TW[(16 * mn + fr) * 128 + n2];
        pg8::f32x4 accr = {0.f, 0.f, 0.f, 0.f}, acci = {0.f, 0.f, 0.f, 0.f};
#pragma unroll
        for (int ks = 0; ks < 4; ++ks) {
            const bf16x8 wre = *(const LAS bf16x8*)(w1 + (16 * mt + fr) * 272 + (32 * ks + 8 * fq) * 2);
            const bf16x8 wim = *(const LAS bf16x8*)(w1 + (128 + 16 * mt + fr) * 272 + (32 * ks + 8 * fq) * 2);
            accr = MFMA16(xb[ks], wre, accr); acci = MFMA16(xb[ks], wim, acci);
        }
        float tr[4], ti[4];
#pragma unroll
        for (int e = 0; e < 4; ++e) { tr[e] = accr[e] * twc.x + acci[e] * twc.y; ti[e] = acci[e] * twc.x - accr[e] * twc.y; }
        u32x2 wr_; wr_.x = pk2(tr[0], tr[1]); wr_.y = pk2(tr[2], tr[3]); u32x2 wi_; wi_.x = pk2(ti[0], ti[1]); wi_.y = pk2(ti[2], ti[3]);
        *(u32x2*)tbp = wr_; *(u32x2*)(tbp + (size_t)128 * 65536) = wi_;
        tbp += (size_t)16 * 65536;
        twc = twn;
    }
}
__device__ __forceinline__ void fft2_task(const bf16_t* TB, bf16_t* XF, const LAS unsigned char* w2, int task, int lane) {
    const int fr = lane & 15, fq = lane >> 4, k1 = task >> 5, cb = task & 31, c = 16 * cb + fr, hh = cb >> 3, cc4 = (16 * cb & 127) + 4 * fq;
    bf16x8 tb[8];
#pragma unroll
    for (int ks = 0; ks < 8; ++ks)
#pragma unroll
        for (int i = 0; i < 8; ++i) { const int kk = 32 * ks + 8 * fq + i; tb[ks][i] = (short)TB[((size_t)((kk >> 7) * 128 + k1) * 128 + (kk & 127)) * 512 + c]; }
    for (int mt = 0; mt < 16; ++mt) {
        pg8::f32x4 acc = {0.f, 0.f, 0.f, 0.f};
#pragma unroll
        for (int ks = 0; ks < 8; ++ks) { const bf16x8 w = *(const LAS bf16x8*)(w2 + (16 * mt + fr) * 528 + (32 * ks + 8 * fq) * 2); acc = MFMA16(tb[ks], w, acc); }
        const int r = 16 * mt + fr, po = r >> 7, k2 = r & 127;
        u32x2 o; o.x = pk2(acc[0], acc[1]); o.y = pk2(acc[2], acc[3]);
        *(u32x2*)(XF + (size_t)(k1 + 128 * k2) * 1024 + hh * 256 + po * 128 + cc4) = o;
    }
}
__device__ __forceinline__ void fftc_task(const bf16_t* UF, bf16_t* XF, const bf16_t* WC, int task, int lane) {
    const int fr = lane & 15, fq = lane >> 4, cb = task & 31, mtg = task >> 5, c = 16 * cb + fr, hh = cb >> 3, cc4 = (16 * cb & 127) + 4 * fq;
    bf16x8 xb[8];
#pragma unroll
    for (int ks = 0; ks < 8; ++ks)
#pragma unroll
        for (int i = 0; i < 8; ++i) xb[ks][i] = (short)UF[(size_t)(L + 32 * ks + 8 * fq + i) * 512 + c];
    for (int mt = 8 * mtg; mt < 8 * mtg + 8; ++mt) {
        pg8::f32x4 acc = {0.f, 0.f, 0.f, 0.f};
#pragma unroll
        for (int ks = 0; ks < 8; ++ks) { const bf16x8 w = *(const bf16x8*)(WC + (size_t)(16 * mt + fr) * 256 + 32 * ks + 8 * fq); acc = MFMA16(xb[ks], w, acc); }
        const int r = 16 * mt + fr, po = r >> 8, kk = r & 255;
        u32x2 o; o.x = pk2(acc[0], acc[1]); o.y = pk2(acc[2], acc[3]);
        *(u32x2*)(XF + (size_t)(L + kk) * 1024 + hh * 256 + po * 128 + cc4) = o;
    }
}

#define XB_TMO      128
#define XB_XCNT(j)  (256  + 64 * (j))
#define XB_XSUB(j)  (1280 + 64 * (j))
#define XB_XGEN(j)  (2304 + 64 * (j))
#define XB_TOP      3328
#define XB_TOPGEN   3392
#define XCD_BAR_WORDS 3456
#define XB_SPIN_CAP (1u << 18)

__device__ __forceinline__ unsigned xb_ld(unsigned* p)              { return __hip_atomic_load(p, __ATOMIC_RELAXED, __HIP_MEMORY_SCOPE_AGENT); }
__device__ __forceinline__ unsigned xb_add(unsigned* p, unsigned v) { return __hip_atomic_fetch_add(p, v, __ATOMIC_RELAXED, __HIP_MEMORY_SCOPE_AGENT); }
__device__ __forceinline__ unsigned xb_xcc_id() { return (unsigned)__builtin_amdgcn_s_getreg((3 << 11) | 20) & 0xFu; }
#define XB_SPIN(cond, bar) do { unsigned _sp = 0; while (cond) { __builtin_amdgcn_s_sleep(1); \
    if ((++_sp & 255u) == 0u) { if (xb_ld(&(bar)[XB_TMO])) break; if (_sp > XB_SPIN_CAP) { atomicAdd(&(bar)[XB_TMO], 1u); break; } } } } while (0)

struct XcdBarrier {
    unsigned* bar; unsigned x;
    volatile LAS unsigned* st;
};

__device__ __forceinline__ XcdBarrier xcd_barrier_post(unsigned* bar, volatile LAS unsigned* st) {
    XcdBarrier b; b.bar = bar; b.x = xb_xcc_id(); b.st = st;
    if (threadIdx.x == 0) (void)xb_add(&bar[XB_XCNT(b.x)], 1u);
    return b;
}
__device__ __forceinline__ void xcd_barrier_complete(unsigned* bar, unsigned x, unsigned& nloc, unsigned& nx) {
    const unsigned G = gridDim.x * gridDim.y * gridDim.z;
    unsigned sum, cnt, mine, sp = 0u;
    for (;;) {
        sum = 0u; cnt = 0u; mine = 0u;
#pragma unroll
        for (unsigned j = 0; j < 16; ++j) { const unsigned c = xb_ld(&bar[XB_XCNT(j)]); sum += c; cnt += (c > 0u) ? 1u : 0u; mine = (j == x) ? c : mine; }
        if (sum == G) break;
        __builtin_amdgcn_s_sleep(1);
        if ((++sp & 255u) == 0u) { if (xb_ld(&bar[XB_TMO])) break; if (sp > XB_SPIN_CAP) { atomicAdd(&bar[XB_TMO], 1u); break; } }
    }
    nloc = mine > 0u ? mine : 1u; nx = cnt > 0u ? cnt : 1u;
}

__device__ __forceinline__ void xcd_barrier(const XcdBarrier& b) {
    asm volatile("s_waitcnt vmcnt(0)" ::: "memory");
    __syncthreads();
    if (threadIdx.x == 0) {
        unsigned* bar = b.bar;
        __builtin_amdgcn_s_waitcnt(0);
        unsigned nloc = b.st[0], nx = b.st[1];
        if (nloc == 0u) { xcd_barrier_complete(bar, b.x, nloc, nx); b.st[0] = nloc; b.st[1] = nx; }
        const unsigned old = xb_add(&bar[XB_XSUB(b.x)], 1u);
        const unsigned gen = old / nloc;
        if (old + 1u == (gen + 1u) * nloc) {
            __builtin_amdgcn_fence(__ATOMIC_RELEASE, "agent");
            asm volatile("s_waitcnt vmcnt(0)" ::: "memory");
            const unsigned og = xb_add(&bar[XB_TOP], 1u);
            const unsigned tg = og / nx;
            if (og + 1u == (tg + 1u) * nx) xb_add(&bar[XB_TOPGEN], 1u);
            else XB_SPIN(xb_ld(&bar[XB_TOPGEN]) == tg, bar);
            __builtin_amdgcn_fence(__ATOMIC_ACQUIRE, "agent");
            xb_add(&bar[XB_XGEN(b.x)], 1u);
            asm volatile("s_waitcnt vmcnt(0)" ::: "memory");
        } else {
            XB_SPIN(xb_ld(&bar[XB_XGEN(b.x)]) == gen, bar);
            __builtin_amdgcn_fence(__ATOMIC_ACQUIRE, "agent");
            asm volatile("s_waitcnt vmcnt(0)" ::: "memory");
        }
    }
    __syncthreads();
}

constexpr int TAB_OFF = LDS_BYTES - 256;
__device__ __forceinline__ const void* tabptr(LAS unsigned char* lds, int i) {
    const LAS unsigned* t = (const LAS unsigned*)(lds + TAB_OFF) + 2 * i;
    const unsigned lo = __builtin_amdgcn_readfirstlane(t[0]), hi = __builtin_amdgcn_readfirstlane(t[1]);
    return (const void*)(((unsigned long long)hi << 32) | lo);
}
#define INP(i) ((const float*)tabptr(lds, (i)))
#define PH_IDS \
    int tid = threadIdx.x; asm volatile("" : "+v"(tid)); const int lane = tid & 63, wave = __builtin_amdgcn_readfirstlane(tid >> 6); \
    int bx = blockIdx.x, G = gridDim.x; asm volatile("" : "+s"(bx), "+s"(G)); \
    const int gw = bx * 8 + wave, NGW = G * 8, gt = bx * 512 + tid, NTH = G * 512; (void)lane; (void)gw; (void)NGW; (void)gt; (void)NTH; \
    unsigned char* ws = (unsigned char*)tabptr(lds, 29); (void)ws;
#define WSP(T, off) ((T*)(ws + (off)))
__device__ __forceinline__ void conv_item(LAS unsigned char* lds, unsigned char* ws, int it, LAS float* scr, int lane) {
    const int layer = it / 10816; int r = it - layer * 10816;
    if (r < 1280) { tr_item(INP(10) + (size_t)layer * DM * INW, DM, INW, WSP(bf16_t, O_WIN) + (size_t)layer * INW * DM, 0, scr, r, lane); return; } r -= 1280;
    if (r < 1024) { tr_item(INP(24) + (size_t)layer * DM * DM, DM, DM, WSP(bf16_t, O_WOUT) + (size_t)layer * DM * DM, 0, scr, r, lane); return; } r -= 1024;
    if (r < 2816) { tr_item(INP(25) + (size_t)layer * DM * FF, DM, FF, WSP(bf16_t, O_WGU) + (size_t)layer * 2 * FF * DM, 1, scr, r, lane); return; } r -= 2816;
    if (r < 2816) { tr_item(INP(26) + (size_t)layer * DM * FF, DM, FF, WSP(bf16_t, O_WGU) + (size_t)layer * 2 * FF * DM, 2, scr, r, lane); return; } r -= 2816;
    if (r < 2816) { tr_item(INP(27) + (size_t)layer * FF * DM, FF, DM, WSP(bf16_t, O_WDN) + (size_t)layer * DM * FF, 0, scr, r, lane); return; } r -= 2816;
    tr_item(INP(21) + (size_t)layer * 512 * 512, 512, 512, WSP(bf16_t, O_WGLU) + (size_t)layer * 512 * 512, 0, scr, r, lane);
}
constexpr int CONV_P0 = 6552;
constexpr int CONV_B = 6616;
constexpr int CONV_A = 4200;

#define GSYNC() do { XcdBarrier b_; b_.bar = (unsigned*)((unsigned char*)tabptr(lds, 29) + O_BAR); b_.x = xb_xcc_id(); b_.st = (volatile LAS unsigned*)(lds + TAB_OFF - 16); xcd_barrier(b_); } while (0)

#ifndef PROBE_CAT
#define PROBE_CAT 0
#endif
#if PROBE_CAT
#define PB(cat) do { if (PROBE_CAT == (cat)) t_st = __builtin_amdgcn_s_memrealtime(); } while (0)
#define PE(cat) do { if (PROBE_CAT == (cat)) t_acc += __builtin_amdgcn_s_memrealtime() - t_st; } while (0)
#else
#define PB(cat) do {} while (0)
#define PE(cat) do {} while (0)
#endif
__global__ void __launch_bounds__(512, 2) hybrid_fwd(Params P) {
    extern __shared__ __attribute__((aligned(16))) unsigned char lds_raw[];
    cg::grid_group grid = cg::this_grid();
#if PROBE_CAT
    unsigned long long t_acc = 0, t_st = 0;
#endif
    LAS unsigned char* lds = (LAS unsigned char*)lds_raw;
    if (threadIdx.x == 0) {
        LAS unsigned long long* t = (LAS unsigned long long*)(lds + TAB_OFF);
#pragma unroll
        for (int i = 0; i < 28; ++i) t[i] = (unsigned long long)P.in[i];
        t[28] = (unsigned long long)P.out; t[29] = (unsigned long long)P.ws;
        LAS unsigned* xst = (LAS unsigned*)(lds + TAB_OFF - 16); xst[0] = 0u; xst[1] = 0u;
        (void)xb_add((unsigned*)(P.ws + O_BAR) + XB_XCNT(xb_xcc_id()), 1u);
    }
    __syncthreads();

    PB(5);
    {
        PH_IDS
        LAS float* sl = (LAS float*)lds;
        LAS float* ct = (LAS float*)(lds + 16384);
        { const float* cin = INP(1); const float* cctx = INP(3);
          for (int i = tid; i < 2048; i += 512) { const float a = cin[i], b = cctx[i]; sl[i] = a / (1.f + expf(-a)); sl[2048 + i] = b / (1.f + expf(-b)); } }
        if (tid < 128) ct[tid] = cospif((float)tid * (1.f / 64.f));
        __syncthreads();
        { const float* adaw = INP(4); float* MODP = WSP(float, O_MODP);
          for (int it = gt; it < 98304; it += NTH) {
            const int kc = it / 6144, r = it - kc * 6144, layer = r / 3072, c4 = r - layer * 3072;
            const float* w = adaw + ((size_t)layer * 2048 + kc * 128) * 12288 + 4 * c4;
            f32x4 a0 = {0.f, 0.f, 0.f, 0.f}, a1 = {0.f, 0.f, 0.f, 0.f};
#pragma unroll 8
            for (int k = 0; k < 128; ++k) { const f32x4 wv = *(const f32x4*)(w + (size_t)k * 12288); const float s0 = sl[kc * 128 + k], s1 = sl[2048 + kc * 128 + k]; a0 += wv * s0; a1 += wv * s1; }
            float* o = MODP + ((size_t)(kc * 2 + layer) * 2) * 12288 + 4 * c4;
            *(f32x4*)o = a0; *(f32x4*)(o + 12288) = a1;
          } }
        { float* ROPE = WSP(float, O_ROPE);
          for (int it = gt; it < 8192; it += NTH) { const int pos = it >> 5, i = it & 31; const float freq = powf(10000.f, -(float)i * (1.f / 32.f)); const float ang = (float)pos * freq;
            const double a = (double)ang, kq = rint(a * 0.15915494309189535), rr = a - kq * 6.283185307179586; const float rf = (float)rr; ROPE[2 * it] = cosf(rf); ROPE[2 * it + 1] = sinf(rf); } }
        { const float* lamre = INP(13); const float* lamim = INP(14); const float* logdt = INP(15); const float* bre = INP(16); const float* bim = INP(17); const float* cre = INP(18); const float* cim = INP(19);
          f32x4* AB = WSP(f32x4, O_AB); unsigned* BBT32 = WSP(unsigned, O_BBT); unsigned* CB32 = WSP(unsigned, O_CB);
          for (int it = gt; it < 8192; it += NTH) {
            const int p = it & 63;
            const float lr = lamre[it], li = lamim[it], ldt = logdt[it >> 6];
            const float dt = expf(ldt), mag = expf(lr * dt), th = li * dt;
            const float ar = mag * cosf(th), ai = mag * sinf(th);
            const float den = lr * lr + li * li, cr = ((ar - 1.f) * lr + ai * li) / den, ci = (ai * lr - (ar - 1.f) * li) / den;
            float pr = ar, pi = ai;
#pragma unroll
            for (int s = 0; s < 6; ++s) { const float nr = pr * pr - pi * pi, ni = 2.f * pr * pi; pr = nr; pi = ni; }
            AB[it] = (f32x4){ar, ai, pr, pi};
#pragma unroll
            for (int h = 0; h < 16; h += 2) { const float br0 = bre[(size_t)it * 16 + h], bi0 = bim[(size_t)it * 16 + h], br1 = bre[(size_t)it * 16 + h + 1], bi1 = bim[(size_t)it * 16 + h + 1];
                BBT32[((size_t)(it >> 6) * 128 + p) * 8 + (h >> 1)] = pk2(cr * br0 - ci * bi0, cr * br1 - ci * bi1);
                BBT32[((size_t)(it >> 6) * 128 + 64 + p) * 8 + (h >> 1)] = pk2(cr * bi0 + ci * br0, cr * bi1 + ci * br1); }
#pragma unroll
            for (int h = 0; h < 16; ++h) { const size_t ci_ = ((size_t)(it >> 6) * 16 + h) * 64 + p; CB32[ci_] = pk2(cre[ci_], -cim[ci_]); }
          } }
        { bf16_t* W1 = WSP(bf16_t, O_W1); bf16_t* W2 = WSP(bf16_t, O_W2); bf16_t* WC = WSP(bf16_t, O_WC); f32x2* TW = WSP(f32x2, O_TW);
          for (int it = gt; it < 32768; it += NTH) { const int r = it >> 7, n1 = it & 127, m = ((r & 127) * n1) & 127; const float x = (float)m * (1.f / 64.f); W1[it] = f2bf(r < 128 ? cospif(x) : -sinpif(x)); }
          for (int it = gt; it < 65536; it += NTH) { const int r = it >> 8, kk = it & 255, po = r >> 7, k2 = r & 127, pi_ = kk >> 7, n2 = kk & 127, m = (k2 * n2) & 127; const float x = (float)m * (1.f / 64.f);
            const float cv = cospif(x), sv = sinpif(x); W2[it] = f2bf(po == pi_ ? cv : (po == 0 ? sv : -sv)); }
          for (int it = gt; it < 131072; it += NTH) { const int r = it >> 8, n = it & 255, part = r >> 8, k = r & 255, m = (k * n) & 255; const float x = (float)m * (1.f / 128.f); WC[it] = f2bf(8.f * (part == 0 ? cospif(x) : -sinpif(x))); }
          for (int it = gt; it < 16384; it += NTH) { const int k1 = it >> 7, n2 = it & 127; const float x = (float)(k1 * n2) * (1.f / 8192.f); TW[it] = (f32x2){cospif(x), sinpif(x)}; } }
        { const float* fwp = INP(23); bf16_t* WF = WSP(bf16_t, O_WF);
          for (int it = gt; it < 2 * 131072; it += NTH) { const int layer = it >> 17, r = it & 131071, n4 = r & 127, kk = r >> 7, hh = kk >> 8, part = (kk >> 7) & 1, c = kk & 127;
            const float* fw = fwp + (size_t)layer * 262144 + (size_t)(hh * 128) * 512 + 4 * n4; f32x4 acc = {0.f, 0.f, 0.f, 0.f};
#pragma unroll 4
            for (int j = 0; j < 128; ++j) { const int m = (c * j) & 127; const float t = part ? ct[(m + 96) & 127] : ct[m]; acc += *(const f32x4*)(fw + (size_t)j * 512) * t; }
            bf16_t* o = WF + (size_t)layer * 524288 + (size_t)(4 * n4) * 1024 + kk;
            o[0] = f2bf(acc.x * 6.9053396600248786e-4f); o[1024] = f2bf(acc.y * 6.9053396600248786e-4f); o[2048] = f2bf(acc.z * 6.9053396600248786e-4f); o[3072] = f2bf(acc.w * 6.9053396600248786e-4f); } }
        __syncthreads();
        { LAS float* scr = (LAS float*)(lds + wave * 16640);
          if (G == 256) { for (int it = gw; it < CONV_P0 + 64; it += NGW) conv_item(lds, ws, it < CONV_P0 ? it : 10752 + (it - CONV_P0), scr, lane); }
          else { for (int it = gw; it < 2 * 10816; it += NGW) conv_item(lds, ws, it, scr, lane); } }
    }
    grid.sync();
    {
        PH_IDS
        const float* adab = INP(5); const float* MODP = WSP(float, O_MODP); float* MOD = WSP(float, O_MOD);
        for (int it = gt; it < 49152; it += NTH) { const int layer = it / 24576, v = (it / 12288) & 1, col = it % 12288; float s = adab[layer * 12288 + col];
#pragma unroll
            for (int kc = 0; kc < 16; ++kc) s += MODP[((size_t)(kc * 2 + layer) * 2 + v) * 12288 + col];
            MOD[it] = s; }
    }
    GSYNC();
    PE(5); PB(4);
    {
        PH_IDS
        const float* MOD = WSP(float, O_MOD);
        prenorm_rows(INP(0), INP(2), WSP(bf16_t, O_H), INP(6), MOD, MOD + 12288, 0, 2048, MT, gw, NGW, lane);
    }
    GSYNC();

    PE(4);
#pragma unroll 1
    for (int layer = 0; layer < 2; ++layer) {
        PB(1);
        { PH_IDS
          pg8::Gemm g{WSP(bf16_t, O_H), WSP(bf16_t, O_WIN) + (size_t)layer * INW * DM, MT, INW, DM}; pg8::StaticOrder S; S.init(MT, INW, G, bx);
          EpiIn E{WSP(float, O_QRAW), WSP(float, O_KRAW), WSP(bf16_t, O_VB), WSP(float, O_US), WSP(bf16_t, O_UF)};
          pg8::gemm_phase<EpiIn, pg8::StaticOrder, true, true>(lds, g, S, E);
          if (G == 256 && bx >= 138) { LAS float* scr = (LAS float*)(lds + wave * 16640);
              if (layer == 0) { for (int r = CONV_P0 + (bx - 138) * 8 + wave; r < 10752; r += 118 * 8) conv_item(lds, ws, r, scr, lane); }
              else            { for (int r = CONV_B + (bx - 138) * 8 + wave; r < 10816; r += 118 * 8) conv_item(lds, ws, 10816 + r, scr, lane); } } }
        GSYNC();
        PE(1); PB(3); PB(31);
        {
            PH_IDS
            { const bf16_t* W1 = WSP(bf16_t, O_W1);
              for (int i = tid; i < 256 * 16; i += 512) { const int r = i >> 4, ch = i & 15; *(LAS u32x4*)(lds + r * 272 + ch * 16) = *(const u32x4*)(W1 + r * 128 + ch * 8); } }
            __syncthreads();
            { const bf16_t* UF = WSP(bf16_t, O_UF); bf16_t* TB = WSP(bf16_t, O_TB); const f32x2* TW = WSP(f32x2, O_TW);
              for (int task = gw; task < 4096; task += NGW) fft1_task(UF, TB, TW, lds, task, lane); }
            { LAS float* usb = (LAS float*)(lds + 69632 + wave * 8192);
              const float* US = WSP(float, O_US); const f32x4* AB = WSP(f32x4, O_AB); const bf16_t* BBT = WSP(bf16_t, O_BBT); float* SS = WSP(float, O_S);
              int cur = 0;
              if (gw < NCH * 32) ssm_dma_u(US, usb, gw >> 5, gw & 31, lane);
              for (int task = gw; task < NCH * 32; task += NGW) { const int k = task >> 5, g = task & 31, nxt = task + NGW;
                asm volatile("s_waitcnt vmcnt(0)" ::: "memory");
                if (nxt < NCH * 32) ssm_dma_u(US, usb + (cur ^ 1) * 1024, nxt >> 5, nxt & 31, lane);
                const int ldg0 = (layer * 2) * 32 + g, ldg1 = ldg0 + 32;
                const f32x4 ab0 = AB[ldg0 * 64 + lane], ab1 = AB[ldg1 * 64 + lane];
                const LAS float* us = usb + cur * 1024;
                bf16x8 bf0[4], bf1[4]; ssm_load_bf4(BBT, bf0, ldg0, lane); ssm_load_bf4(BBT, bf1, ldg1, lane);
                ssm_s1_run<0>(ab0.x, ab0.y, bf0, us, SS + ((size_t)(0 * NCH + k) * 32 + g) * 128, lane);
                ssm_s1_run<1>(ab1.x, ab1.y, bf1, us, SS + ((size_t)(1 * NCH + k) * 32 + g) * 128, lane);
                cur ^= 1; } }
            kq_post(WSP(float, O_QRAW), WSP(float, O_KRAW), WSP(bf16_t, O_QB), WSP(bf16_t, O_KB), INP(11) + layer * 128, INP(12) + layer * 128, WSP(float, O_ROPE), gw, NGW, lane);
        }
        GSYNC();
        PE(31); PB(32);
        {
            PH_IDS
            { const bf16_t* W2 = WSP(bf16_t, O_W2);
              for (int i = tid; i < 256 * 32; i += 512) { const int r = i >> 5, ch = i & 31; *(LAS u32x4*)(lds + r * 528 + ch * 16) = *(const u32x4*)(W2 + r * 256 + ch * 8); } }
            __syncthreads();
            { const f32x4* AB = WSP(f32x4, O_AB); const float* SS = WSP(float, O_S); float* HIN = WSP(float, O_HIN);
              for (int task = gw; task < 4096; task += NGW) ssm_s2_task(AB, SS, HIN, layer, task, lane); }
            { const bf16_t* TB = WSP(bf16_t, O_TB); bf16_t* XF = WSP(bf16_t, O_XF);
              for (int task = gw; task < 4096; task += NGW) fft2_task(TB, XF, lds, task, lane); }
            if (layer == 0) { const bf16_t* UF = WSP(bf16_t, O_UF); bf16_t* XF = WSP(bf16_t, O_XF); const bf16_t* WC = WSP(bf16_t, O_WC);
              for (int task = gw; task < 128; task += NGW) fftc_task(UF, XF, WC, task, lane); }
        }
        GSYNC();
        PE(32); PB(33);
        {
            PH_IDS
            LAS float* usb = (LAS float*)(lds + wave * 16896);
            LAS unsigned* st = (LAS unsigned*)(lds + wave * 16896 + 8192);
            const int fr = lane & 15, fq = lane >> 4;
            const int ntask = (layer == 0 ? NCH : 256) * 32;
            const float* US = WSP(float, O_US); const f32x4* AB = WSP(f32x4, O_AB); const bf16_t* BBT = WSP(bf16_t, O_BBT); const bf16_t* CB = WSP(bf16_t, O_CB); const float* HIN = WSP(float, O_HIN);
            bf16_t* GB = WSP(bf16_t, O_G); const float* dvp = INP(20) + layer * 512;
            int cur = 0;
            if (gw < ntask) ssm_dma_u(US, usb, gw >> 5, gw & 31, lane);
            for (int task = gw; task < ntask; task += NGW) { const int k = task >> 5, g = task & 31, nxt = task + NGW;
                asm volatile("s_waitcnt vmcnt(0)" ::: "memory");
                if (nxt < ntask) ssm_dma_u(US, usb + (cur ^ 1) * 1024, nxt >> 5, nxt & 31, lane);
                const int ldg0 = (layer * 2) * 32 + g, ldg1 = ldg0 + 32;
                const f32x4 ab0 = AB[ldg0 * 64 + lane], ab1 = AB[ldg1 * 64 + lane];
                const float* hin0 = HIN + ((size_t)(0 * NCH + k) * 32 + g) * 128; const float* hin1 = HIN + ((size_t)(1 * NCH + k) * 32 + g) * 128;
                const f32x2 hh0 = {hin0[lane], hin0[64 + lane]}, hh1 = {hin1[lane], hin1[64 + lane]};
                const f32x4 dv4 = *(const f32x4*)(dvp + 16 * g + 4 * fq);
                bf16x8 cb0[4], cb1[4];
#pragma unroll
                for (int ks = 0; ks < 4; ++ks) { cb0[ks] = *(const bf16x8*)(CB + ((size_t)(ldg0 * 16 + fr)) * 128 + 32 * ks + 8 * fq); cb1[ks] = *(const bf16x8*)(CB + ((size_t)(ldg1 * 16 + fr)) * 128 + 32 * ks + 8 * fq); }
                const LAS float* us = usb + cur * 1024;
                pg8::f32x4 yacc[4];
#pragma unroll
                for (int q = 0; q < 4; ++q) yacc[q] = (pg8::f32x4){0.f, 0.f, 0.f, 0.f};
                bf16x8 bf0[4], bf1[4]; ssm_load_bf4(BBT, bf0, ldg0, lane); ssm_load_bf4(BBT, bf1, ldg1, lane);
                ssm_s3_run<0>(ab0.x, ab0.y, bf0, cb0, hh0, us, st, yacc, lane);
                ssm_s3_run<1>(ab1.x, ab1.y, bf1, cb1, hh1, us, st, yacc, lane);
#pragma unroll
                for (int q = 0; q < 4; ++q) { const int tok = 16 * q + fr; const f32x4 u4 = *(const LAS f32x4*)(us + fq * 256 + tok * 4);
                    const float y0 = gelu_tanh(yacc[q][0] + dv4.x * u4.x), y1 = gelu_tanh(yacc[q][1] + dv4.y * u4.y), y2 = gelu_tanh(yacc[q][2] + dv4.z * u4.z), y3 = gelu_tanh(yacc[q][3] + dv4.w * u4.w);
                    u32x2 o; o.x = pk2(y0, y1); o.y = pk2(y2, y3); *(u32x2*)(GB + (size_t)(64 * k + tok) * 512 + 16 * g + 4 * fq) = o; }
                cur ^= 1;
            }
        }
        GSYNC();
        PE(3); PE(33); PB(6);
        { PH_IDS
          const int MR = layer == 0 ? MT : L;
          pg8::Gemm g{WSP(bf16_t, O_G), WSP(bf16_t, O_WGLU) + (size_t)layer * 512 * 512, MR, 512, 512}; pg8::StaticOrder S; S.init(MR, 512, G, bx);
          EpiMix E{WSP(bf16_t, O_CAT), WSP(bf16_t, O_G), INP(22) + layer * 512, 0};
          pg8::gemm_phase<EpiMix, pg8::StaticOrder, true, true>(lds, g, S, E); }
        __syncthreads();
        { PH_IDS
          const int MR = layer == 0 ? MT : L;
          pg8::Gemm g{WSP(bf16_t, O_XF), WSP(bf16_t, O_WF) + (size_t)layer * 524288, MR, 512, 1024}; pg8::StaticOrder S; S.init(MR, 512, G, (bx + 128) % G);
          EpiMix E{WSP(bf16_t, O_CAT), WSP(bf16_t, O_G), INP(22) + layer * 512, 1};
          pg8::gemm_phase<EpiMix, pg8::StaticOrder, true, true>(lds, g, S, E); }
        __syncthreads();
        PE(6); PB(2);
        { PH_IDS
          const float* q_ = WSP(const float, O_QRAW); const att::bf16* k_ = WSP(const att::bf16, O_KB); const att::bf16* v_ = WSP(const att::bf16, O_VB); att::bf16* o_ = WSP(att::bf16, O_CAT);
          const float* wqn = INP(11) + layer * 128; const float* ropet = WSP(float, O_ROPE);
          float negB;
          { const float* qn = INP(11) + layer * 128; const float* kn = INP(12) + layer * 128;
            float wq = fmaxf(fabsf(qn[lane]), fabsf(qn[64 + lane])), wk = fmaxf(fabsf(kn[lane]), fabsf(kn[64 + lane]));
#pragma unroll
            for (int o = 1; o < 64; o <<= 1) { wq = fmaxf(wq, __shfl_xor(wq, o)); wk = fmaxf(wk, __shfl_xor(wk, o)); }
            negB = -(16.32212f * wq * wk * 1.02f + 0.25f); }
          for (int u = bx; u < 512; u += G) { const int xcd = u & 7, j = (u >> 3) & 31, rr = u >> 8, kvh = xcd & 1, head = 4 * kvh + (xcd >> 1), qb = j + 32 * rr;
              att::attn_dense_body<float>(q_ + (size_t)qb * 256 * 1024 + head * 128, k_ + kvh * 128, v_ + kvh * 128, o_ + (size_t)qb * 256 * 2048 + head * 128, MT, (char*)lds_raw, negB, wqn, ropet, qb * 256);
              __syncthreads(); }
          if (layer == 0 && bx >= 8 && bx < 16) { const int head = bx - 8, kvh = head >> 2;
              att::attn_dense_body<float>(q_ + (size_t)L * 1024 + head * 128, k_ + (size_t)L * 256 + kvh * 128, v_ + (size_t)L * 256 + kvh * 128, o_ + (size_t)L * 2048 + head * 128, 256, (char*)lds_raw, negB, wqn, ropet, -1);
              __syncthreads(); }
        }
        GSYNC();
        PE(2); PB(1);
        { PH_IDS
          pg8::Gemm g{WSP(bf16_t, O_CAT), WSP(bf16_t, O_WOUT) + (size_t)layer * DM * DM, L, DM, DM}; pg8::StaticOrder S; S.init(L, DM, G, bx);
          EpiF32 E{WSP(bf16_t, O_Y), DM};
          pg8::gemm_phase<EpiF32, pg8::StaticOrder, true, true>(lds, g, S, E); }
        GSYNC();
        PE(1); PB(4);
        { PH_IDS
          const bool ctxl = (layer == 0) && (G > 16);
          if (ctxl && bx < 8) {
              pg8::Gemm g{WSP(bf16_t, O_CAT) + (size_t)L * DM, WSP(bf16_t, O_WOUT) + (size_t)layer * DM * DM, 256, DM, DM}; pg8::StaticOrder S; S.init(256, DM, 8, bx);
              EpiF32 E{WSP(bf16_t, O_Y) + (size_t)L * DM, DM};
              pg8::gemm_phase<EpiF32, pg8::StaticOrder, true, true>(lds, g, S, E);
          } else {
              const float* modl = WSP(float, O_MOD) + (size_t)layer * 24576; const float* modc = modl + 12288;
              float* outp = (float*)tabptr(lds, 28); float* XC = WSP(float, O_XC);
              const float* xl_src = layer == 0 ? INP(0) : outp; const float* xc_src = layer == 0 ? INP(2) : XC;
              const int gwp = ctxl ? gw - 64 : gw, ngwp = ctxl ? NGW - 64 : NGW;
              post_rows<true>(xl_src, xc_src, outp, XC, WSP(bf16_t, O_Y), INP(7) + layer * DM, modl, modc, 2 * 2048, true, WSP(bf16_t, O_H), INP(8) + layer * DM, modl, modc, 3 * 2048, 4 * 2048,
                        0, L, gwp, ngwp, lane, (LAS float*)lds, tid);
          } }
        GSYNC();
        if (layer == 0 && gridDim.x > 16) {
            { PH_IDS
              const float* modl = WSP(float, O_MOD); const float* modc = modl + 12288; float* outp = (float*)tabptr(lds, 28); float* XC = WSP(float, O_XC);
              post_rows<false>(INP(0), INP(2), outp, XC, WSP(bf16_t, O_Y), INP(7), modl, modc, 2 * 2048, true, WSP(bf16_t, O_H), INP(8), modl, modc, 3 * 2048, 4 * 2048, L, MT, gw, NGW, lane, (LAS float*)lds, tid); }
            GSYNC();
        }
        PE(4); PB(1);
        { PH_IDS
          const int MR = layer == 0 ? MT : L;
          pg8::Gemm g{WSP(bf16_t, O_H), WSP(bf16_t, O_WGU) + (size_t)layer * 2 * FF * DM, MR, 2 * FF, DM}; pg8::StaticOrder S; S.init(MR, 2 * FF, G, bx);
          EpiUp E{WSP(bf16_t, O_HID)};
          pg8::gemm_phase<EpiUp, pg8::StaticOrder, true, true>(lds, g, S, E);
          if (layer == 0 && G == 256 && bx >= 44) { LAS float* scr = (LAS float*)(lds + wave * 16640);
              for (int r = (bx - 44) * 8 + wave; r < CONV_B; r += 212 * 8) conv_item(lds, ws, 10816 + r, scr, lane); } }
        GSYNC();
        { PH_IDS
          pg8::Gemm g{WSP(bf16_t, O_HID), WSP(bf16_t, O_WDN) + (size_t)layer * DM * FF, L, DM, FF}; pg8::StaticOrder S; S.init(L, DM, G, bx);
          EpiF32 E{WSP(bf16_t, O_Y), DM};
          pg8::gemm_phase<EpiF32, pg8::StaticOrder, true, true>(lds, g, S, E); }
        GSYNC();
        PE(1); PB(4);
        { PH_IDS
          const bool ctxl = (layer == 0) && (G > 16);
          if (ctxl && bx < 32) {
              const int kp = bx >> 3;
              pg8::Gemm g{WSP(bf16_t, O_HID) + (size_t)L * FF + kp * (FF / 4), WSP(bf16_t, O_WDN) + (size_t)layer * DM * FF + kp * (FF / 4), 256, DM, FF / 4, FF}; pg8::StaticOrder S; S.init(256, DM, 8, bx & 7);
              EpiP32 E{WSP(float, O_YP) + (size_t)kp * 256 * DM, DM};
              pg8::gemm_phase<EpiP32, pg8::StaticOrder, true, true>(lds, g, S, E);
          } else {
              const float* modl = WSP(float, O_MOD) + (size_t)layer * 24576; const float* modc = modl + 12288; const float* nmodl = modl + 24576;
              float* outp = (float*)tabptr(lds, 28); float* XC = WSP(float, O_XC);
              const int gwp = ctxl ? gw - 256 : gw, ngwp = ctxl ? NGW - 256 : NGW;
              post_rows<true>(outp, XC, outp, XC, WSP(bf16_t, O_Y), INP(9) + layer * DM, modl, modc, 5 * 2048, layer == 0, WSP(bf16_t, O_H), INP(6) + (layer + 1) * DM, nmodl, nmodl + 12288, 0, 2048,
                        0, L, gwp, ngwp, lane, (LAS float*)lds, tid);
          } }
        GSYNC();
        if (layer == 0 && gridDim.x > 16) {
            { PH_IDS
              const float* modl = WSP(float, O_MOD); const float* modc = modl + 12288; const float* nmodl = modl + 24576; float* outp = (float*)tabptr(lds, 28); float* XC = WSP(float, O_XC);
              post_rows<false>(outp, XC, outp, XC, WSP(bf16_t, O_Y), INP(9), modl, modc, 5 * 2048, true, WSP(bf16_t, O_H), INP(6) + DM, nmodl, nmodl + 12288, 0, 2048, L, MT, gw, NGW, lane, (LAS float*)lds, tid, WSP(float, O_YP)); }
            GSYNC();
        }
        PE(4);
    }
#if PROBE_CAT == 9
    for (int i = 0; i < 40; ++i) grid.sync();
#endif
#if PROBE_CAT
    if (blockIdx.x == 0) { const unsigned long long t0 = __builtin_amdgcn_s_memrealtime(); while (__builtin_amdgcn_s_memrealtime() - t0 < t_acc) __builtin_amdgcn_s_sleep(8); }
#endif
}

extern "C" void kernel_launch(void* const* d_in, const int* in_sizes, int n_in, void* d_out, int out_size, void* d_ws, size_t ws_size, hipStream_t stream) {
    static int grid = 0;
    if (grid == 0) {
        if (n_in != 28 || ws_size < WS_END) { fprintf(stderr, "kernel_launch: n_in %d (want 28), ws %zu (want >= %zu)\n", n_in, ws_size, (size_t)WS_END); grid = -1; return; }
        int dev = 0, cus = 0, per_cu = 0;
        (void)hipGetDevice(&dev); (void)hipDeviceGetAttribute(&cus, hipDeviceAttributeMultiprocessorCount, dev);
        if (hipFuncSetAttribute((const void*)hybrid_fwd, hipFuncAttributeMaxDynamicSharedMemorySize, LDS_BYTES) != hipSuccess) { fprintf(stderr, "kernel_launch: hipFuncSetAttribute failed\n"); grid = -1; return; }
        if (hipOccupancyMaxActiveBlocksPerMultiprocessor(&per_cu, (const void*)hybrid_fwd, 512, LDS_BYTES) != hipSuccess || per_cu < 1) { fprintf(stderr, "kernel_launch: occupancy query gave %d\n", per_cu); per_cu = 1; }
        (void)hipGetLastError();
        grid = cus * 1;
        if (grid <= 0) grid = 256;
    }
    if (grid < 0) return;
    Params p{};
    for (int i = 0; i < 28; ++i) p.in[i] = (const float*)d_in[i];
    p.out = (float*)d_out; p.ws = (unsigned char*)d_ws;
    (void)hipMemsetAsync((unsigned char*)d_ws + O_BAR, 0, 16384, stream);
    void* args[] = {&p};
    hipError_t e = hipLaunchCooperativeKernel((const void*)hybrid_fwd, dim3(grid), dim3(512), args, LDS_BYTES, stream);
    if (e != hipSuccess) fprintf(stderr, "kernel_launch: cooperative launch failed: %s (grid %d)\n", hipGetErrorString(e), grid);
}
```

```cpp
#include <hip/hip_runtime.h>
#include <hip/hip_cooperative_groups.h>
#include <hip/hip_bf16.h>
#include <cstdio>
#include <cstdint>
#include <cmath>
namespace cg = cooperative_groups;
namespace pg8 {
#define PG8_LAS __attribute__((address_space(3)))
typedef unsigned short bf16_t;
typedef short bf16x8 __attribute__((ext_vector_type(8)));
typedef float f32x4 __attribute__((ext_vector_type(4)));
typedef unsigned u32x4 __attribute__((ext_vector_type(4)));
constexpr int BM = 256, BK = 64, HALF = 128, HTB = HALF * BK * 2  , STAGE_BYTES = 8 * HTB, NXCD = 8, WGM = 8;

__host__ __device__ __forceinline__ int lds_byte(int r, int c) { const int st = (r >> 4) * 2 + (c >> 5), rr = r & 15, cc = c & 31, ob = rr * 64 + cc * 2; return st * 1024 + (ob ^ (((ob >> 9) & 1) << 5)); }
__host__ __device__ __forceinline__ void stage_rc(int b, int& R, int& C) { const int st = b / 1024, sb = b % 1024, swz = sb ^ (((sb >> 9) & 1) << 5); R = (st >> 1) * 16 + swz / 64; C = (st & 1) * 32 + (swz % 64) / 2; }
__host__ __device__ __forceinline__ int perm32(int rho) { const int n = rho >> 4, i = rho & 15; return 8 * (i >> 2) + 4 * n + (i & 3); }

struct Unit { int pm, pn; };
struct Gemm { const bf16_t* A; const bf16_t* Bt; int M, N, K; int ld = 0; };

struct StaticOrder {
    int nM, nN, nwg, G, c;
    __host__ __device__ void init(int M, int N, int G_, int c_) { nM = M / BM; nN = N / BM; nwg = nM * nN; G = G_; c = c_; }
    __host__ __device__ bool next(int i, Unit& u) const {
        const long L = (long)i * G + c; if (L >= nwg) return false;
        int wgid = (int)L; { const int q = nwg / NXCD, r = nwg % NXCD, xcd = wgid % NXCD, off = wgid / NXCD; wgid = (xcd < r ? xcd * (q + 1) : r * (q + 1) + (xcd - r) * q) + off; }
        const int nig = WGM * nN, gid = wgid / nig, fm = gid * WGM, gsz = (nM - fm) < WGM ? (nM - fm) : WGM;
        u.pm = fm + ((wgid % nig) % gsz); u.pn = (wgid % nig) / gsz; return true;
    }
    __device__ __forceinline__ void a_ready(const Unit&) const {}
    __device__ __forceinline__ void done(const Unit&) const {}
};

__device__ __forceinline__ unsigned cvt_pk_bf16(float lo, float hi) { unsigned r; asm volatile("v_cvt_pk_bf16_f32 %0, %1, %2" : "=v"(r) : "v"(lo), "v"(hi)); return r; }
typedef float f32x2 __attribute__((ext_vector_type(2)));
template <class Epi, class Sched, bool ALIGN_EPI = false, bool SP2 = false>
__device__ __forceinline__ void gemm_phase(PG8_LAS unsigned char* lds, const Gemm g, const Sched& S, const Epi& E) {
    int tid_ = threadIdx.x; asm volatile("" : "+v"(tid_)); const int tid = tid_, wid = __builtin_amdgcn_readfirstlane(tid >> 6), lane = tid & 63, wr = wid >> 2, wc = wid & 3, fr = lane & 15, fq = lane >> 4;
    const int nt = g.K / BK, K = g.ld ? g.ld : g.K;
    unsigned voffA[2], voffB[2];
#pragma unroll
    for (int i = 0; i < 2; ++i) { int R, C; stage_rc(tid * 16 + i * 8192, R, C); const int Rb = Epi::PERM ? ((R & ~31) + perm32(R & 31)) : R;
        voffA[i] = (unsigned)(R * K + C) * 2u; voffB[i] = (unsigned)(Rb * K + C) * 2u; }
    const size_t kstep = (size_t)(BK * 2);
    const size_t hstep = (size_t)HALF * K * 2;
    const size_t tstep = 2 * hstep;
    const unsigned ldsw = (unsigned)wid * 1024u;
    const int aoff = lds_byte(wr * 64 + fr, fq * 8), boff = lds_byte(wc * 32 + fr, fq * 8);
#define PG8_SA(b, h) (((b) * 2 + (h)) * HTB)
#define PG8_SB(b, h) ((4 + (b) * 2 + (h)) * HTB)
#define PG8_STAGE(bufoff, gbase, voff) do { _Pragma("unroll") for (int _i = 0; _i < 2; ++_i) \
        __builtin_amdgcn_global_load_lds((const unsigned*)((const char*)(gbase) + (voff)[_i]), (PG8_LAS unsigned*)(lds + (bufoff) + ldsw + _i * 8192), 16, 0, 0); } while (0)
#define PG8_LDA(dst, b, h) do { _Pragma("unroll") for (int m = 0; m < 4; ++m) _Pragma("unroll") for (int k = 0; k < 2; ++k) dst[m][k] = *(const PG8_LAS bf16x8*)(lds + PG8_SA(b, h) + aoff + m * 2048 + k * 1024); } while (0)
#define PG8_LDB(dst, b, h) do { _Pragma("unroll") for (int n = 0; n < 2; ++n) _Pragma("unroll") for (int k = 0; k < 2; ++k) dst[n][k] = *(const PG8_LAS bf16x8*)(lds + PG8_SB(b, h) + boff + n * 2048 + k * 1024); } while (0)
#define PG8_MMA(ai, bj, At, Bt) do { __builtin_amdgcn_s_setprio(1); _Pragma("unroll") for (int m = 0; m < 4; ++m) _Pragma("unroll") for (int n = 0; n < 2; ++n) _Pragma("unroll") for (int k = 0; k < 2; ++k) \
        acc[ai][bj][m][n] = __builtin_amdgcn_mfma_f32_16x16x32_bf16(Bt[n][k], At[m][k], acc[ai][bj][m][n], 0, 0, 0); __builtin_amdgcn_s_setprio(0); } while (0)
#define PG8_WAIT_V(n) asm volatile("s_waitcnt vmcnt(" #n ")" ::: "memory")
#define PG8_WAIT_L(n) asm volatile("s_waitcnt lgkmcnt(" #n ")" ::: "memory")
#define PG8_BAR __builtin_amdgcn_s_barrier()
#define PG8_SCHED __builtin_amdgcn_sched_barrier(0)
    Unit cur, nxt; int ui = 0;
    if (!S.next(0, cur)) return;
    f32x4 acc[2][2][4][2];
#pragma unroll
    for (int a = 0; a < 2; ++a)
#pragma unroll
        for (int b = 0; b < 2; ++b)
#pragma unroll
            for (int m = 0; m < 4; ++m)
#pragma unroll
                for (int n = 0; n < 2; ++n) acc[a][b][m][n] = (f32x4){0.f, 0.f, 0.f, 0.f};
    bf16x8 At[4][2], B0[2][2], B1[2][2];
    const char* cA = (const char*)g.A + (size_t)cur.pm * tstep; const char* cB = (const char*)g.Bt + (size_t)cur.pn * tstep;
    S.a_ready(cur);
    if constexpr (SP2) {
        PG8_STAGE(PG8_SB(0, 0), cB, voffB); PG8_STAGE(PG8_SB(0, 1), cB + hstep, voffB); PG8_STAGE(PG8_SA(0, 0), cA, voffA); PG8_STAGE(PG8_SA(0, 1), cA + hstep, voffA);
        if (wr == 1) PG8_BAR;
        PG8_WAIT_V(2); PG8_BAR;
        PG8_STAGE(PG8_SB(1, 0), cB + kstep, voffB); PG8_STAGE(PG8_SA(1, 0), cA + kstep, voffA); PG8_STAGE(PG8_SB(1, 1), cB + hstep + kstep, voffB);
        PG8_WAIT_V(6); PG8_BAR;
    } else {
        PG8_STAGE(PG8_SB(0, 0), cB, voffB); PG8_STAGE(PG8_SA(0, 0), cA, voffA); PG8_STAGE(PG8_SB(0, 1), cB + hstep, voffB); PG8_STAGE(PG8_SA(0, 1), cA + hstep, voffA);
        if (wr == 1) PG8_BAR;
        PG8_WAIT_V(4); PG8_BAR;
        PG8_STAGE(PG8_SB(1, 0), cB + kstep, voffB); PG8_STAGE(PG8_SA(1, 0), cA + kstep, voffA); PG8_STAGE(PG8_SB(1, 1), cB + hstep + kstep, voffB);
        PG8_WAIT_V(6); PG8_BAR;
    }
    for (;;) {
        const bool has_next = S.next(ui + 1, nxt);
        const char* nA = has_next ? (const char*)g.A + (size_t)nxt.pm * tstep : cA; const char* nB = has_next ? (const char*)g.Bt + (size_t)nxt.pn * tstep : cB;
        for (int t = 0; t < nt; t += 2) {
            const bool last = (t == nt - 2);
            const char* a1 = cA + (size_t)(t + 1) * kstep;
            const char* a2 = last ? nA : cA + (size_t)(t + 2) * kstep; const char* b2 = last ? nB : cB + (size_t)(t + 2) * kstep;
            const char* a3 = a2 + kstep; const char* b3 = b2 + kstep;
            if (last && has_next) S.a_ready(nxt);
            if constexpr (SP2) {
            PG8_LDB(B0, 0, 0); PG8_LDB(B1, 0, 1); PG8_SCHED; PG8_LDA(At, 0, 0); PG8_STAGE(PG8_SA(1, 1), a1 + hstep, voffA);
            PG8_WAIT_V(8); PG8_WAIT_L(0); PG8_BAR; PG8_MMA(0, 0, At, B0); PG8_MMA(0, 1, At, B1); PG8_BAR; PG8_SCHED;
            PG8_LDA(At, 0, 1); PG8_STAGE(PG8_SB(0, 0), b2, voffB); PG8_STAGE(PG8_SB(0, 1), b2 + hstep, voffB); PG8_STAGE(PG8_SA(0, 0), a2, voffA);
            PG8_WAIT_V(8); PG8_WAIT_L(0); PG8_BAR; PG8_MMA(1, 0, At, B0); PG8_MMA(1, 1, At, B1); PG8_BAR; PG8_SCHED;
            PG8_LDB(B0, 1, 0); PG8_LDB(B1, 1, 1); PG8_SCHED; PG8_LDA(At, 1, 0); PG8_STAGE(PG8_SA(0, 1), a2 + hstep, voffA);
            PG8_WAIT_V(8); PG8_WAIT_L(0); PG8_BAR; PG8_MMA(0, 0, At, B0); PG8_MMA(0, 1, At, B1); PG8_BAR; PG8_SCHED;
            PG8_LDA(At, 1, 1); PG8_STAGE(PG8_SB(1, 0), b3, voffB); PG8_STAGE(PG8_SB(1, 1), b3 + hstep, voffB); PG8_STAGE(PG8_SA(1, 0), a3, voffA);
            PG8_WAIT_V(8); PG8_WAIT_L(0); PG8_BAR; PG8_MMA(1, 0, At, B0); PG8_MMA(1, 1, At, B1); PG8_BAR; PG8_SCHED;
            } else {
            PG8_LDB(B0, 0, 0); PG8_SCHED; PG8_LDA(At, 0, 0); PG8_STAGE(PG8_SA(1, 1), a1 + hstep, voffA);
            PG8_WAIT_L(8); PG8_BAR; PG8_WAIT_L(0); PG8_MMA(0, 0, At, B0); PG8_BAR; PG8_SCHED;
            PG8_LDB(B1, 0, 1); PG8_STAGE(PG8_SB(0, 0), b2, voffB);
            PG8_BAR; PG8_WAIT_L(0); PG8_MMA(0, 1, At, B1); PG8_BAR;
            PG8_LDA(At, 0, 1); PG8_STAGE(PG8_SA(0, 0), a2, voffA);
            PG8_BAR; PG8_WAIT_L(0); PG8_MMA(1, 0, At, B0); PG8_BAR; PG8_SCHED;
            PG8_STAGE(PG8_SB(0, 1), b2 + hstep, voffB);
            PG8_WAIT_V(6); PG8_BAR; PG8_MMA(1, 1, At, B1); PG8_BAR;
            PG8_LDB(B0, 1, 0); PG8_SCHED; PG8_LDA(At, 1, 0); PG8_STAGE(PG8_SA(0, 1), a2 + hstep, voffA);
            PG8_WAIT_L(8); PG8_BAR; PG8_WAIT_L(0); PG8_MMA(0, 0, At, B0); PG8_BAR; PG8_SCHED;
            PG8_LDB(B1, 1, 1); PG8_STAGE(PG8_SB(1, 0), b3, voffB);
            PG8_BAR; PG8_WAIT_L(0); PG8_MMA(0, 1, At, B1); PG8_BAR;
            PG8_LDA(At, 1, 1); PG8_STAGE(PG8_SA(1, 0), a3, voffA);
            PG8_BAR; PG8_WAIT_L(0); PG8_MMA(1, 0, At, B0); PG8_BAR; PG8_SCHED;
            PG8_STAGE(PG8_SB(1, 1), b3 + hstep, voffB);
            PG8_WAIT_V(6); PG8_BAR; PG8_MMA(1, 1, At, B1); PG8_BAR;
            }
        }
        if constexpr (ALIGN_EPI) { if (wr == 0) PG8_BAR; }
        if constexpr (!Epi::AFTER_DRAIN) { E(acc, cur, wr, wc, fr, fq); S.done(cur); }
        if (!has_next) break;
#pragma unroll
        for (int a = 0; a < 2; ++a)
#pragma unroll
            for (int b = 0; b < 2; ++b)
#pragma unroll
                for (int m = 0; m < 4; ++m)
#pragma unroll
                    for (int n = 0; n < 2; ++n) acc[a][b][m][n] = (f32x4){0.f, 0.f, 0.f, 0.f};
        cur = nxt; cA = nA; cB = nB; ++ui;
        if constexpr (ALIGN_EPI) { if (wr == 1) PG8_BAR; }
    }
    PG8_WAIT_V(0);
    if constexpr (!ALIGN_EPI) { if (wr == 0) PG8_BAR; }
    PG8_BAR;
    if constexpr (Epi::AFTER_DRAIN) { E.fused(acc, cur, wr, wc, fr, fq, lds, wid, lane); S.done(cur); }
#undef PG8_SA
#undef PG8_SB
#undef PG8_STAGE
#undef PG8_LDA
#undef PG8_LDB
#undef PG8_MMA
#undef PG8_WAIT_V
#undef PG8_WAIT_L
#undef PG8_BAR
#undef PG8_SCHED
}
}
namespace att {
using bf16 = __hip_bfloat16;
constexpr int   D = 128, NW = 8, QBLK = 32, KVBLK = 64;
constexpr float SCALE = 0.088388347648318440f;
constexpr float THR = 8.f;
constexpr int SDEPTH = 1;
constexpr int LDQ = 1024, LDK = 256, LDO = 2048;
constexpr size_t SHM_V = KVBLK * D * 2, SHM_K = KVBLK * D * 2, SHM_ATTN = 2 * SHM_V + 2 * SHM_K + NW * 64 * 4;
using bf16x8 = __attribute__((ext_vector_type(8))) short;
using s16x4  = __attribute__((ext_vector_type(4))) short;
using f32x16 = __attribute__((ext_vector_type(16))) float;
using f32x8  = __attribute__((ext_vector_type(8))) float;
using u32x4  = __attribute__((ext_vector_type(4))) unsigned;
#define KSWZ(row, colB) ((row) * 256 + ((colB) ^ (((row) & 7) << 4)))
#define SBAR() __builtin_amdgcn_sched_barrier(0)
__device__ __forceinline__ int crow(int r, int hi) { return (r & 3) + 8 * (r >> 2) + 4 * hi; }
__device__ __forceinline__ unsigned cvtpk(float lo, float hi) {
  unsigned r; asm volatile("v_cvt_pk_bf16_f32 %0, %1, %2" : "=v"(r) : "v"(lo), "v"(hi)); return r;
}
template <typename TIn> struct Stage;
template <> struct Stage<bf16>  { using T = bf16x8;
  __device__ static __forceinline__ T ld8(const bf16* p) { return *reinterpret_cast<const bf16x8*>(p); }
  __device__ static __forceinline__ bf16x8 tobf(T x) { return x; } };
template <> struct Stage<float> { using T = f32x8;
  __device__ static __forceinline__ T ld8(const float* p) { return *reinterpret_cast<const f32x8*>(p); }
  __device__ static __forceinline__ bf16x8 tobf(T x) {
    u32x4 w = {cvtpk(x[0], x[1]), cvtpk(x[2], x[3]), cvtpk(x[4], x[5]), cvtpk(x[6], x[7])}; return *reinterpret_cast<bf16x8*>(&w); } };

__device__ __forceinline__ void partialSM(f32x16& p0, f32x16& p1, float& m_reg, f32x16& negm, float& alpha) {
  constexpr float THRL = THR * 1.4426950408889634f;
  float pmax = p0[0]; for (int r = 1; r < 16; ++r) pmax = fmaxf(pmax, p0[r]); for (int r = 0; r < 16; ++r) pmax = fmaxf(pmax, p1[r]);
  { auto rr = __builtin_amdgcn_permlane32_swap(__float_as_uint(pmax), __float_as_uint(pmax), false, false);
    pmax = fmaxf(__uint_as_float(rr[0]), __uint_as_float(rr[1])); }
  if (__builtin_expect(__all(pmax <= THRL), 1)) { alpha = 1.f; }
  else { const float dl = fmaxf(pmax, 0.f); m_reg += dl; alpha = __builtin_amdgcn_exp2f(-dl);
    for (int r = 0; r < 16; ++r) { p0[r] -= dl; p1[r] -= dl; }
    for (int r = 0; r < 16; ++r) negm[r] = -m_reg; asm volatile("" : "+v"(negm)); }
  for (int r = 0; r < 16; ++r) p0[r] = __builtin_amdgcn_exp2f(p0[r]);
}
__device__ __forceinline__ void exp_half(f32x16& p0) { for (int r = 0; r < 16; ++r) p0[r] = __builtin_amdgcn_exp2f(p0[r]); }
__device__ __forceinline__ void finishSM(f32x16& p0, f32x16& p1, float alpha, float& l_reg, bf16x8& pa0, bf16x8& pa1, bf16x8& pa2, bf16x8& pa3) {
  for (int r = 0; r < 16; ++r) p1[r] = __builtin_amdgcn_exp2f(p1[r]);
  float ps = 0; for (int r = 0; r < 16; ++r) ps += p0[r]; for (int r = 0; r < 16; ++r) ps += p1[r];
  { auto rr = __builtin_amdgcn_permlane32_swap(__float_as_uint(ps), __float_as_uint(ps), false, false);
    ps = __uint_as_float(rr[0]) + __uint_as_float(rr[1]); }
  l_reg = l_reg * alpha + ps;
#define PK4(P, BASE, OUT) do { unsigned a0 = cvtpk(P[BASE + 0], P[BASE + 1]), a1 = cvtpk(P[BASE + 2], P[BASE + 3]);   \
    unsigned b0 = cvtpk(P[BASE + 4], P[BASE + 5]), b1 = cvtpk(P[BASE + 6], P[BASE + 7]);                              \
      \
    u32x4 w = {a0, a1, b0, b1}; OUT = *reinterpret_cast<bf16x8*>(&w); } while (0)
  PK4(p0, 0, pa0); PK4(p0, 8, pa1); PK4(p1, 0, pa2); PK4(p1, 8, pa3);
#undef PK4
}
__device__ __forceinline__ void qkt(f32x16& p0, f32x16& p1, const bf16* Ks, const bf16x8* qr, int r32, int hi, const f32x16& negm) {
  for (int d0 = 0; d0 < 8; ++d0) { int cb = (d0 * 16 + hi * 8) * 2;
    bf16x8 b0 = *reinterpret_cast<const bf16x8*>((const char*)Ks + KSWZ(r32, cb));
    bf16x8 b1 = *reinterpret_cast<const bf16x8*>((const char*)Ks + KSWZ(32 + r32, cb));
    if (d0 == 0) { p0 = __builtin_amdgcn_mfma_f32_32x32x16_bf16(b0, qr[0], negm, 0, 0, 0); p1 = __builtin_amdgcn_mfma_f32_32x32x16_bf16(b1, qr[0], negm, 0, 0, 0); }
    else { p0 = __builtin_amdgcn_mfma_f32_32x32x16_bf16(b0, qr[d0], p0, 0, 0, 0); p1 = __builtin_amdgcn_mfma_f32_32x32x16_bf16(b1, qr[d0], p1, 0, 0, 0); } }
}
__device__ __forceinline__ int v_st(int k, int c) { const int kk = k;   return ((kk >> 3) * 4 + (c >> 5)) * 512 + ((kk & 7) * 32 + (c & 31)) * 2; }
__device__ __forceinline__ int v_rd_base(int lane) { return ((lane & 3) << 3) | (((lane >> 2) & 3) << 6) | (((lane >> 4) & 1) << 5) | (((lane >> 5) & 1) << 8); }
constexpr int v_rd_off(int d0, int ks, int half) { return d0 * 512 + ks * 4096 + half * 2048; }
template <int OFF> __device__ __forceinline__ s16x4 tr_read(int vb) {
  s16x4 r; asm volatile("ds_read_b64_tr_b16 %0, %1 offset:%2" : "=&v"(r) : "v"(vb), "i"(OFF) : "memory"); return r;
}
template <int D0> __device__ __forceinline__ void pv_one(f32x16& od, int vb, bf16x8 pa0, bf16x8 pa1, bf16x8 pa2, bf16x8 pa3) {
  const s16x4 l0 = tr_read<v_rd_off(D0, 0, 0)>(vb), h0 = tr_read<v_rd_off(D0, 0, 1)>(vb), l1 = tr_read<v_rd_off(D0, 1, 0)>(vb), h1 = tr_read<v_rd_off(D0, 1, 1)>(vb);
  const s16x4 l2 = tr_read<v_rd_off(D0, 2, 0)>(vb), h2 = tr_read<v_rd_off(D0, 2, 1)>(vb), l3 = tr_read<v_rd_off(D0, 3, 0)>(vb), h3 = tr_read<v_rd_off(D0, 3, 1)>(vb);
  asm volatile("s_waitcnt lgkmcnt(0)" ::: "memory"); SBAR();
#define PK(L, H) (bf16x8){L[0], L[1], L[2], L[3], H[0], H[1], H[2], H[3]}
  od = __builtin_amdgcn_mfma_f32_32x32x16_bf16(pa0, PK(l0, h0), od, 0, 0, 0);
  od = __builtin_amdgcn_mfma_f32_32x32x16_bf16(pa1, PK(l1, h1), od, 0, 0, 0);
  od = __builtin_amdgcn_mfma_f32_32x32x16_bf16(pa2, PK(l2, h2), od, 0, 0, 0);
  od = __builtin_amdgcn_mfma_f32_32x32x16_bf16(pa3, PK(l3, h3), od, 0, 0, 0);
#undef PK
}
__device__ __forceinline__ void pv_d0(f32x16* o, int vb, bf16x8 pa0, bf16x8 pa1, bf16x8 pa2, bf16x8 pa3) {
  pv_one<0>(o[0], vb, pa0, pa1, pa2, pa3); pv_one<1>(o[1], vb, pa0, pa1, pa2, pa3); pv_one<2>(o[2], vb, pa0, pa1, pa2, pa3); pv_one<3>(o[3], vb, pa0, pa1, pa2, pa3);
}
template <typename TQ>
__device__ __forceinline__ void attn_dense_body(const TQ* Qb, const bf16* Kh, const bf16* Vh,
                                                bf16* Ob, int seq, char* lds, float negB, const float* wq, const float* rope, int tok0) {
  using St = Stage<bf16>; using SQ = Stage<TQ>;
  int tid_ = threadIdx.x; asm volatile("" : "+v"(tid_)); const int tid = tid_, wid = tid >> 6, lane = tid & 63, r32 = lane & 31, hi = lane >> 5;
  bf16* V_lds = (bf16*)lds; bf16* K_lds = (bf16*)(lds + 2 * SHM_V);
  float* ws = (float*)(lds + 2 * SHM_V + 2 * SHM_K) + wid * 64; float* li_l = ws; float* al_l = ws + 32;
  float l_reg = 0; f32x16 o[4] = {}; bf16x8 qr[8];
  f32x16 negm; for (int r = 0; r < 16; ++r) negm[r] = negB; asm volatile("" : "+v"(negm));
  { const TQ* Qw = Qb + (long)(wid * QBLK + r32) * LDQ + hi * 8;
    f32x8 xr[8]; float ss = 0.f;
#pragma unroll
    for (int d0 = 0; d0 < 8; ++d0) { xr[d0] = *reinterpret_cast<const f32x8*>(Qw + d0 * 16);
#pragma unroll
      for (int e = 0; e < 8; ++e) ss += xr[d0][e] * xr[d0][e]; }
    { auto rr = __builtin_amdgcn_permlane32_swap(__float_as_uint(ss), __float_as_uint(ss), false, false); ss = __uint_as_float(rr[0]) + __uint_as_float(rr[1]); }
    const float rs = rsqrtf(ss * (1.f / 128.f) + 1e-6f) * 0.12751743f;
#pragma unroll
    for (int d0 = 0; d0 < 8; ++d0) { const f32x8 wv = *reinterpret_cast<const f32x8*>(wq + d0 * 16 + hi * 8);
#pragma unroll
      for (int e = 0; e < 8; ++e) xr[d0][e] = xr[d0][e] * rs * wv[e]; }
    if (tok0 >= 0) { const int tok = tok0 + wid * QBLK + r32;
#pragma unroll
      for (int h2 = 0; h2 < 2; ++h2) { const int pos = h2 == 0 ? (tok >> 6) : (tok & 63);
#pragma unroll
        for (int dd = 0; dd < 2; ++dd) { const float* rp = rope + ((size_t)pos * 32 + dd * 16 + hi * 8) * 2;
#pragma unroll
          for (int e = 0; e < 8; ++e) { const float c = rp[2 * e], s = rp[2 * e + 1]; const float a = xr[4 * h2 + dd][e], bq = xr[4 * h2 + dd + 2][e];
            xr[4 * h2 + dd][e] = a * c - bq * s; xr[4 * h2 + dd + 2][e] = bq * c + a * s; } } } }
#pragma unroll
    for (int d0 = 0; d0 < 8; ++d0) qr[d0] = Stage<float>::tobf(xr[d0]); }
  const int sr = tid >> 4, sc = (tid & 15) * 8, vst0 = v_st(sr, sc), vst1 = v_st(32 + sr, sc);
  const int vb0 = (int)(uintptr_t)V_lds + v_rd_base(lane);
  struct { typename St::T vs0, vs1, ks0, ks1; } sr_[SDEPTH];
#define SLOAD(i, k0) do { sr_[i].vs0 = St::ld8(&Vh[(long)((k0) + sr) * LDK + sc]); sr_[i].vs1 = St::ld8(&Vh[(long)((k0) + 32 + sr) * LDK + sc]); \
    sr_[i].ks0 = St::ld8(&Kh[(long)((k0) + sr) * LDK + sc]); sr_[i].ks1 = St::ld8(&Kh[(long)((k0) + 32 + sr) * LDK + sc]); } while (0)
#define SWRITE(b, i) do { *(bf16x8*)((char*)V_lds + (b) * SHM_V + vst0) = St::tobf(sr_[i].vs0);          \
    *(bf16x8*)((char*)V_lds + (b) * SHM_V + vst1) = St::tobf(sr_[i].vs1); int kc = sc * 2;               \
    *(bf16x8*)((char*)K_lds + (b) * SHM_K + KSWZ(sr, kc)) = St::tobf(sr_[i].ks0);                       \
    *(bf16x8*)((char*)K_lds + (b) * SHM_K + KSWZ(32 + sr, kc)) = St::tobf(sr_[i].ks1); } while (0)
#define SWAIT() do { if constexpr (SDEPTH == 2) asm volatile("s_waitcnt vmcnt(4)" ::: "memory"); else asm volatile("s_waitcnt vmcnt(0)" ::: "memory"); } while (0)
#define RESC(a) do { if (__any((a) < 1.f)) { if (hi == 0) al_l[r32] = (a); asm volatile("s_waitcnt lgkmcnt(0)" ::: "memory"); \
    for (int d = 0; d < 4; ++d) for (int r = 0; r < 16; ++r) o[d][r] *= al_l[crow(r, hi)]; } } while (0)
  f32x16 pA0, pA1, pB0, pB1; bf16x8 pa0, pa1, pa2, pa3; const int NT = seq / KVBLK;
  constexpr int SE = 0, SO = SDEPTH - 1;
  SLOAD(SE, 0); asm volatile("s_waitcnt vmcnt(0)" ::: "memory"); SWRITE(0, SE); __syncthreads();
  qkt(pA0, pA1, K_lds, qr, r32, hi, negm); exp_half(pA0);
  SLOAD(SO, KVBLK); if constexpr (SDEPTH == 2) { if (2 < NT) SLOAD(SE, 2 * KVBLK); }
  SWAIT(); SWRITE(1, SO); __syncthreads();
  for (int j = 1; j + 1 < NT; j += 2) {
    SBAR(); qkt(pB0, pB1, (bf16*)((char*)K_lds + SHM_K), qr, r32, hi, negm);
    finishSM(pA0, pA1, 1.f, l_reg, pa0, pa1, pa2, pa3); SBAR();
    SLOAD(SO, (j + SDEPTH) * KVBLK); SBAR();
    pv_d0(o, vb0, pa0, pa1, pa2, pa3); exp_half(pB0);
    __syncthreads(); SWAIT(); SWRITE(0, SE);
    __syncthreads();
    SBAR(); qkt(pA0, pA1, K_lds, qr, r32, hi, negm);
    finishSM(pB0, pB1, 1.f, l_reg, pa0, pa1, pa2, pa3); SBAR();
    if (SDEPTH == 1 || j + 3 < NT) SLOAD(SE, (j + 1 + SDEPTH) * KVBLK); SBAR();
    pv_d0(o, vb0 + (int)SHM_V, pa0, pa1, pa2, pa3); exp_half(pA0);
    __syncthreads(); SWAIT(); SWRITE(1, SO);
    __syncthreads();
  }
  SBAR(); qkt(pB0, pB1, (bf16*)((char*)K_lds + SHM_K), qr, r32, hi, negm);
  finishSM(pA0, pA1, 1.f, l_reg, pa0, pa1, pa2, pa3); SBAR();
  pv_d0(o, vb0, pa0, pa1, pa2, pa3); exp_half(pB0);
  __syncthreads();
  finishSM(pB0, pB1, 1.f, l_reg, pa0, pa1, pa2, pa3); SBAR();
  pv_d0(o, vb0 + (int)SHM_V, pa0, pa1, pa2, pa3);
  if (hi == 0) li_l[r32] = l_reg; asm volatile("s_waitcnt lgkmcnt(0)" ::: "memory");
  float rli[16];
#pragma unroll
  for (int r = 0; r < 16; ++r) rli[r] = __builtin_amdgcn_rcpf(li_l[crow(r, hi)]);
  bf16* Ow = Ob + (long)(wid * QBLK) * LDO;
#pragma unroll
  for (int r = 0; r < 16; ++r) { int orow = crow(r, hi);
    for (int d0 = 0; d0 < 4; ++d0) Ow[(long)orow * LDO + d0 * 32 + r32] = __float2bfloat16(o[d0][r] * rli[r]); }
#undef SLOAD
#undef SWRITE
#undef SWAIT
#undef RESC
}
}

#define LAS __attribute__((address_space(3)))
typedef unsigned short bf16_t;
typedef float f32x4 __attribute__((ext_vector_type(4)));
typedef float f32x2 __attribute__((ext_vector_type(2)));
typedef unsigned u32x4 __attribute__((ext_vector_type(4)));
typedef unsigned u32x2 __attribute__((ext_vector_type(2)));
typedef short bf16x8 __attribute__((ext_vector_type(8)));

constexpr int L = 16384, NCTX = 256, MT = L + NCTX, DM = 2048, INW = 2560, FF = 5632, NCH = 260;
constexpr float EPS = 1e-6f;

constexpr size_t al256(size_t x) { return (x + 255) / 256 * 256; }
constexpr size_t SZ_WIN = (size_t)INW * DM * 2, SZ_WOUT = (size_t)DM * DM * 2, SZ_WGU = (size_t)2 * FF * DM * 2, SZ_WDN = (size_t)DM * FF * 2,
                 SZ_WGLU = 512 * 512 * 2, SZ_WF = 512 * 1024 * 2;
constexpr size_t O_WIN = 0;
constexpr size_t O_WOUT = O_WIN + 2 * SZ_WIN;
constexpr size_t O_WGU = O_WOUT + 2 * SZ_WOUT;
constexpr size_t O_WDN = O_WGU + 2 * SZ_WGU;
constexpr size_t O_WGLU = O_WDN + 2 * SZ_WDN;
constexpr size_t O_WF = O_WGLU + 2 * SZ_WGLU;
constexpr size_t O_MODP = O_WF + 2 * SZ_WF;
constexpr size_t O_MOD = O_MODP + (size_t)16 * 4 * 12288 * 4;
constexpr size_t O_ROPE = O_MOD + (size_t)4 * 12288 * 4;
constexpr size_t O_AB = O_ROPE + 65536;
constexpr size_t O_BB = O_AB + 8192 * 16;
constexpr size_t O_CB = O_BB + (size_t)8192 * 16 * 8;
constexpr size_t O_W1 = O_CB + (size_t)128 * 16 * 128 * 2;
constexpr size_t O_W2 = O_W1 + 65536;
constexpr size_t O_WC = O_W2 + 131072;
constexpr size_t O_TW = O_WC + 262144;
constexpr size_t O_XC = O_TW + 131072;
constexpr size_t SZ_S = (size_t)2 * NCH * 32 * 128 * 4;
constexpr size_t O_S = O_XC + (size_t)NCTX * DM * 4;
constexpr size_t O_HIN = O_S + SZ_S;
constexpr size_t O_BBT = al256(O_HIN + SZ_S);
constexpr size_t O_BAR = O_BBT + (size_t)128 * 128 * 16 * 2;
constexpr size_t O_H = O_BAR + 16384;
constexpr size_t O_Y = O_H + (size_t)MT * DM * 2;
constexpr size_t O_YP = O_Y + (size_t)72 * 1024 * 1024;
constexpr size_t O_OV = O_Y + (size_t)MT * DM * 4;
static_assert((size_t)MT * DM * 2 <= (size_t)72 * 1024 * 1024 && O_YP + (size_t)4 * 256 * DM * 4 <= O_OV, "YP inside the Y region");
constexpr size_t O_QRAW = O_OV;
constexpr size_t O_KRAW = O_QRAW + (size_t)MT * 1024 * 4;
constexpr size_t O_QB = O_KRAW + (size_t)MT * 256 * 4;
constexpr size_t O_KB = O_QB + (size_t)MT * 1024 * 2;
constexpr size_t O_VB = O_KB + (size_t)MT * 256 * 2;
constexpr size_t O_US = O_VB + (size_t)MT * 256 * 2;
constexpr size_t O_UF = O_US + (size_t)MT * 512 * 4;
constexpr size_t O_TB = O_UF + (size_t)MT * 512 * 2;
constexpr size_t O_XF = O_TB + (size_t)2 * 128 * 128 * 512 * 2;
constexpr size_t O_G = O_XF + (size_t)MT * 1024 * 2;
constexpr size_t O_CAT = O_G + (size_t)MT * 512 * 2;
constexpr size_t O_OVEND = O_CAT + (size_t)MT * DM * 2;
constexpr size_t O_HID = O_OV;
constexpr size_t WS_END = (O_OVEND > O_HID + (size_t)MT * FF * 2) ? O_OVEND : O_HID + (size_t)MT * FF * 2;
static_assert(WS_END <= (size_t)768 * 1024 * 1024, "d_ws map exceeds 768 MiB");

constexpr int LDS_BYTES = 147456;

struct Params { const float* in[28]; float* out; unsigned char* ws; };

__device__ __forceinline__ unsigned pk2(float lo, float hi) { typedef __bf16 bf2_t __attribute__((ext_vector_type(2))); f32x2 v = {lo, hi}; bf2_t b = __builtin_convertvector(v, bf2_t); return __builtin_bit_cast(unsigned, b); }
__device__ __forceinline__ bf16_t f2bf(float f) { return (bf16_t)(pk2(f, 0.f) & 0xffffu); }
__device__ __forceinline__ float bf2f(unsigned b) { return __uint_as_float(b << 16); }
__device__ __forceinline__ float wave_sum(float v) {
#pragma unroll
    for (int o = 1; o < 64; o <<= 1) v += __shfl_xor(v, o);
    return v;
}
__device__ __forceinline__ float sigmoidf_(float x) { return 1.0f / (1.0f + __expf(-x)); }
__device__ __forceinline__ float gelu_tanh(float x) { const float u = 0.7978845608028654f * (x + 0.044715f * x * x * x); return x * sigmoidf_(2.f * u); }
#define LDS_WAIT() asm volatile("s_waitcnt lgkmcnt(0)" ::: "memory")

struct EpiIn {
    static constexpr bool PERM = true, AFTER_DRAIN = false;
    float* qraw; float* kraw; bf16_t* vb; bf16_t* us; bf16_t* uf;
    __device__ __forceinline__ void operator()(const pg8::f32x4 (&acc)[2][2][4][2], const pg8::Unit& u, int wr, int wc, int fr, int fq) const {
        const int row0 = u.pm * 256 + wr * 64 + fr, cl = wc * 32 + 8 * fq, pn = u.pn;
        float* fbase = nullptr; bf16_t* bbase = nullptr; int ldc = 0;
        if (pn < 4) { fbase = qraw + pn * 256; ldc = 1024; } else if (pn == 4) { fbase = kraw; ldc = 256; } else if (pn == 5) { bbase = vb; ldc = 256; }
        else if (pn < 8) { bbase = us + (pn - 6) * 256; ldc = 512; } else { bbase = uf + (pn - 8) * 256; ldc = 512; }
#pragma unroll
        for (int ai = 0; ai < 2; ++ai)
#pragma unroll
            for (int m = 0; m < 4; ++m) { const size_t ro = (size_t)(row0 + ai * 128 + m * 16) * ldc + cl;
#pragma unroll
                for (int bj = 0; bj < 2; ++bj) { const pg8::f32x4 v0 = acc[ai][bj][m][0], v1 = acc[ai][bj][m][1];
                    if (fbase) { float* p = fbase + ro + bj * 128; *(f32x4*)p = (f32x4){v0[0], v0[1], v0[2], v0[3]}; *(f32x4*)(p + 4) = (f32x4){v1[0], v1[1], v1[2], v1[3]}; }
                    else { u32x4 w; w.x = pk2(v0[0], v0[1]); w.y = pk2(v0[2], v0[3]); w.z = pk2(v1[0], v1[1]); w.w = pk2(v1[2], v1[3]); *(u32x4*)(bbase + ro + bj * 128) = w; } } }
    }
};
struct EpiF32 {
    static constexpr bool PERM = true, AFTER_DRAIN = false;
    bf16_t* O; int ldc;
    __device__ __forceinline__ void operator()(const pg8::f32x4 (&acc)[2][2][4][2], const pg8::Unit& u, int wr, int wc, int fr, int fq) const {
        const int row0 = u.pm * 256 + wr * 64 + fr, col0 = u.pn * 256 + wc * 32 + 8 * fq;
#pragma unroll
        for (int ai = 0; ai < 2; ++ai)
#pragma unroll
            for (int m = 0; m < 4; ++m) { bf16_t* rowp = O + (size_t)(row0 + ai * 128 + m * 16) * ldc + col0;
#pragma unroll
                for (int bj = 0; bj < 2; ++bj) { const pg8::f32x4 v0 = acc[ai][bj][m][0], v1 = acc[ai][bj][m][1];
                    u32x4 w; w.x = pk2(v0[0], v0[1]); w.y = pk2(v0[2], v0[3]); w.z = pk2(v1[0], v1[1]); w.w = pk2(v1[2], v1[3]); *(u32x4*)(rowp + bj * 128) = w; } }
    }
};
struct EpiP32 {
    static constexpr bool PERM = true, AFTER_DRAIN = false;
    float* O; int ldc;
    __device__ __forceinline__ void operator()(const pg8::f32x4 (&acc)[2][2][4][2], const pg8::Unit& u, int wr, int wc, int fr, int fq) const {
        const int row0 = u.pm * 256 + wr * 64 + fr, col0 = u.pn * 256 + wc * 32 + 8 * fq;
#pragma unroll
        for (int ai = 0; ai < 2; ++ai)
#pragma unroll
            for (int m = 0; m < 4; ++m) { float* rowp = O + (size_t)(row0 + ai * 128 + m * 16) * ldc + col0;
#pragma unroll
                for (int bj = 0; bj < 2; ++bj) { const pg8::f32x4 v0 = acc[ai][bj][m][0], v1 = acc[ai][bj][m][1];
                    *(f32x4*)(rowp + bj * 128) = (f32x4){v0[0], v0[1], v0[2], v0[3]}; *(f32x4*)(rowp + bj * 128 + 4) = (f32x4){v1[0], v1[1], v1[2], v1[3]}; } }
    }
};
struct EpiUp {
    static constexpr bool PERM = true, AFTER_DRAIN = false;
    bf16_t* hid;
    __device__ __forceinline__ void operator()(const pg8::f32x4 (&acc)[2][2][4][2], const pg8::Unit& u, int wr, int wc, int fr, int fq) const {
        const int row0 = u.pm * 256 + wr * 64 + fr, col0 = u.pn * 128 + wc * 32 + 8 * fq;
#pragma unroll
        for (int ai = 0; ai < 2; ++ai)
#pragma unroll
            for (int m = 0; m < 4; ++m) { bf16_t* rowp = hid + (size_t)(row0 + ai * 128 + m * 16) * FF + col0;
                float o[8];
#pragma unroll
                for (int n = 0; n < 2; ++n)
#pragma unroll
                    for (int e = 0; e < 4; ++e) { const float g = acc[ai][0][m][n][e], up = acc[ai][1][m][n][e]; o[4 * n + e] = g * sigmoidf_(g) * up; }
                u32x4 w; w.x = pk2(o[0], o[1]); w.y = pk2(o[2], o[3]); w.z = pk2(o[4], o[5]); w.w = pk2(o[6], o[7]); *(u32x4*)rowp = w; }
    }
};
struct EpiMix {
    static constexpr bool PERM = true, AFTER_DRAIN = false;
    bf16_t* cat; const bf16_t* gbuf; const float* bias; int mode;
    __device__ __forceinline__ void operator()(const pg8::f32x4 (&acc)[2][2][4][2], const pg8::Unit& u, int wr, int wc, int fr, int fq) const {
        const int row0 = u.pm * 256 + wr * 64 + fr, col0 = u.pn * 256 + wc * 32 + 8 * fq;
#pragma unroll
        for (int ai = 0; ai < 2; ++ai)
#pragma unroll
            for (int m = 0; m < 4; ++m) { const size_t row = (size_t)(row0 + ai * 128 + m * 16);
#pragma unroll
                for (int bj = 0; bj < 2; ++bj) { const int col = col0 + bj * 128; float o[8];
#pragma unroll
                    for (int n = 0; n < 2; ++n)
#pragma unroll
                        for (int e = 0; e < 4; ++e) o[4 * n + e] = acc[ai][bj][m][n][e];
                    if (mode == 0) { const u32x4 gv = *(const u32x4*)(gbuf + row * 512 + col); const f32x4 b0 = *(const f32x4*)(bias + col), b1 = *(const f32x4*)(bias + col + 4);
                        const unsigned gw_[4] = {gv.x, gv.y, gv.z, gv.w};
#pragma unroll
                        for (int q = 0; q < 4; ++q) { const float g0 = bf2f(gw_[q] & 0xffffu), g1 = bf2f(gw_[q] >> 16);
                            const float z0 = o[2 * q] + (q < 2 ? b0[2 * q] : b1[2 * q - 4]), z1 = o[2 * q + 1] + (q < 2 ? b0[2 * q + 1] : b1[2 * q - 3]);
                            o[2 * q] = g0 * sigmoidf_(z0); o[2 * q + 1] = g1 * sigmoidf_(z1); } }
                    u32x4 w; w.x = pk2(o[0], o[1]); w.y = pk2(o[2], o[3]); w.z = pk2(o[4], o[5]); w.w = pk2(o[6], o[7]);
                    *(u32x4*)(cat + row * 2048 + (mode == 0 ? 1024 : 1536) + col) = w; } }
    }
};

__device__ __forceinline__ void tr_item(const float* W, int K, int N, bf16_t* WT, int mode, LAS float* scr, int item, int lane) {
    const int nblk = N / 64, kb = item / nblk, nb = item - kb * nblk, k0 = 64 * kb, n0 = 64 * nb;
    const int drow0 = (mode == 0) ? n0 : ((n0 >> 7) * 256 + (mode == 2 ? 128 : 0) + (n0 & 127));
    const int c4 = lane & 15, kr = lane >> 4;
    f32x4 v[16];
#pragma unroll
    for (int i = 0; i < 16; ++i) v[i] = *(const f32x4*)(W + (size_t)(k0 + 4 * i + kr) * N + n0 + 4 * c4);
#pragma unroll
    for (int i = 0; i < 16; ++i) { LAS float* d = scr + (4 * i + kr) * 65 + 4 * c4; d[0] = v[i].x; d[1] = v[i].y; d[2] = v[i].z; d[3] = v[i].w; }
    LDS_WAIT(); asm volatile("" ::: "memory");
    const int c = lane & 7;
#pragma unroll
    for (int j = 0; j < 8; ++j) { const int n = (lane >> 3) + 8 * j; const LAS float* sp = scr + (8 * c) * 65 + n;
        u32x4 o; o.x = pk2(sp[0 * 65], sp[1 * 65]); o.y = pk2(sp[2 * 65], sp[3 * 65]); o.z = pk2(sp[4 * 65], sp[5 * 65]); o.w = pk2(sp[6 * 65], sp[7 * 65]);
        *(u32x4*)(WT + (size_t)(drow0 + n) * K + k0 + 8 * c) = o; }
    LDS_WAIT(); asm volatile("" ::: "memory");
}

__device__ __forceinline__ void prenorm_rows(const float* xl, const float* xc, bf16_t* H, const float* g, const float* modl, const float* modc, int sh_off, int sc_off,
                                             int nrows, int gw, int NGW, int lane) {
    f32x4 v[8], vn[8];
    if (gw < nrows) { const float* src = gw < L ? xl + (size_t)gw * DM : xc + (size_t)(gw - L) * DM;
#pragma unroll
        for (int j = 0; j < 8; ++j) v[j] = *(const f32x4*)(src + 4 * lane + 256 * j); }
    for (int row = gw; row < nrows; row += NGW) {
        const int nrow = row + NGW;
        if (nrow < nrows) { const float* src = nrow < L ? xl + (size_t)nrow * DM : xc + (size_t)(nrow - L) * DM;
#pragma unroll
            for (int j = 0; j < 8; ++j) vn[j] = *(const f32x4*)(src + 4 * lane + 256 * j); }
        const float* md = row < L ? modl : modc;
        float ss = 0.f;
#pragma unroll
        for (int j = 0; j < 8; ++j) ss += (v[j].x * v[j].x + v[j].y * v[j].y) + (v[j].z * v[j].z + v[j].w * v[j].w);
        const float rstd = rsqrtf(wave_sum(ss) * (1.f / DM) + EPS);
#pragma unroll
        for (int j = 0; j < 8; ++j) { const int col = 4 * lane + 256 * j;
            const f32x4 g4 = *(const f32x4*)(g + col), s4 = *(const f32x4*)(md + sc_off + col), h4 = *(const f32x4*)(md + sh_off + col);
            const f32x4 o = v[j] * rstd * g4 * (1.f + s4) + h4;
            u32x2 w; w.x = pk2(o.x, o.y); w.y = pk2(o.z, o.w); *(u32x2*)(H + (size_t)row * DM + col) = w; }
#pragma unroll
        for (int j = 0; j < 8; ++j) v[j] = vn[j];
    }
}
template <bool PL> __device__ __forceinline__ void post_rows(const float* xl_src, const float* xc_src, float* xl_dst, float* xc_dst, const bf16_t* Y, const float* wpost, const float* modl, const float* modc, int gate_off,
                                          bool do_next, bf16_t* H, const float* wpre, const float* nmodl, const float* nmodc, int sh_off, int sc_off,
                                          int row0, int nrows, int gw, int NGW, int lane, LAS float* pl, int tid, const float* yp4 = nullptr) {
    if (PL) { const int c = 4 * tid;
        *(LAS f32x4*)(pl + c) = *(const f32x4*)(wpost + c); *(LAS f32x4*)(pl + 2048 + c) = *(const f32x4*)(modl + gate_off + c);
        if (do_next) { *(LAS f32x4*)(pl + 4096 + c) = *(const f32x4*)(wpre + c); *(LAS f32x4*)(pl + 6144 + c) = *(const f32x4*)(nmodl + sc_off + c); *(LAS f32x4*)(pl + 8192 + c) = *(const f32x4*)(nmodl + sh_off + c); }
        __syncthreads(); }
    f32x4 x[8], y[8], xn[8], yn[8];
    gw += row0;
    if (gw < nrows) { const float* src = gw < L ? xl_src + (size_t)gw * DM : xc_src + (size_t)(gw - L) * DM; const bf16_t* yr = Y + (size_t)gw * DM;
#pragma unroll
        for (int j = 0; j < 8; ++j) { { if (yp4) { const float* yq = yp4 + (size_t)(gw - L) * DM + 4 * lane + 256 * j; y[j] = (*(const f32x4*)yq + *(const f32x4*)(yq + 256 * DM)) + (*(const f32x4*)(yq + 2 * 256 * DM) + *(const f32x4*)(yq + 3 * 256 * DM)); }
              else { const u32x2 yw = *(const u32x2*)(yr + 4 * lane + 256 * j); y[j] = (f32x4){bf2f(yw.x & 0xffffu), bf2f(yw.x >> 16), bf2f(yw.y & 0xffffu), bf2f(yw.y >> 16)}; } } x[j] = *(const f32x4*)(src + 4 * lane + 256 * j); } }
    for (int row = gw; row < nrows; row += NGW) {
        const bool lat = row < L;
        const int nrow = row + NGW;
        if (nrow < nrows) { const float* src = nrow < L ? xl_src + (size_t)nrow * DM : xc_src + (size_t)(nrow - L) * DM; const bf16_t* yr = Y + (size_t)nrow * DM;
#pragma unroll
            for (int j = 0; j < 8; ++j) { { if (yp4) { const float* yq = yp4 + (size_t)(nrow - L) * DM + 4 * lane + 256 * j; yn[j] = (*(const f32x4*)yq + *(const f32x4*)(yq + 256 * DM)) + (*(const f32x4*)(yq + 2 * 256 * DM) + *(const f32x4*)(yq + 3 * 256 * DM)); }
                  else { const u32x2 yw = *(const u32x2*)(yr + 4 * lane + 256 * j); yn[j] = (f32x4){bf2f(yw.x & 0xffffu), bf2f(yw.x >> 16), bf2f(yw.y & 0xffffu), bf2f(yw.y >> 16)}; } } xn[j] = *(const f32x4*)(src + 4 * lane + 256 * j); } }
        float* dst = lat ? xl_dst + (size_t)row * DM : xc_dst + (size_t)(row - L) * DM;
        const float* md = lat ? modl : modc;
        float ss = 0.f;
#pragma unroll
        for (int j = 0; j < 8; ++j) ss += (y[j].x * y[j].x + y[j].y * y[j].y) + (y[j].z * y[j].z + y[j].w * y[j].w);
        const float rstd = rsqrtf(wave_sum(ss) * (1.f / DM) + EPS);
        float s2 = 0.f;
#pragma unroll
        for (int j = 0; j < 8; ++j) { const int col = 4 * lane + 256 * j;
            const f32x4 w4 = PL ? *(const LAS f32x4*)(pl + col) : *(const f32x4*)(wpost + col), g4 = PL ? *(const LAS f32x4*)(pl + 2048 + col) : *(const f32x4*)(md + gate_off + col);
            x[j] = x[j] + g4 * (y[j] * rstd * w4);
            *(f32x4*)(dst + col) = x[j];
            s2 += (x[j].x * x[j].x + x[j].y * x[j].y) + (x[j].z * x[j].z + x[j].w * x[j].w); }
        if (do_next) {
            const float* nmd = lat ? nmodl : nmodc;
            const float rstd2 = rsqrtf(wave_sum(s2) * (1.f / DM) + EPS);
#pragma unroll
            for (int j = 0; j < 8; ++j) { const int col = 4 * lane + 256 * j;
                const f32x4 g4 = PL ? *(const LAS f32x4*)(pl + 4096 + col) : *(const f32x4*)(wpre + col), s4 = PL ? *(const LAS f32x4*)(pl + 6144 + col) : *(const f32x4*)(nmd + sc_off + col),
                            h4 = PL ? *(const LAS f32x4*)(pl + 8192 + col) : *(const f32x4*)(nmd + sh_off + col);
                const f32x4 o = x[j] * rstd2 * g4 * (1.f + s4) + h4;
                u32x2 w; w.x = pk2(o.x, o.y); w.y = pk2(o.z, o.w); *(u32x2*)(H + (size_t)row * DM + col) = w; }
        }
#pragma unroll
        for (int j = 0; j < 8; ++j) { x[j] = xn[j]; y[j] = yn[j]; }
    }
}

__device__ __forceinline__ void kq_post(const float* qraw, const float* kraw, bf16_t* qb, bf16_t* kb, const float* qn, const float* kn, const float* rope, int gw, int NGW, int lane) {
    const int j = lane & 31, hsel = lane >> 5;
    const f32x4 wq4 = *(const f32x4*)(qn + 4 * j), wk4 = *(const f32x4*)(kn + 4 * j);
    for (int it0 = gw; it0 < MT; it0 += 8 * NGW) {
        f32x4 v[8]; int rows[8], heads[8]; bool ok[8];
#pragma unroll
        for (int q = 0; q < 8; ++q) { const int it = it0 + q * NGW; ok[q] = it < MT; const int itc = ok[q] ? it : it0;
            const int row = itc, head = 8 + hsel; rows[q] = row; heads[q] = head;
            const float* src = head < 8 ? qraw + (size_t)row * 1024 + head * 128 + 4 * j : kraw + (size_t)row * 256 + (head - 8) * 128 + 4 * j;
            v[q] = *(const f32x4*)src; }
#pragma unroll
        for (int q = 0; q < 8; ++q) { const int row = rows[q], head = heads[q]; f32x4 x = v[q];
            float ss = (x.x * x.x + x.y * x.y) + (x.z * x.z + x.w * x.w);
#pragma unroll
            for (int o = 1; o < 32; o <<= 1) ss += __shfl_xor(ss, o);
            const float rstd = rsqrtf(ss * (1.f / 128.f) + EPS);
            x = x * rstd * wk4;
            f32x4 pt; pt.x = __shfl_xor(x.x, 8); pt.y = __shfl_xor(x.y, 8); pt.z = __shfl_xor(x.z, 8); pt.w = __shfl_xor(x.w, 8);
            if (row < L) {
                const int pos = (j < 16) ? (row >> 6) : (row & 63), fi = (4 * j) & 31;
                const f32x4 t0 = *(const f32x4*)(rope + (pos * 32 + fi) * 2), t1 = *(const f32x4*)(rope + (pos * 32 + fi) * 2 + 4);
                const float sg = (j & 8) ? 1.f : -1.f;
                x.x = x.x * t0.x + sg * pt.x * t0.y; x.y = x.y * t0.z + sg * pt.y * t0.w; x.z = x.z * t1.x + sg * pt.z * t1.y; x.w = x.w * t1.z + sg * pt.w * t1.w;
            }
            bf16_t* dst = head < 8 ? qb + (size_t)row * 1024 + head * 128 + 4 * j : kb + (size_t)row * 256 + (head - 8) * 128 + 4 * j;
            u32x2 o; o.x = pk2(x.x, x.y); o.y = pk2(x.z, x.w); if (ok[q]) *(u32x2*)dst = o; }
    }
}

__device__ __forceinline__ void ssm_stage_u(const float* US, LAS float* us, int k, int g, int lane) {
    const float* src = US + (size_t)(64 * k + lane) * 512 + 16 * g;
#pragma unroll
    for (int q = 0; q < 4; ++q) *(LAS f32x4*)(us + lane * 16 + 4 * q) = *(const f32x4*)(src + 4 * q);
}
__device__ __forceinline__ void ssm_bu_tile(const LAS float* us, LAS float* bu, const bf16x8 (&bfr)[8], int t0, int lane) {
    const int fr = lane & 15, fq = lane >> 4;
    const LAS float* up = us + (2 * (fq & 1)) * 256 + (t0 + fr) * 4;
    const f32x4 ua = *(const LAS f32x4*)up, ub = *(const LAS f32x4*)(up + 256);
    u32x4 aw; aw.x = pk2(ua.x, ua.y); aw.y = pk2(ua.z, ua.w); aw.z = pk2(ub.x, ub.y); aw.w = pk2(ub.z, ub.w);
    if (fq >= 2) aw = (u32x4){0u, 0u, 0u, 0u};
    const bf16x8 af = __builtin_bit_cast(bf16x8, aw);
#pragma unroll
    for (int nt = 0; nt < 8; ++nt) {
        const pg8::f32x4 d = __builtin_amdgcn_mfma_f32_16x16x32_bf16(af, bfr[nt], (pg8::f32x4){0.f, 0.f, 0.f, 0.f}, 0, 0, 0);
#pragma unroll
        for (int e = 0; e < 4; ++e) bu[(4 * fq + e) * 132 + 16 * nt + fr] = d[e];
    }
}
__device__ __forceinline__ void ssm_load_bfr(const bf16_t* BBT, bf16x8 (&bfr)[8], int ldg, int lane) {
    const int fr = lane & 15, fq = lane >> 4;
#pragma unroll
    for (int nt = 0; nt < 8; ++nt) { u32x4 w = *(const u32x4*)(BBT + ((size_t)ldg * 128 + 16 * nt + fr) * 16 + 8 * (fq & 1)); if (fq >= 2) w = (u32x4){0u, 0u, 0u, 0u}; bfr[nt] = __builtin_bit_cast(bf16x8, w); }
}
template <int DIR, bool WR> __device__ __forceinline__ void ssm_rec16(float ar, float ai, f32x2& hh, const LAS float* bu, LAS unsigned* st, int lane) {
    f32x2 b[16];
#pragma unroll
    for (int tt = 0; tt < 16; ++tt) { const int t = DIR == 0 ? tt : 15 - tt; b[tt] = (f32x2){bu[t * 132 + lane], bu[t * 132 + 64 + lane]}; }
#pragma unroll
    for (int tt = 0; tt < 16; ++tt) { const int t = DIR == 0 ? tt : 15 - tt;
        const f32x2 hs_ = {-hh.y, hh.x}; hh = b[tt] + (hh * ar + hs_ * ai);
        if (WR) st[t * 68 + lane] = pk2(hh.x, hh.y); }
}
__device__ __forceinline__ void ssm_dma_u(const bf16_t* US, LAS float* us, int k, int g, int lane) {
    const bf16_t* src = US + (size_t)(64 * k + lane) * 512 + 16 * g;
#pragma unroll
    for (int q = 0; q < 2; ++q) __builtin_amdgcn_global_load_lds((const unsigned*)(src + 8 * q), (LAS unsigned*)((LAS unsigned char*)us + q * 1024), 16, 0, 0);
}
typedef float f32x16_t __attribute__((ext_vector_type(16)));
__device__ __forceinline__ void ssm_load_bf4(const bf16_t* BBT, bf16x8 (&bf4)[4], int ldg, int lane) {
    const int r32 = lane & 31, hi = lane >> 5;
#pragma unroll
    for (int n = 0; n < 4; ++n) bf4[n] = *(const bf16x8*)(BBT + ((size_t)ldg * 128 + 32 * n + r32) * 16 + 8 * hi);
}
#define SSM_SWAP32(a, b) { auto rr_ = __builtin_amdgcn_permlane32_swap(__float_as_uint(a), __float_as_uint(b), false, false); a = __uint_as_float(rr_[0]); b = __uint_as_float(rr_[1]); }
template <int DIR, bool WR> __device__ __forceinline__ void ssm_tile32(const LAS float* us, const bf16x8 (&bf4)[4], float ar, float ai, f32x2& hh, LAS unsigned* st, int t0, int lane) {
    const int r32 = lane & 31, hi = lane >> 5;
    const bf16x8 af = *(const LAS bf16x8*)((const LAS unsigned char*)us + hi * 1024 + (t0 + r32) * 16);
    const f32x16_t z = {0.f, 0.f, 0.f, 0.f, 0.f, 0.f, 0.f, 0.f, 0.f, 0.f, 0.f, 0.f, 0.f, 0.f, 0.f, 0.f};
    f32x16_t dre0 = __builtin_amdgcn_mfma_f32_32x32x16_bf16(af, bf4[0], z, 0, 0, 0), dre1 = __builtin_amdgcn_mfma_f32_32x32x16_bf16(af, bf4[1], z, 0, 0, 0);
    f32x16_t dim0 = __builtin_amdgcn_mfma_f32_32x32x16_bf16(af, bf4[2], z, 0, 0, 0), dim1 = __builtin_amdgcn_mfma_f32_32x32x16_bf16(af, bf4[3], z, 0, 0, 0);
#pragma unroll
    for (int r = 0; r < 16; ++r) { SSM_SWAP32(dre0[r], dre1[r]) SSM_SWAP32(dim0[r], dim1[r]) }
#pragma unroll
    for (int tt = 0; tt < 32; ++tt) { const int t = DIR == 0 ? tt : 31 - tt; const int ri = 4 * (t >> 3) + (t & 3);
        const f32x2 b = ((t >> 2) & 1) ? (f32x2){dre1[ri], dim1[ri]} : (f32x2){dre0[ri], dim0[ri]};
        const f32x2 hs_ = {-hh.y, hh.x}; hh = b + (hh * ar + hs_ * ai);
        if (WR) st[t * 68 + lane] = pk2(hh.x, hh.y); }
}
template <int DIR> __device__ __forceinline__ void ssm_s1_run(float ar, float ai, const bf16x8 (&bf4)[4], const LAS float* us, float* o, int lane) {
    f32x2 hh = {0.f, 0.f};
    if (DIR == 0) { ssm_tile32<0, false>(us, bf4, ar, ai, hh, nullptr, 0, lane); ssm_tile32<0, false>(us, bf4, ar, ai, hh, nullptr, 32, lane); }
    else          { ssm_tile32<1, false>(us, bf4, ar, ai, hh, nullptr, 32, lane); ssm_tile32<1, false>(us, bf4, ar, ai, hh, nullptr, 0, lane); }
    o[lane] = hh.x; o[64 + lane] = hh.y;
}
template <int DIR, int T> __device__ __forceinline__ void ssm_s3_tile(float ar, float ai, const bf16x8 (&bf4)[4], const bf16x8 (&cb)[4], f32x2& hh, const LAS float* us, LAS unsigned* st, pg8::f32x4 (&yacc)[4], int lane) {
    const int fr = lane & 15, fq = lane >> 4;
    ssm_tile32<DIR, true>(us, bf4, ar, ai, hh, st, 32 * T, lane);
#pragma unroll
    for (int mt = 0; mt < 2; ++mt)
#pragma unroll
        for (int ks = 0; ks < 4; ++ks) { const bf16x8 a0 = *(const LAS bf16x8*)((const LAS unsigned char*)st + (16 * mt + fr) * 272 + (32 * ks + 8 * fq) * 2);
            yacc[2 * T + mt] = __builtin_amdgcn_mfma_f32_16x16x32_bf16(cb[ks], a0, yacc[2 * T + mt], 0, 0, 0); }
}
template <int DIR> __device__ __forceinline__ void ssm_s3_run(float ar, float ai, const bf16x8 (&bf4)[4], const bf16x8 (&cb)[4], f32x2 hh, const LAS float* us, LAS unsigned* st, pg8::f32x4 (&yacc)[4], int lane) {
    if (DIR == 0) { ssm_s3_tile<0, 0>(ar, ai, bf4, cb, hh, us, st, yacc, lane); ssm_s3_tile<0, 1>(ar, ai, bf4, cb, hh, us, st, yacc, lane); }
    else          { ssm_s3_tile<1, 1>(ar, ai, bf4, cb, hh, us, st, yacc, lane); ssm_s3_tile<1, 0>(ar, ai, bf4, cb, hh, us, st, yacc, lane); }
}
__device__ __forceinline__ void cmul_add(float& dr, float& di, float ar, float ai, float br, float bi, float cr, float ci) { dr = ar * br - ai * bi + cr; di = ar * bi + ai * br + ci; }
__device__ __forceinline__ void ssm_s2_task(const f32x4* AB, const float* S, float* HIN, int layer, int task, int lane) {
    const int p = task & 63, g = (task >> 6) & 31, dir = task >> 11;
    const f32x4 ab = AB[((layer * 2 + dir) * 32 + g) * 64 + p]; const float ar = ab.z, ai = ab.w;
    const size_t dbase = (size_t)dir * NCH * 32 * 128 + (size_t)g * 128 + p;
#define CH_OF(q) (dir == 0 ? (((q) + 256) % NCH) : (NCH - 1 - (q)))
    float h4r = 0.f, h4i = 0.f;
    for (int q = 0; q < 4; ++q) { const size_t o = dbase + (size_t)CH_OF(q) * 4096; if (lane == 0) { HIN[o] = h4r; HIN[o + 64] = h4i; }
        const float sr = S[o], si = S[o + 64]; float nr, ni; cmul_add(nr, ni, ar, ai, h4r, h4i, sr, si); h4r = nr; h4i = ni; }
    float sr[4], si[4];
#pragma unroll
    for (int i = 0; i < 4; ++i) { const size_t o = dbase + (size_t)CH_OF(4 + 4 * lane + i) * 4096; sr[i] = S[o]; si[i] = S[o + 64]; }
    float er = sr[0], ei = si[0];
#pragma unroll
    for (int i = 1; i < 4; ++i) { float nr, ni; cmul_add(nr, ni, ar, ai, er, ei, sr[i], si[i]); er = nr; ei = ni; }
    float mr, mi; { const float a2r = ar * ar - ai * ai, a2i = 2.f * ar * ai; mr = a2r * a2r - a2i * a2i; mi = 2.f * a2r * a2i; }
#pragma unroll
    for (int d = 1; d < 64; d <<= 1) {
        const float pr = __shfl_up(er, d), pi = __shfl_up(ei, d), qr = __shfl_up(mr, d), qi = __shfl_up(mi, d);
        if (lane >= d) { float nr, ni; cmul_add(nr, ni, mr, mi, pr, pi, er, ei); er = nr; ei = ni; const float tr = mr * qr - mi * qi, ti = mr * qi + mi * qr; mr = tr; mi = ti; }
    }
    float outr, outi; cmul_add(outr, outi, mr, mi, h4r, h4i, er, ei);
    float inr = __shfl_up(outr, 1), ini = __shfl_up(outi, 1);
    if (lane == 0) { inr = h4r; ini = h4i; }
#pragma unroll
    for (int i = 0; i < 4; ++i) { const size_t o = dbase + (size_t)CH_OF(4 + 4 * lane + i) * 4096; HIN[o] = inr; HIN[o + 64] = ini; float nr, ni; cmul_add(nr, ni, ar, ai, inr, ini, sr[i], si[i]); inr = nr; ini = ni; }
#undef CH_OF
}

#define MFMA16(a, b, c) __builtin_amdgcn_mfma_f32_16x16x32_bf16(a, b, c, 0, 0, 0)
__device__ __forceinline__ void fft1_task(const bf16_t* UF, bf16_t* TB, const f32x2* TW, const LAS unsigned char* w1, int task, int lane) {
    const int fr = lane & 15, fq = lane >> 4, n2 = task >> 5, cb = task & 31;
    bf16x8 xb[4];
#pragma unroll
    for (int ks = 0; ks < 4; ++ks)
#pragma unroll
        for (int i = 0; i < 8; ++i) xb[ks][i] = (short)UF[(size_t)(128 * (32 * ks + 8 * fq + i) + n2) * 512 + 16 * cb + fr];
    f32x2 twc = TW[fr * 128 + n2];
    bf16_t* tbp = TB + ((size_t)fr * 128 + n2) * 512 + 16 * cb + 4 * fq;
#pragma unroll 1
    for (int mt = 0; mt < 8; ++mt) {
        const int mn = mt < 7 ? mt + 1 : mt; const f32x2 twn = TW[(16 * mn + fr) * 128 + n2];
        pg8::f32x4 accr = {0.f, 0.f, 0.f, 0.f}, acci = {0.f, 0.f, 0.f, 0.f};
#pragma unroll
        for (int ks = 0; ks < 4; ++ks) {
            const bf16x8 wre = *(const LAS bf16x8*)(w1 + (16 * mt + fr) * 272 + (32 * ks + 8 * fq) * 2);
            const bf16x8 wim = *(const LAS bf16x8*)(w1 + (128 + 16 * mt + fr) * 272 + (32 * ks + 8 * fq) * 2);
            accr = MFMA16(xb[ks], wre, accr); acci = MFMA16(xb[ks], wim, acci);
        }
        float tr[4], ti[4];
#pragma unroll
        for (int e = 0; e < 4; ++e) { tr[e] = accr[e] * twc.x + acci[e] * twc.y; ti[e] = acci[e] * twc.x - accr[e] * twc.y; }
        u32x2 wr_; wr_.x = pk2(tr[0], tr[1]); wr_.y = pk2(tr[2], tr[3]); u32x2 wi_; wi_.x = pk2(ti[0], ti[1]); wi_.y = pk2(ti[2], ti[3]);
        *(u32x2*)tbp = wr_; *(u32x2*)(tbp + (size_t)128 * 65536) = wi_;
        tbp += (size_t)16 * 65536;
        twc = twn;
    }
}
__device__ __forceinline__ void fft2_task(const bf16_t* TB, bf16_t* XF, const LAS unsigned char* w2, int task, int lane) {
    const int fr = lane & 15, fq = lane >> 4, k1 = task >> 5, cb = task & 31, c = 16 * cb + fr, hh = cb >> 3, cc4 = (16 * cb & 127) + 4 * fq;
    bf16x8 tb[8];
#pragma unroll
    for (int ks = 0; ks < 8; ++ks)
#pragma unroll
        for (int i = 0; i < 8; ++i) { const int kk = 32 * ks + 8 * fq + i; tb[ks][i] = (short)TB[((size_t)((kk >> 7) * 128 + k1) * 128 + (kk & 127)) * 512 + c]; }
    for (int mt = 0; mt < 16; ++mt) {
        pg8::f32x4 acc = {0.f, 0.f, 0.f, 0.f};
#pragma unroll
        for (int ks = 0; ks < 8; ++ks) { const bf16x8 w = *(const LAS bf16x8*)(w2 + (16 * mt + fr) * 528 + (32 * ks + 8 * fq) * 2); acc = MFMA16(tb[ks], w, acc); }
        const int r = 16 * mt + fr, po = r >> 7, k2 = r & 127;
        u32x2 o; o.x = pk2(acc[0], acc[1]); o.y = pk2(acc[2], acc[3]);
        *(u32x2*)(XF + (size_t)(k1 + 128 * k2) * 1024 + hh * 256 + po * 128 + cc4) = o;
    }
}
__device__ __forceinline__ void fftc_task(const bf16_t* UF, bf16_t* XF, const bf16_t* WC, int task, int lane) {
    const int fr = lane & 15, fq = lane >> 4, cb = task & 31, mtg = task >> 5, c = 16 * cb + fr, hh = cb >> 3, cc4 = (16 * cb & 127) + 4 * fq;
    bf16x8 xb[8];
#pragma unroll
    for (int ks = 0; ks < 8; ++ks)
#pragma unroll
        for (int i = 0; i < 8; ++i) xb[ks][i] = (short)UF[(size_t)(L + 32 * ks + 8 * fq + i) * 512 + c];
    for (int mt = 8 * mtg; mt < 8 * mtg + 8; ++mt) {
        pg8::f32x4 acc = {0.f, 0.f, 0.f, 0.f};
#pragma unroll
        for (int ks = 0; ks < 8; ++ks) { const bf16x8 w = *(const bf16x8*)(WC + (size_t)(16 * mt + fr) * 256 + 32 * ks + 8 * fq); acc = MFMA16(xb[ks], w, acc); }
        const int r = 16 * mt + fr, po = r >> 8, kk = r & 255;
        u32x2 o; o.x = pk2(acc[0], acc[1]); o.y = pk2(acc[2], acc[3]);
        *(u32x2*)(XF + (size_t)(L + kk) * 1024 + hh * 256 + po * 128 + cc4) = o;
    }
}

#define XB_TMO      128
#define XB_XCNT(j)  (256  + 64 * (j))
#define XB_XSUB(j)  (1280 + 64 * (j))
#define XB_XGEN(j)  (2304 + 64 * (j))
#define XB_TOP      3328
#define XB_TOPGEN   3392
#define XCD_BAR_WORDS 3456
#define XB_SPIN_CAP (1u << 18)

__device__ __forceinline__ unsigned xb_ld(unsigned* p)              { return __hip_atomic_load(p, __ATOMIC_RELAXED, __HIP_MEMORY_SCOPE_AGENT); }
__device__ __forceinline__ unsigned xb_add(unsigned* p, unsigned v) { return __hip_atomic_fetch_add(p, v, __ATOMIC_RELAXED, __HIP_MEMORY_SCOPE_AGENT); }
__device__ __forceinline__ unsigned xb_xcc_id() { return (unsigned)__builtin_amdgcn_s_getreg((3 << 11) | 20) & 0xFu; }
#define XB_SPIN(cond, bar) do { unsigned _sp = 0; while (cond) { __builtin_amdgcn_s_sleep(1); \
    if ((++_sp & 255u) == 0u) { if (xb_ld(&(bar)[XB_TMO])) break; if (_sp > XB_SPIN_CAP) { atomicAdd(&(bar)[XB_TMO], 1u); break; } } } } while (0)

struct XcdBarrier {
    unsigned* bar; unsigned x;
    volatile LAS unsigned* st;
};

__device__ __forceinline__ XcdBarrier xcd_barrier_post(unsigned* bar, volatile LAS unsigned* st) {
    XcdBarrier b; b.bar = bar; b.x = xb_xcc_id(); b.st = st;
    if (threadIdx.x == 0) (void)xb_add(&bar[XB_XCNT(b.x)], 1u);
    return b;
}
__device__ __forceinline__ void xcd_barrier_complete(unsigned* bar, unsigned x, unsigned& nloc, unsigned& nx) {
    const unsigned G = gridDim.x * gridDim.y * gridDim.z;
    unsigned sum, cnt, mine, sp = 0u;
    for (;;) {
        sum = 0u; cnt = 0u; mine = 0u;
#pragma unroll
        for (unsigned j = 0; j < 16; ++j) { const unsigned c = xb_ld(&bar[XB_XCNT(j)]); sum += c; cnt += (c > 0u) ? 1u : 0u; mine = (j == x) ? c : mine; }
        if (sum == G) break;
        __builtin_amdgcn_s_sleep(1);
        if ((++sp & 255u) == 0u) { if (xb_ld(&bar[XB_TMO])) break; if (sp > XB_SPIN_CAP) { atomicAdd(&bar[XB_TMO], 1u); break; } }
    }
    nloc = mine > 0u ? mine : 1u; nx = cnt > 0u ? cnt : 1u;
}

__device__ __forceinline__ void xcd_barrier(const XcdBarrier& b) {
    asm volatile("s_waitcnt vmcnt(0)" ::: "memory");
    __syncthreads();
    if (threadIdx.x == 0) {
        unsigned* bar = b.bar;
        __builtin_amdgcn_s_waitcnt(0);
        unsigned nloc = b.st[0], nx = b.st[1];
        if (nloc == 0u) { xcd_barrier_complete(bar, b.x, nloc, nx); b.st[0] = nloc; b.st[1] = nx; }
        const unsigned old = xb_add(&bar[XB_XSUB(b.x)], 1u);
        const unsigned gen = old / nloc;
        if (old + 1u == (gen + 1u) * nloc) {
            __builtin_amdgcn_fence(__ATOMIC_RELEASE, "agent");
            asm volatile("s_waitcnt vmcnt(0)" ::: "memory");
            const unsigned og = xb_add(&bar[XB_TOP], 1u);
            const unsigned tg = og / nx;
            if (og + 1u == (tg + 1u) * nx) xb_add(&bar[XB_TOPGEN], 1u);
            else XB_SPIN(xb_ld(&bar[XB_TOPGEN]) == tg, bar);
            __builtin_amdgcn_fence(__ATOMIC_ACQUIRE, "agent");
            xb_add(&bar[XB_XGEN(b.x)], 1u);
            asm volatile("s_waitcnt vmcnt(0)" ::: "memory");
        } else {
            XB_SPIN(xb_ld(&bar[XB_XGEN(b.x)]) == gen, bar);
            __builtin_amdgcn_fence(__ATOMIC_ACQUIRE, "agent");
            asm volatile("s_waitcnt vmcnt(0)" ::: "memory");
        }
    }
    __syncthreads();
}

constexpr int TAB_OFF = LDS_BYTES - 256;
__device__ __forceinline__ const void* tabptr(LAS unsigned char* lds, int i) {
    const LAS unsigned* t = (const LAS unsigned*)(lds + TAB_OFF) + 2 * i;
    const unsigned lo = __builtin_amdgcn_readfirstlane(t[0]), hi = __builtin_amdgcn_readfirstlane(t[1]);
    return (const void*)(((unsigned long long)hi << 32) | lo);
}
#define INP(i) ((const float*)tabptr(lds, (i)))
#define PH_IDS \
    int tid = threadIdx.x; asm volatile("" : "+v"(tid)); const int lane = tid & 63, wave = __builtin_amdgcn_readfirstlane(tid >> 6); \
    int bx = blockIdx.x, G = gridDim.x; asm volatile("" : "+s"(bx), "+s"(G)); \
    const int gw = bx * 8 + wave, NGW = G * 8, gt = bx * 512 + tid, NTH = G * 512; (void)lane; (void)gw; (void)NGW; (void)gt; (void)NTH; \
    unsigned char* ws = (unsigned char*)tabptr(lds, 29); (void)ws;
#define WSP(T, off) ((T*)(ws + (off)))
__device__ __forceinline__ void conv_item(LAS unsigned char* lds, unsigned char* ws, int it, LAS float* scr, int lane) {
    const int layer = it / 10816; int r = it - layer * 10816;
    if (r < 1280) { tr_item(INP(10) + (size_t)layer * DM * INW, DM, INW, WSP(bf16_t, O_WIN) + (size_t)layer * INW * DM, 0, scr, r, lane); return; } r -= 1280;
    if (r < 1024) { tr_item(INP(24) + (size_t)layer * DM * DM, DM, DM, WSP(bf16_t, O_WOUT) + (size_t)layer * DM * DM, 0, scr, r, lane); return; } r -= 1024;
    if (r < 2816) { tr_item(INP(25) + (size_t)layer * DM * FF, DM, FF, WSP(bf16_t, O_WGU) + (size_t)layer * 2 * FF * DM, 1, scr, r, lane); return; } r -= 2816;
    if (r < 2816) { tr_item(INP(26) + (size_t)layer * DM * FF, DM, FF, WSP(bf16_t, O_WGU) + (size_t)layer * 2 * FF * DM, 2, scr, r, lane); return; } r -= 2816;
    if (r < 2816) { tr_item(INP(27) + (size_t)layer * FF * DM, FF, DM, WSP(bf16_t, O_WDN) + (size_t)layer * DM * FF, 0, scr, r, lane); return; } r -= 2816;
    tr_item(INP(21) + (size_t)layer * 512 * 512, 512, 512, WSP(bf16_t, O_WGLU) + (size_t)layer * 512 * 512, 0, scr, r, lane);
}
constexpr int CONV_P0 = 6552;
constexpr int CONV_B = 6616;
constexpr int CONV_A = 4200;

#define GSYNC() do { XcdBarrier b_; b_.bar = (unsigned*)((unsigned char*)tabptr(lds, 29) + O_BAR); b_.x = xb_xcc_id(); b_.st = (volatile LAS unsigned*)(lds + TAB_OFF - 16); xcd_barrier(b_); } while (0)

#ifndef PROBE_CAT
#define PROBE_CAT 0
#endif
#if PROBE_CAT
#define PB(cat) do { if (PROBE_CAT == (cat)) t_st = __builtin_amdgcn_s_memrealtime(); } while (0)
#define PE(cat) do { if (PROBE_CAT == (cat)) t_acc += __builtin_amdgcn_s_memrealtime() - t_st; } while (0)
#else
#define PB(cat) do {} while (0)
#define PE(cat) do {} while (0)
#endif
__global__ void __launch_bounds__(512, 2) hybrid_fwd(Params P) {
    extern __shared__ __attribute__((aligned(16))) unsigned char lds_raw[];
    cg::grid_group grid = cg::this_grid();
#if PROBE_CAT
    unsigned long long t_acc = 0, t_st = 0;
#endif
    LAS unsigned char* lds = (LAS unsigned char*)lds_raw;
    if (threadIdx.x == 0) {
        LAS unsigned long long* t = (LAS unsigned long long*)(lds + TAB_OFF);
#pragma unroll
        for (int i = 0; i < 28; ++i) t[i] = (unsigned long long)P.in[i];
        t[28] = (unsigned long long)P.out; t[29] = (unsigned long long)P.ws;
        LAS unsigned* xst = (LAS unsigned*)(lds + TAB_OFF - 16); xst[0] = 0u; xst[1] = 0u;
        (void)xb_add((unsigned*)(P.ws + O_BAR) + XB_XCNT(xb_xcc_id()), 1u);
    }
    __syncthreads();

    PB(5);
    {
        PH_IDS
        LAS float* sl = (LAS float*)lds;
        LAS float* ct = (LAS float*)(lds + 16384);
        { const float* cin = INP(1); const float* cctx = INP(3);
          for (int i = tid; i < 2048; i += 512) { const float a = cin[i], b = cctx[i]; sl[i] = a / (1.f + expf(-a)); sl[2048 + i] = b / (1.f + expf(-b)); } }
        if (tid < 128) ct[tid] = cospif((float)tid * (1.f / 64.f));
        __syncthreads();
        { const float* adaw = INP(4); float* MODP = WSP(float, O_MODP);
          for (int it = gt; it < 98304; it += NTH) {
            const int kc = it / 6144, r = it - kc * 6144, layer = r / 3072, c4 = r - layer * 3072;
            const float* w = adaw + ((size_t)layer * 2048 + kc * 128) * 12288 + 4 * c4;
            f32x4 a0 = {0.f, 0.f, 0.f, 0.f}, a1 = {0.f, 0.f, 0.f, 0.f};
#pragma unroll 8
            for (int k = 0; k < 128; ++k) { const f32x4 wv = *(const f32x4*)(w + (size_t)k * 12288); const float s0 = sl[kc * 128 + k], s1 = sl[2048 + kc * 128 + k]; a0 += wv * s0; a1 += wv * s1; }
            float* o = MODP + ((size_t)(kc * 2 + layer) * 2) * 12288 + 4 * c4;
            *(f32x4*)o = a0; *(f32x4*)(o + 12288) = a1;
          } }
        { float* ROPE = WSP(float, O_ROPE);
          for (int it = gt; it < 8192; it += NTH) { const int pos = it >> 5, i = it & 31; const float freq = powf(10000.f, -(float)i * (1.f / 32.f)); const float ang = (float)pos * freq;
            const double a = (double)ang, kq = rint(a * 0.15915494309189535), rr = a - kq * 6.283185307179586; const float rf = (float)rr; ROPE[2 * it] = cosf(rf); ROPE[2 * it + 1] = sinf(rf); } }
        { const float* lamre = INP(13); const float* lamim = INP(14); const float* logdt = INP(15); const float* bre = INP(16); const float* bim = INP(17); const float* cre = INP(18); const float* cim = INP(19);
          f32x4* AB = WSP(f32x4, O_AB); unsigned* BBT32 = WSP(unsigned, O_BBT); unsigned* CB32 = WSP(unsigned, O_CB);
          for (int it = gt; it < 8192; it += NTH) {
            const int p = it & 63;
            const float lr = lamre[it], li = lamim[it], ldt = logdt[it >> 6];
            const float dt = expf(ldt), mag = expf(lr * dt), th = li * dt;
            const float ar = mag * cosf(th), ai = mag * sinf(th);
            const float den = lr * lr + li * li, cr = ((ar - 1.f) * lr + ai * li) / den, ci = (ai * lr - (ar - 1.f) * li) / den;
            float pr = ar, pi = ai;
#pragma unroll
            for (int s = 0; s < 6; ++s) { const float nr = pr * pr - pi * pi, ni = 2.f * pr * pi; pr = nr; pi = ni; }
            AB[it] = (f32x4){ar, ai, pr, pi};
#pragma unroll
            for (int h = 0; h < 16; h += 2) { const float br0 = bre[(size_t)it * 16 + h], bi0 = bim[(size_t)it * 16 + h], br1 = bre[(size_t)it * 16 + h + 1], bi1 = bim[(size_t)it * 16 + h + 1];
                BBT32[((size_t)(it >> 6) * 128 + p) * 8 + (h >> 1)] = pk2(cr * br0 - ci * bi0, cr * br1 - ci * bi1);
                BBT32[((size_t)(it >> 6) * 128 + 64 + p) * 8 + (h >> 1)] = pk2(cr * bi0 + ci * br0, cr * bi1 + ci * br1); }
#pragma unroll
            for (int h = 0; h < 16; ++h) { const size_t ci_ = ((size_t)(it >> 6) * 16 + h) * 64 + p; CB32[ci_] = pk2(cre[ci_], -cim[ci_]); }
          } }
        { bf16_t* W1 = WSP(bf16_t, O_W1); bf16_t* W2 = WSP(bf16_t, O_W2); bf16_t* WC = WSP(bf16_t, O_WC); f32x2* TW = WSP(f32x2, O_TW);
          for (int it = gt; it < 32768; it += NTH) { const int r = it >> 7, n1 = it & 127, m = ((r & 127) * n1) & 127; const float x = (float)m * (1.f / 64.f); W1[it] = f2bf(r < 128 ? cospif(x) : -sinpif(x)); }
          for (int it = gt; it < 65536; it += NTH) { const int r = it >> 8, kk = it & 255, po = r >> 7, k2 = r & 127, pi_ = kk >> 7, n2 = kk & 127, m = (k2 * n2) & 127; const float x = (float)m * (1.f / 64.f);
            const float cv = cospif(x), sv = sinpif(x); W2[it] = f2bf(po == pi_ ? cv : (po == 0 ? sv : -sv)); }
          for (int it = gt; it < 131072; it += NTH) { const int r = it >> 8, n = it & 255, part = r >> 8, k = r & 255, m = (k * n) & 255; const float x = (float)m * (1.f / 128.f); WC[it] = f2bf(8.f * (part == 0 ? cospif(x) : -sinpif(x))); }
          for (int it = gt; it < 16384; it += NTH) { const int k1 = it >> 7, n2 = it & 127; const float x = (float)(k1 * n2) * (1.f / 8192.f); TW[it] = (f32x2){cospif(x), sinpif(x)}; } }
        { const float* fwp = INP(23); bf16_t* WF = WSP(bf16_t, O_WF);
          for (int it = gt; it < 2 * 131072; it += NTH) { const int layer = it >> 17, r = it & 131071, n4 = r & 127, kk = r >> 7, hh = kk >> 8, part = (kk >> 7) & 1, c = kk & 127;
            const float* fw = fwp + (size_t)layer * 262144 + (size_t)(hh * 128) * 512 + 4 * n4; f32x4 acc = {0.f, 0.f, 0.f, 0.f};
#pragma unroll 4
            for (int j = 0; j < 128; ++j) { const int m = (c * j) & 127; const float t = part ? ct[(m + 96) & 127] : ct[m]; acc += *(const f32x4*)(fw + (size_t)j * 512) * t; }
            bf16_t* o = WF + (size_t)layer * 524288 + (size_t)(4 * n4) * 1024 + kk;
            o[0] = f2bf(acc.x * 6.9053396600248786e-4f); o[1024] = f2bf(acc.y * 6.9053396600248786e-4f); o[2048] = f2bf(acc.z * 6.9053396600248786e-4f); o[3072] = f2bf(acc.w * 6.9053396600248786e-4f); } }
        __syncthreads();
        { LAS float* scr = (LAS float*)(lds + wave * 16640);
          if (G == 256) { for (int it = gw; it < CONV_P0 + 64; it += NGW) conv_item(lds, ws, it < CONV_P0 ? it : 10752 + (it - CONV_P0), scr, lane); }
          else { for (int it = gw; it < 2 * 10816; it += NGW) conv_item(lds, ws, it, scr, lane); } }
    }
    grid.sync();
    {
        PH_IDS
        const float* adab = INP(5); const float* MODP = WSP(float, O_MODP); float* MOD = WSP(float, O_MOD);
        for (int it = gt; it < 49152; it += NTH) { const int layer = it / 24576, v = (it / 12288) & 1, col = it % 12288; float s = adab[layer * 12288 + col];
#pragma unroll
            for (int kc = 0; kc < 16; ++kc) s += MODP[((size_t)(kc * 2 + layer) * 2 + v) * 12288 + col];
            MOD[it] = s; }
    }
    GSYNC();
    PE(5); PB(4);
    {
        PH_IDS
        const float* MOD = WSP(float, O_MOD);
        prenorm_rows(INP(0), INP(2), WSP(bf16_t, O_H), INP(6), MOD, MOD + 12288, 0, 2048, MT, gw, NGW, lane);
    }
    GSYNC();

    PE(4);
#pragma unroll 1
    for (int layer = 0; layer < 2; ++layer) {
        PB(1);
        { PH_IDS
          pg8::Gemm g{WSP(bf16_t, O_H), WSP(bf16_t, O_WIN) + (size_t)layer * INW * DM, MT, INW, DM}; pg8::StaticOrder S; S.init(MT, INW, G, bx);
          EpiIn E{WSP(float, O_QRAW), WSP(float, O_KRAW), WSP(bf16_t, O_VB), WSP(bf16_t, O_US), WSP(bf16_t, O_UF)};
          pg8::gemm_phase<EpiIn, pg8::StaticOrder, true, true>(lds, g, S, E);
          if (G == 256 && bx >= 138) { LAS float* scr = (LAS float*)(lds + wave * 16640);
              if (layer == 0) { for (int r = CONV_P0 + (bx - 138) * 8 + wave; r < 10752; r += 118 * 8) conv_item(lds, ws, r, scr, lane); }
              else            { for (int r = CONV_B + (bx - 138) * 8 + wave; r < 10816; r += 118 * 8) conv_item(lds, ws, 10816 + r, scr, lane); } } }
        GSYNC();
        PE(1); PB(3); PB(31);
        {
            PH_IDS
            { const bf16_t* W1 = WSP(bf16_t, O_W1);
              for (int i = tid; i < 256 * 16; i += 512) { const int r = i >> 4, ch = i & 15; *(LAS u32x4*)(lds + r * 272 + ch * 16) = *(const u32x4*)(W1 + r * 128 + ch * 8); } }
            __syncthreads();
            { const bf16_t* UF = WSP(bf16_t, O_UF); bf16_t* TB = WSP(bf16_t, O_TB); const f32x2* TW = WSP(f32x2, O_TW);
              for (int task = gw; task < 4096; task += NGW) fft1_task(UF, TB, TW, lds, task, lane); }
            { LAS float* usb = (LAS float*)(lds + 69632 + wave * 8192);
              const bf16_t* US = WSP(bf16_t, O_US); const f32x4* AB = WSP(f32x4, O_AB); const bf16_t* BBT = WSP(bf16_t, O_BBT); float* SS = WSP(float, O_S);
              int cur = 0;
              if (gw < NCH * 32) ssm_dma_u(US, usb, gw >> 5, gw & 31, lane);
              for (int task = gw; task < NCH * 32; task += NGW) { const int k = task >> 5, g = task & 31, nxt = task + NGW;
                asm volatile("s_waitcnt vmcnt(0)" ::: "memory");
                if (nxt < NCH * 32) ssm_dma_u(US, usb + (cur ^ 1) * 1024, nxt >> 5, nxt & 31, lane);
                const int ldg0 = (layer * 2) * 32 + g, ldg1 = ldg0 + 32;
                const f32x4 ab0 = AB[ldg0 * 64 + lane], ab1 = AB[ldg1 * 64 + lane];
                const LAS float* us = usb + cur * 1024;
                bf16x8 bf0[4], bf1[4]; ssm_load_bf4(BBT, bf0, ldg0, lane); ssm_load_bf4(BBT, bf1, ldg1, lane);
                ssm_s1_run<0>(ab0.x, ab0.y, bf0, us, SS + ((size_t)(0 * NCH + k) * 32 + g) * 128, lane);
                ssm_s1_run<1>(ab1.x, ab1.y, bf1, us, SS + ((size_t)(1 * NCH + k) * 32 + g) * 128, lane);
                cur ^= 1; } }
            kq_post(WSP(float, O_QRAW), WSP(float, O_KRAW), WSP(bf16_t, O_QB), WSP(bf16_t, O_KB), INP(11) + layer * 128, INP(12) + layer * 128, WSP(float, O_ROPE), gw, NGW, lane);
        }
        GSYNC();
        PE(31); PB(32);
        {
            PH_IDS
            { const bf16_t* W2 = WSP(bf16_t, O_W2);
              for (int i = tid; i < 256 * 32; i += 512) { const int r = i >> 5, ch = i & 31; *(LAS u32x4*)(lds + r * 528 + ch * 16) = *(const u32x4*)(W2 + r * 256 + ch * 8); } }
            __syncthreads();
            { const f32x4* AB = WSP(f32x4, O_AB); const float* SS = WSP(float, O_S); float* HIN = WSP(float, O_HIN);
              for (int task = gw; task < 4096; task += NGW) ssm_s2_task(AB, SS, HIN, layer, task, lane); }
            { const bf16_t* TB = WSP(bf16_t, O_TB); bf16_t* XF = WSP(bf16_t, O_XF);
              for (int task = gw; task < 4096; task += NGW) fft2_task(TB, XF, lds, task, lane); }
            if (layer == 0) { const bf16_t* UF = WSP(bf16_t, O_UF); bf16_t* XF = WSP(bf16_t, O_XF); const bf16_t* WC = WSP(bf16_t, O_WC);
              for (int task = gw; task < 128; task += NGW) fftc_task(UF, XF, WC, task, lane); }
        }
        GSYNC();
        PE(32); PB(33);
        {
            PH_IDS
            LAS float* usb = (LAS float*)(lds + wave * 16896);
            LAS unsigned* st = (LAS unsigned*)(lds + wave * 16896 + 8192);
            const int fr = lane & 15, fq = lane >> 4;
            const int ntask = (layer == 0 ? NCH : 256) * 32;
            const bf16_t* US = WSP(bf16_t, O_US); const f32x4* AB = WSP(f32x4, O_AB); const bf16_t* BBT = WSP(bf16_t, O_BBT); const bf16_t* CB = WSP(bf16_t, O_CB); const float* HIN = WSP(float, O_HIN);
            bf16_t* GB = WSP(bf16_t, O_G); const float* dvp = INP(20) + layer * 512;
            int cur = 0;
            if (gw < ntask) ssm_dma_u(US, usb, gw >> 5, gw & 31, lane);
            for (int task = gw; task < ntask; task += NGW) { const int k = task >> 5, g = task & 31, nxt = task + NGW;
                asm volatile("s_waitcnt vmcnt(0)" ::: "memory");
                if (nxt < ntask) ssm_dma_u(US, usb + (cur ^ 1) * 1024, nxt >> 5, nxt & 31, lane);
                const int ldg0 = (layer * 2) * 32 + g, ldg1 = ldg0 + 32;
                const f32x4 ab0 = AB[ldg0 * 64 + lane], ab1 = AB[ldg1 * 64 + lane];
                const float* hin0 = HIN + ((size_t)(0 * NCH + k) * 32 + g) * 128; const float* hin1 = HIN + ((size_t)(1 * NCH + k) * 32 + g) * 128;
                const f32x2 hh0 = {hin0[lane], hin0[64 + lane]}, hh1 = {hin1[lane], hin1[64 + lane]};
                const f32x4 dv4 = *(const f32x4*)(dvp + 16 * g + 4 * fq);
                bf16x8 cb0[4], cb1[4];
#pragma unroll
                for (int ks = 0; ks < 4; ++ks) { cb0[ks] = *(const bf16x8*)(CB + ((size_t)(ldg0 * 16 + fr)) * 128 + 32 * ks + 8 * fq); cb1[ks] = *(const bf16x8*)(CB + ((size_t)(ldg1 * 16 + fr)) * 128 + 32 * ks + 8 * fq); }
                const LAS float* us = usb + cur * 1024;
                pg8::f32x4 yacc[4];
#pragma unroll
                for (int q = 0; q < 4; ++q) yacc[q] = (pg8::f32x4){0.f, 0.f, 0.f, 0.f};
                bf16x8 bf0[4], bf1[4]; ssm_load_bf4(BBT, bf0, ldg0, lane); ssm_load_bf4(BBT, bf1, ldg1, lane);
                ssm_s3_run<0>(ab0.x, ab0.y, bf0, cb0, hh0, us, st, yacc, lane);
                ssm_s3_run<1>(ab1.x, ab1.y, bf1, cb1, hh1, us, st, yacc, lane);
#pragma unroll
                for (int q = 0; q < 4; ++q) { const int tok = 16 * q + fr; const u32x2 uw_ = *(const LAS u32x2*)((const LAS unsigned char*)us + (fq >> 1) * 1024 + tok * 16 + (fq & 1) * 8); const f32x4 u4 = {bf2f(uw_.x & 0xffffu), bf2f(uw_.x >> 16), bf2f(uw_.y & 0xffffu), bf2f(uw_.y >> 16)};
                    const float y0 = gelu_tanh(yacc[q][0] + dv4.x * u4.x), y1 = gelu_tanh(yacc[q][1] + dv4.y * u4.y), y2 = gelu_tanh(yacc[q][2] + dv4.z * u4.z), y3 = gelu_tanh(yacc[q][3] + dv4.w * u4.w);
                    u32x2 o; o.x = pk2(y0, y1); o.y = pk2(y2, y3); *(u32x2*)(GB + (size_t)(64 * k + tok) * 512 + 16 * g + 4 * fq) = o; }
                cur ^= 1;
            }
        }
        GSYNC();
        PE(3); PE(33); PB(6);
        { PH_IDS
          const int MR = layer == 0 ? MT : L;
          pg8::Gemm g{WSP(bf16_t, O_G), WSP(bf16_t, O_WGLU) + (size_t)layer * 512 * 512, MR, 512, 512}; pg8::StaticOrder S; S.init(MR, 512, G, bx);
          EpiMix E{WSP(bf16_t, O_CAT), WSP(bf16_t, O_G), INP(22) + layer * 512, 0};
          pg8::gemm_phase<EpiMix, pg8::StaticOrder, true, true>(lds, g, S, E); }
        __syncthreads();
        { PH_IDS
          const int MR = layer == 0 ? MT : L;
          pg8::Gemm g{WSP(bf16_t, O_XF), WSP(bf16_t, O_WF) + (size_t)layer * 524288, MR, 512, 1024}; pg8::StaticOrder S; S.init(MR, 512, G, (bx + 128) % G);
          EpiMix E{WSP(bf16_t, O_CAT), WSP(bf16_t, O_G), INP(22) + layer * 512, 1};
          pg8::gemm_phase<EpiMix, pg8::StaticOrder, true, true>(lds, g, S, E); }
        __syncthreads();
        PE(6); PB(2);
        { PH_IDS
          const float* q_ = WSP(const float, O_QRAW); const att::bf16* k_ = WSP(const att::bf16, O_KB); const att::bf16* v_ = WSP(const att::bf16, O_VB); att::bf16* o_ = WSP(att::bf16, O_CAT);
          const float* wqn = INP(11) + layer * 128; const float* ropet = WSP(float, O_ROPE);
          float negB;
          { const float* qn = INP(11) + layer * 128; const float* kn = INP(12) + layer * 128;
            float wq = fmaxf(fabsf(qn[lane]), fabsf(qn[64 + lane])), wk = fmaxf(fabsf(kn[lane]), fabsf(kn[64 + lane]));
#pragma unroll
            for (int o = 1; o < 64; o <<= 1) { wq = fmaxf(wq, __shfl_xor(wq, o)); wk = fmaxf(wk, __shfl_xor(wk, o)); }
            negB = -(16.32212f * wq * wk * 1.02f + 0.25f); }
          for (int u = bx; u < 512; u += G) { const int xcd = u & 7, j = (u >> 3) & 31, rr = u >> 8, kvh = xcd & 1, head = 4 * kvh + (xcd >> 1), qb = j + 32 * rr;
              att::attn_dense_body<float>(q_ + (size_t)qb * 256 * 1024 + head * 128, k_ + kvh * 128, v_ + kvh * 128, o_ + (size_t)qb * 256 * 2048 + head * 128, MT, (char*)lds_raw, negB, wqn, ropet, qb * 256);
              __syncthreads(); }
          if (layer == 0 && bx >= 8 && bx < 16) { const int head = bx - 8, kvh = head >> 2;
              att::attn_dense_body<float>(q_ + (size_t)L * 1024 + head * 128, k_ + (size_t)L * 256 + kvh * 128, v_ + (size_t)L * 256 + kvh * 128, o_ + (size_t)L * 2048 + head * 128, 256, (char*)lds_raw, negB, wqn, ropet, -1);
              __syncthreads(); }
        }
        GSYNC();
        PE(2); PB(1);
        { PH_IDS
          pg8::Gemm g{WSP(bf16_t, O_CAT), WSP(bf16_t, O_WOUT) + (size_t)layer * DM * DM, L, DM, DM}; pg8::StaticOrder S; S.init(L, DM, G, bx);
          EpiF32 E{WSP(bf16_t, O_Y), DM};
          pg8::gemm_phase<EpiF32, pg8::StaticOrder, true, true>(lds, g, S, E); }
        GSYNC();
        PE(1); PB(4);
        { PH_IDS
          const bool ctxl = (layer == 0) && (G > 16);
          if (ctxl && bx < 8) {
              pg8::Gemm g{WSP(bf16_t, O_CAT) + (size_t)L * DM, WSP(bf16_t, O_WOUT) + (size_t)layer * DM * DM, 256, DM, DM}; pg8::StaticOrder S; S.init(256, DM, 8, bx);
              EpiF32 E{WSP(bf16_t, O_Y) + (size_t)L * DM, DM};
              pg8::gemm_phase<EpiF32, pg8::StaticOrder, true, true>(lds, g, S, E);
          } else {
              const float* modl = WSP(float, O_MOD) + (size_t)layer * 24576; const float* modc = modl + 12288;
              float* outp = (float*)tabptr(lds, 28); float* XC = WSP(float, O_XC);
              const float* xl_src = layer == 0 ? INP(0) : outp; const float* xc_src = layer == 0 ? INP(2) : XC;
              const int gwp = ctxl ? gw - 64 : gw, ngwp = ctxl ? NGW - 64 : NGW;
              post_rows<true>(xl_src, xc_src, outp, XC, WSP(bf16_t, O_Y), INP(7) + layer * DM, modl, modc, 2 * 2048, true, WSP(bf16_t, O_H), INP(8) + layer * DM, modl, modc, 3 * 2048, 4 * 2048,
                        0, L, gwp, ngwp, lane, (LAS float*)lds, tid);
          } }
        GSYNC();
        if (layer == 0 && gridDim.x > 16) {
            { PH_IDS
              const float* modl = WSP(float, O_MOD); const float* modc = modl + 12288; float* outp = (float*)tabptr(lds, 28); float* XC = WSP(float, O_XC);
              post_rows<false>(INP(0), INP(2), outp, XC, WSP(bf16_t, O_Y), INP(7), modl, modc, 2 * 2048, true, WSP(bf16_t, O_H), INP(8), modl, modc, 3 * 2048, 4 * 2048, L, MT, gw, NGW, lane, (LAS float*)lds, tid); }
            GSYNC();
        }
        PE(4); PB(1);
        { PH_IDS
          const int MR = layer == 0 ? MT : L;
          pg8::Gemm g{WSP(bf16_t, O_H), WSP(bf16_t, O_WGU) + (size_t)layer * 2 * FF * DM, MR, 2 * FF, DM}; pg8::StaticOrder S; S.init(MR, 2 * FF, G, bx);
          EpiUp E{WSP(bf16_t, O_HID)};
          pg8::gemm_phase<EpiUp, pg8::StaticOrder, true, true>(lds, g, S, E);
          if (layer == 0 && G == 256 && bx >= 44) { LAS float* scr = (LAS float*)(lds + wave * 16640);
              for (int r = (bx - 44) * 8 + wave; r < CONV_B; r += 212 * 8) conv_item(lds, ws, 10816 + r, scr, lane); } }
        GSYNC();
        { PH_IDS
          pg8::Gemm g{WSP(bf16_t, O_HID), WSP(bf16_t, O_WDN) + (size_t)layer * DM * FF, L, DM, FF}; pg8::StaticOrder S; S.init(L, DM, G, bx);
          EpiF32 E{WSP(bf16_t, O_Y), DM};
          pg8::gemm_phase<EpiF32, pg8::StaticOrder, true, true>(lds, g, S, E); }
        GSYNC();
        PE(1); PB(4);
        { PH_IDS
          const bool ctxl = (layer == 0) && (G > 16);
          if (ctxl && bx < 32) {
              const int kp = bx >> 3;
              pg8::Gemm g{WSP(bf16_t, O_HID) + (size_t)L * FF + kp * (FF / 4), WSP(bf16_t, O_WDN) + (size_t)layer * DM * FF + kp * (FF / 4), 256, DM, FF / 4, FF}; pg8::StaticOrder S; S.init(256, DM, 8, bx & 7);
              EpiP32 E{WSP(float, O_YP) + (size_t)kp * 256 * DM, DM};
              pg8::gemm_phase<EpiP32, pg8::StaticOrder, true, true>(lds, g, S, E);
          } else {
              const float* modl = WSP(float, O_MOD) + (size_t)layer * 24576; const float* modc = modl + 12288; const float* nmodl = modl + 24576;
              float* outp = (float*)tabptr(lds, 28); float* XC = WSP(float, O_XC);
              const int gwp = ctxl ? gw - 256 : gw, ngwp = ctxl ? NGW - 256 : NGW;
              post_rows<true>(outp, XC, outp, XC, WSP(bf16_t, O_Y), INP(9) + layer * DM, modl, modc, 5 * 2048, layer == 0, WSP(bf16_t, O_H), INP(6) + (layer + 1) * DM, nmodl, nmodl + 12288, 0, 2048,
                        0, L, gwp, ngwp, lane, (LAS float*)lds, tid);
          } }
        GSYNC();
        if (layer == 0 && gridDim.x > 16) {
            { PH_IDS
              const float* modl = WSP(float, O_MOD); const float* modc = modl + 12288; const float* nmodl = modl + 24576; float* outp = (float*)tabptr(lds, 28); float* XC = WSP(float, O_XC);
              post_rows<false>(outp, XC, outp, XC, WSP(bf16_t, O_Y), INP(9), modl, modc, 5 * 2048, true, WSP(bf16_t, O_H), INP(6) + DM, nmodl, nmodl + 12288, 0, 2048, L, MT, gw, NGW, lane, (LAS float*)lds, tid, WSP(float, O_YP)); }
            GSYNC();
        }
        PE(4);
    }
#if PROBE_CAT == 9
    for (int i = 0; i < 40; ++i) grid.sync();
#endif
#if PROBE_CAT
    if (blockIdx.x == 0) { const unsigned long long t0 = __builtin_amdgcn_s_memrealtime(); while (__builtin_amdgcn_s_memrealtime() - t0 < t_acc) __builtin_amdgcn_s_sleep(8); }
#endif
}

extern "C" void kernel_launch(void* const* d_in, const int* in_sizes, int n_in, void* d_out, int out_size, void* d_ws, size_t ws_size, hipStream_t stream) {
    static int grid = 0;
    if (grid == 0) {
        if (n_in != 28 || ws_size < WS_END) { fprintf(stderr, "kernel_launch: n_in %d (want 28), ws %zu (want >= %zu)\n", n_in, ws_size, (size_t)WS_END); grid = -1; return; }
        int dev = 0, cus = 0, per_cu = 0;
        (void)hipGetDevice(&dev); (void)hipDeviceGetAttribute(&cus, hipDeviceAttributeMultiprocessorCount, dev);
        if (hipFuncSetAttribute((const void*)hybrid_fwd, hipFuncAttributeMaxDynamicSharedMemorySize, LDS_BYTES) != hipSuccess) { fprintf(stderr, "kernel_launch: hipFuncSetAttribute failed\n"); grid = -1; return; }
        if (hipOccupancyMaxActiveBlocksPerMultiprocessor(&per_cu, (const void*)hybrid_fwd, 512, LDS_BYTES) != hipSuccess || per_cu < 1) { fprintf(stderr, "kernel_launch: occupancy query gave %d\n", per_cu); per_cu = 1; }
        (void)hipGetLastError();
        grid = cus * 1;
        if (grid <= 0) grid = 256;
    }
    if (grid < 0) return;
    Params p{};
    for (int i = 0; i < 28; ++i) p.in[i] = (const float*)d_in[i];
    p.out = (float*)d_out; p.ws = (unsigned char*)d_ws;
    (void)hipMemsetAsync((unsigned char*)d_ws + O_BAR, 0, 16384, stream);
    void* args[] = {&p};
    hipError_t e = hipLaunchCooperativeKernel((const void*)hybrid_fwd, dim3(grid), dim3(512), args, LDS_BYTES, stream);
    if (e != hipSuccess) fprintf(stderr, "kernel_launch: cooperative launch failed: %s (grid %d)\n", hipGetErrorString(e), grid);
}
```

```cpp
#include <hip/hip_runtime.h>
#include <hip/hip_cooperative_groups.h>
#include <hip/hip_bf16.h>
#include <cstdio>
#include <cstdint>
#include <cmath>
namespace cg = cooperative_groups;
namespace pg8 {
#define PG8_LAS __attribute__((address_space(3)))
typedef unsigned short bf16_t;
typedef short bf16x8 __attribute__((ext_vector_type(8)));
typedef float f32x4 __attribute__((ext_vector_type(4)));
typedef unsigned u32x4 __attribute__((ext_vector_type(4)));
constexpr int BM = 256, BK = 64, HALF = 128, HTB = HALF * BK * 2  , STAGE_BYTES = 8 * HTB, NXCD = 8, WGM = 8;

__host__ __device__ __forceinline__ int lds_byte(int r, int c) { const int st = (r >> 4) * 2 + (c >> 5), rr = r & 15, cc = c & 31, ob = rr * 64 + cc * 2; return st * 1024 + (ob ^ (((ob >> 9) & 1) << 5)); }
__host__ __device__ __forceinline__ void stage_rc(int b, int& R, int& C) { const int st = b / 1024, sb = b % 1024, swz = sb ^ (((sb >> 9) & 1) << 5); R = (st >> 1) * 16 + swz / 64; C = (st & 1) * 32 + (swz % 64) / 2; }
__host__ __device__ __forceinline__ int perm32(int rho) { const int n = rho >> 4, i = rho & 15; return 8 * (i >> 2) + 4 * n + (i & 3); }

struct Unit { int pm, pn; };
struct Gemm { const bf16_t* A; const bf16_t* Bt; int M, N, K; int ld = 0; };

struct StaticOrder {
    int nM, nN, nwg, G, c;
    __host__ __device__ void init(int M, int N, int G_, int c_) { nM = M / BM; nN = N / BM; nwg = nM * nN; G = G_; c = c_; }
    __host__ __device__ bool next(int i, Unit& u) const {
        const long L = (long)i * G + c; if (L >= nwg) return false;
        int wgid = (int)L; { const int q = nwg / NXCD, r = nwg % NXCD, xcd = wgid % NXCD, off = wgid / NXCD; wgid = (xcd < r ? xcd * (q + 1) : r * (q + 1) + (xcd - r) * q) + off; }
        const int nig = WGM * nN, gid = wgid / nig, fm = gid * WGM, gsz = (nM - fm) < WGM ? (nM - fm) : WGM;
        u.pm = fm + ((wgid % nig) % gsz); u.pn = (wgid % nig) / gsz; return true;
    }
    __device__ __forceinline__ void a_ready(const Unit&) const {}
    __device__ __forceinline__ void done(const Unit&) const {}
};

__device__ __forceinline__ unsigned cvt_pk_bf16(float lo, float hi) { unsigned r; asm volatile("v_cvt_pk_bf16_f32 %0, %1, %2" : "=v"(r) : "v"(lo), "v"(hi)); return r; }
typedef float f32x2 __attribute__((ext_vector_type(2)));
template <class Epi, class Sched, bool ALIGN_EPI = false, bool SP2 = false>
__device__ __forceinline__ void gemm_phase(PG8_LAS unsigned char* lds, const Gemm g, const Sched& S, const Epi& E) {
    int tid_ = threadIdx.x; asm volatile("" : "+v"(tid_)); const int tid = tid_, wid = __builtin_amdgcn_readfirstlane(tid >> 6), lane = tid & 63, wr = wid >> 2, wc = wid & 3, fr = lane & 15, fq = lane >> 4;
    const int nt = g.K / BK, K = g.ld ? g.ld : g.K;
    unsigned voffA[2], voffB[2];
#pragma unroll
    for (int i = 0; i < 2; ++i) { int R, C; stage_rc(tid * 16 + i * 8192, R, C); const int Rb = Epi::PERM ? ((R & ~31) + perm32(R & 31)) : R;
        voffA[i] = (unsigned)(R * K + C) * 2u; voffB[i] = (unsigned)(Rb * K + C) * 2u; }
    const size_t kstep = (size_t)(BK * 2);
    const size_t hstep = (size_t)HALF * K * 2;
    const size_t tstep = 2 * hstep;
    const unsigned ldsw = (unsigned)wid * 1024u;
    const int aoff = lds_byte(wr * 64 + fr, fq * 8), boff = lds_byte(wc * 32 + fr, fq * 8);
#define PG8_SA(b, h) (((b) * 2 + (h)) * HTB)
#define PG8_SB(b, h) ((4 + (b) * 2 + (h)) * HTB)
#define PG8_STAGE(bufoff, gbase, voff) do { _Pragma("unroll") for (int _i = 0; _i < 2; ++_i) \
        __builtin_amdgcn_global_load_lds((const unsigned*)((const char*)(gbase) + (voff)[_i]), (PG8_LAS unsigned*)(lds + (bufoff) + ldsw + _i * 8192), 16, 0, 0); } while (0)
#define PG8_LDA(dst, b, h) do { _Pragma("unroll") for (int m = 0; m < 4; ++m) _Pragma("unroll") for (int k = 0; k < 2; ++k) dst[m][k] = *(const PG8_LAS bf16x8*)(lds + PG8_SA(b, h) + aoff + m * 2048 + k * 1024); } while (0)
#define PG8_LDB(dst, b, h) do { _Pragma("unroll") for (int n = 0; n < 2; ++n) _Pragma("unroll") for (int k = 0; k < 2; ++k) dst[n][k] = *(const PG8_LAS bf16x8*)(lds + PG8_SB(b, h) + boff + n * 2048 + k * 1024); } while (0)
#define PG8_MMA(ai, bj, At, Bt) do { __builtin_amdgcn_s_setprio(1); _Pragma("unroll") for (int m = 0; m < 4; ++m) _Pragma("unroll") for (int n = 0; n < 2; ++n) _Pragma("unroll") for (int k = 0; k < 2; ++k) \
        acc[ai][bj][m][n] = __builtin_amdgcn_mfma_f32_16x16x32_bf16(Bt[n][k], At[m][k], acc[ai][bj][m][n], 0, 0, 0); __builtin_amdgcn_s_setprio(0); } while (0)
#define PG8_WAIT_V(n) asm volatile("s_waitcnt vmcnt(" #n ")" ::: "memory")
#define PG8_WAIT_L(n) asm volatile("s_waitcnt lgkmcnt(" #n ")" ::: "memory")
#define PG8_BAR __builtin_amdgcn_s_barrier()
#define PG8_SCHED __builtin_amdgcn_sched_barrier(0)
    Unit cur, nxt; int ui = 0;
    if (!S.next(0, cur)) return;
    f32x4 acc[2][2][4][2];
#pragma unroll
    for (int a = 0; a < 2; ++a)
#pragma unroll
        for (int b = 0; b < 2; ++b)
#pragma unroll
            for (int m = 0; m < 4; ++m)
#pragma unroll
                for (int n = 0; n < 2; ++n) acc[a][b][m][n] = (f32x4){0.f, 0.f, 0.f, 0.f};
    bf16x8 At[4][2], B0[2][2], B1[2][2];
    const char* cA = (const char*)g.A + (size_t)cur.pm * tstep; const char* cB = (const char*)g.Bt + (size_t)cur.pn * tstep;
    S.a_ready(cur);
    if constexpr (SP2) {
        PG8_STAGE(PG8_SB(0, 0), cB, voffB); PG8_STAGE(PG8_SB(0, 1), cB + hstep, voffB); PG8_STAGE(PG8_SA(0, 0), cA, voffA); PG8_STAGE(PG8_SA(0, 1), cA + hstep, voffA);
        if (wr == 1) PG8_BAR;
        PG8_WAIT_V(2); PG8_BAR;
        PG8_STAGE(PG8_SB(1, 0), cB + kstep, voffB); PG8_STAGE(PG8_SA(1, 0), cA + kstep, voffA); PG8_STAGE(PG8_SB(1, 1), cB + hstep + kstep, voffB);
        PG8_WAIT_V(6); PG8_BAR;
    } else {
        PG8_STAGE(PG8_SB(0, 0), cB, voffB); PG8_STAGE(PG8_SA(0, 0), cA, voffA); PG8_STAGE(PG8_SB(0, 1), cB + hstep, voffB); PG8_STAGE(PG8_SA(0, 1), cA + hstep, voffA);
        if (wr == 1) PG8_BAR;
        PG8_WAIT_V(4); PG8_BAR;
        PG8_STAGE(PG8_SB(1, 0), cB + kstep, voffB); PG8_STAGE(PG8_SA(1, 0), cA + kstep, voffA); PG8_STAGE(PG8_SB(1, 1), cB + hstep + kstep, voffB);
        PG8_WAIT_V(6); PG8_BAR;
    }
    for (;;) {
        const bool has_next = S.next(ui + 1, nxt);
        const char* nA = has_next ? (const char*)g.A + (size_t)nxt.pm * tstep : cA; const char* nB = has_next ? (const char*)g.Bt + (size_t)nxt.pn * tstep : cB;
        for (int t = 0; t < nt; t += 2) {
            const bool last = (t == nt - 2);
            const char* a1 = cA + (size_t)(t + 1) * kstep;
            const char* a2 = last ? nA : cA + (size_t)(t + 2) * kstep; const char* b2 = last ? nB : cB + (size_t)(t + 2) * kstep;
            const char* a3 = a2 + kstep; const char* b3 = b2 + kstep;
            if (last && has_next) S.a_ready(nxt);
            if constexpr (SP2) {
            PG8_LDB(B0, 0, 0); PG8_LDB(B1, 0, 1); PG8_SCHED; PG8_LDA(At, 0, 0); PG8_STAGE(PG8_SA(1, 1), a1 + hstep, voffA);
            PG8_WAIT_V(8); PG8_WAIT_L(0); PG8_BAR; PG8_MMA(0, 0, At, B0); PG8_MMA(0, 1, At, B1); PG8_BAR; PG8_SCHED;
            PG8_LDA(At, 0, 1); PG8_STAGE(PG8_SB(0, 0), b2, voffB); PG8_STAGE(PG8_SB(0, 1), b2 + hstep, voffB); PG8_STAGE(PG8_SA(0, 0), a2, voffA);
            PG8_WAIT_V(8); PG8_WAIT_L(0); PG8_BAR; PG8_MMA(1, 0, At, B0); PG8_MMA(1, 1, At, B1); PG8_BAR; PG8_SCHED;
            PG8_LDB(B0, 1, 0); PG8_LDB(B1, 1, 1); PG8_SCHED; PG8_LDA(At, 1, 0); PG8_STAGE(PG8_SA(0, 1), a2 + hstep, voffA);
            PG8_WAIT_V(8); PG8_WAIT_L(0); PG8_BAR; PG8_MMA(0, 0, At, B0); PG8_MMA(0, 1, At, B1); PG8_BAR; PG8_SCHED;
            PG8_LDA(At, 1, 1); PG8_STAGE(PG8_SB(1, 0), b3, voffB); PG8_STAGE(PG8_SB(1, 1), b3 + hstep, voffB); PG8_STAGE(PG8_SA(1, 0), a3, voffA);
            PG8_WAIT_V(8); PG8_WAIT_L(0); PG8_BAR; PG8_MMA(1, 0, At, B0); PG8_MMA(1, 1, At, B1); PG8_BAR; PG8_SCHED;
            } else {
            PG8_LDB(B0, 0, 0); PG8_SCHED; PG8_LDA(At, 0, 0); PG8_STAGE(PG8_SA(1, 1), a1 + hstep, voffA);
            PG8_WAIT_L(8); PG8_BAR; PG8_WAIT_L(0); PG8_MMA(0, 0, At, B0); PG8_BAR; PG8_SCHED;
            PG8_LDB(B1, 0, 1); PG8_STAGE(PG8_SB(0, 0), b2, voffB);
            PG8_BAR; PG8_WAIT_L(0); PG8_MMA(0, 1, At, B1); PG8_BAR;
            PG8_LDA(At, 0, 1); PG8_STAGE(PG8_SA(0, 0), a2, voffA);
            PG8_BAR; PG8_WAIT_L(0); PG8_MMA(1, 0, At, B0); PG8_BAR; PG8_SCHED;
            PG8_STAGE(PG8_SB(0, 1), b2 + hstep, voffB);
            PG8_WAIT_V(6); PG8_BAR; PG8_MMA(1, 1, At, B1); PG8_BAR;
            PG8_LDB(B0, 1, 0); PG8_SCHED; PG8_LDA(At, 1, 0); PG8_STAGE(PG8_SA(0, 1), a2 + hstep, voffA);
            PG8_WAIT_L(8); PG8_BAR; PG8_WAIT_L(0); PG8_MMA(0, 0, At, B0); PG8_BAR; PG8_SCHED;
            PG8_LDB(B1, 1, 1); PG8_STAGE(PG8_SB(1, 0), b3, voffB);
            PG8_BAR; PG8_WAIT_L(0); PG8_MMA(0, 1, At, B1); PG8_BAR;
            PG8_LDA(At, 1, 1); PG8_STAGE(PG8_SA(1, 0), a3, voffA);
            PG8_BAR; PG8_WAIT_L(0); PG8_MMA(1, 0, At, B0); PG8_BAR; PG8_SCHED;
            PG8_STAGE(PG8_SB(1, 1), b3 + hstep, voffB);
            PG8_WAIT_V(6); PG8_BAR; PG8_MMA(1, 1, At, B1); PG8_BAR;
            }
        }
        if constexpr (ALIGN_EPI) { if (wr == 0) PG8_BAR; }
        if constexpr (!Epi::AFTER_DRAIN) { E(acc, cur, wr, wc, fr, fq); S.done(cur); }
        if (!has_next) break;
#pragma unroll
        for (int a = 0; a < 2; ++a)
#pragma unroll
            for (int b = 0; b < 2; ++b)
#pragma unroll
                for (int m = 0; m < 4; ++m)
#pragma unroll
                    for (int n = 0; n < 2; ++n) acc[a][b][m][n] = (f32x4){0.f, 0.f, 0.f, 0.f};
        cur = nxt; cA = nA; cB = nB; ++ui;
        if constexpr (ALIGN_EPI) { if (wr == 1) PG8_BAR; }
    }
    PG8_WAIT_V(0);
    if constexpr (!ALIGN_EPI) { if (wr == 0) PG8_BAR; }
    PG8_BAR;
    if constexpr (Epi::AFTER_DRAIN) { E.fused(acc, cur, wr, wc, fr, fq, lds, wid, lane); S.done(cur); }
#undef PG8_SA
#undef PG8_SB
#undef PG8_STAGE
#undef PG8_LDA
#undef PG8_LDB
#undef PG8_MMA
#undef PG8_WAIT_V
#undef PG8_WAIT_L
#undef PG8_BAR
#undef PG8_SCHED
}
}
namespace att {
using bf16 = __hip_bfloat16;
constexpr int   D = 128, NW = 8, QBLK = 32, KVBLK = 64;
constexpr float SCALE = 0.088388347648318440f;
constexpr float THR = 8.f;
constexpr int SDEPTH = 1;
constexpr int LDQ = 1024, LDK = 256, LDO = 2048;
constexpr size_t SHM_V = KVBLK * D * 2, SHM_K = KVBLK * D * 2, SHM_ATTN = 2 * SHM_V + 2 * SHM_K + NW * 64 * 4;
using bf16x8 = __attribute__((ext_vector_type(8))) short;
using s16x4  = __attribute__((ext_vector_type(4))) short;
using f32x16 = __attribute__((ext_vector_type(16))) float;
using f32x8  = __attribute__((ext_vector_type(8))) float;
using u32x4  = __attribute__((ext_vector_type(4))) unsigned;
#define KSWZ(row, colB) ((row) * 256 + ((colB) ^ (((row) & 7) << 4)))
#define SBAR() __builtin_amdgcn_sched_barrier(0)
__device__ __forceinline__ int crow(int r, int hi) { return (r & 3) + 8 * (r >> 2) + 4 * hi; }
__device__ __forceinline__ unsigned cvtpk(float lo, float hi) {
  unsigned r; asm volatile("v_cvt_pk_bf16_f32 %0, %1, %2" : "=v"(r) : "v"(lo), "v"(hi)); return r;
}
template <typename TIn> struct Stage;
template <> struct Stage<bf16>  { using T = bf16x8;
  __device__ static __forceinline__ T ld8(const bf16* p) { return *reinterpret_cast<const bf16x8*>(p); }
  __device__ static __forceinline__ bf16x8 tobf(T x) { return x; } };
template <> struct Stage<float> { using T = f32x8;
  __device__ static __forceinline__ T ld8(const float* p) { return *reinterpret_cast<const f32x8*>(p); }
  __device__ static __forceinline__ bf16x8 tobf(T x) {
    u32x4 w = {cvtpk(x[0], x[1]), cvtpk(x[2], x[3]), cvtpk(x[4], x[5]), cvtpk(x[6], x[7])}; return *reinterpret_cast<bf16x8*>(&w); } };

__device__ __forceinline__ void partialSM(f32x16& p0, f32x16& p1, float& m_reg, f32x16& negm, float& alpha) {
  constexpr float THRL = THR * 1.4426950408889634f;
  float pmax = p0[0]; for (int r = 1; r < 16; ++r) pmax = fmaxf(pmax, p0[r]); for (int r = 0; r < 16; ++r) pmax = fmaxf(pmax, p1[r]);
  { auto rr = __builtin_amdgcn_permlane32_swap(__float_as_uint(pmax), __float_as_uint(pmax), false, false);
    pmax = fmaxf(__uint_as_float(rr[0]), __uint_as_float(rr[1])); }
  if (__builtin_expect(__all(pmax <= THRL), 1)) { alpha = 1.f; }
  else { const float dl = fmaxf(pmax, 0.f); m_reg += dl; alpha = __builtin_amdgcn_exp2f(-dl);
    for (int r = 0; r < 16; ++r) { p0[r] -= dl; p1[r] -= dl; }
    for (int r = 0; r < 16; ++r) negm[r] = -m_reg; asm volatile("" : "+v"(negm)); }
  for (int r = 0; r < 16; ++r) p0[r] = __builtin_amdgcn_exp2f(p0[r]);
}
__device__ __forceinline__ void exp_half(f32x16& p0) { for (int r = 0; r < 16; ++r) p0[r] = __builtin_amdgcn_exp2f(p0[r]); }
__device__ __forceinline__ void finishSM(f32x16& p0, f32x16& p1, float alpha, float& l_reg, bf16x8& pa0, bf16x8& pa1, bf16x8& pa2, bf16x8& pa3) {
  for (int r = 0; r < 16; ++r) p1[r] = __builtin_amdgcn_exp2f(p1[r]);
  float ps = 0; for (int r = 0; r < 16; ++r) ps += p0[r]; for (int r = 0; r < 16; ++r) ps += p1[r];
  { auto rr = __builtin_amdgcn_permlane32_swap(__float_as_uint(ps), __float_as_uint(ps), false, false);
    ps = __uint_as_float(rr[0]) + __uint_as_float(rr[1]); }
  l_reg = l_reg * alpha + ps;
#define PK4(P, BASE, OUT) do { unsigned a0 = cvtpk(P[BASE + 0], P[BASE + 1]), a1 = cvtpk(P[BASE + 2], P[BASE + 3]);   \
    unsigned b0 = cvtpk(P[BASE + 4], P[BASE + 5]), b1 = cvtpk(P[BASE + 6], P[BASE + 7]);                              \
      \
    u32x4 w = {a0, a1, b0, b1}; OUT = *reinterpret_cast<bf16x8*>(&w); } while (0)
  PK4(p0, 0, pa0); PK4(p0, 8, pa1); PK4(p1, 0, pa2); PK4(p1, 8, pa3);
#undef PK4
}
__device__ __forceinline__ void qkt(f32x16& p0, f32x16& p1, const bf16* Ks, const bf16x8* qr, int r32, int hi, const f32x16& negm) {
  for (int d0 = 0; d0 < 8; ++d0) { int cb = (d0 * 16 + hi * 8) * 2;
    bf16x8 b0 = *reinterpret_cast<const bf16x8*>((const char*)Ks + KSWZ(r32, cb));
    bf16x8 b1 = *reinterpret_cast<const bf16x8*>((const char*)Ks + KSWZ(32 + r32, cb));
    if (d0 == 0) { p0 = __builtin_amdgcn_mfma_f32_32x32x16_bf16(b0, qr[0], negm, 0, 0, 0); p1 = __builtin_amdgcn_mfma_f32_32x32x16_bf16(b1, qr[0], negm, 0, 0, 0); }
    else { p0 = __builtin_amdgcn_mfma_f32_32x32x16_bf16(b0, qr[d0], p0, 0, 0, 0); p1 = __builtin_amdgcn_mfma_f32_32x32x16_bf16(b1, qr[d0], p1, 0, 0, 0); } }
}
__device__ __forceinline__ int v_st(int k, int c) { const int kk = k;   return ((kk >> 3) * 4 + (c >> 5)) * 512 + ((kk & 7) * 32 + (c & 31)) * 2; }
__device__ __forceinline__ int v_rd_base(int lane) { return ((lane & 3) << 3) | (((lane >> 2) & 3) << 6) | (((lane >> 4) & 1) << 5) | (((lane >> 5) & 1) << 8); }
constexpr int v_rd_off(int d0, int ks, int half) { return d0 * 512 + ks * 4096 + half * 2048; }
template <int OFF> __device__ __forceinline__ s16x4 tr_read(int vb) {
  s16x4 r; asm volatile("ds_read_b64_tr_b16 %0, %1 offset:%2" : "=&v"(r) : "v"(vb), "i"(OFF) : "memory"); return r;
}
template <int D0> __device__ __forceinline__ void pv_one(f32x16& od, int vb, bf16x8 pa0, bf16x8 pa1, bf16x8 pa2, bf16x8 pa3) {
  const s16x4 l0 = tr_read<v_rd_off(D0, 0, 0)>(vb), h0 = tr_read<v_rd_off(D0, 0, 1)>(vb), l1 = tr_read<v_rd_off(D0, 1, 0)>(vb), h1 = tr_read<v_rd_off(D0, 1, 1)>(vb);
  const s16x4 l2 = tr_read<v_rd_off(D0, 2, 0)>(vb), h2 = tr_read<v_rd_off(D0, 2, 1)>(vb), l3 = tr_read<v_rd_off(D0, 3, 0)>(vb), h3 = tr_read<v_rd_off(D0, 3, 1)>(vb);
  asm volatile("s_waitcnt lgkmcnt(0)" ::: "memory"); SBAR();
#define PK(L, H) (bf16x8){L[0], L[1], L[2], L[3], H[0], H[1], H[2], H[3]}
  od = __builtin_amdgcn_mfma_f32_32x32x16_bf16(pa0, PK(l0, h0), od, 0, 0, 0);
  od = __builtin_amdgcn_mfma_f32_32x32x16_bf16(pa1, PK(l1, h1), od, 0, 0, 0);
  od = __builtin_amdgcn_mfma_f32_32x32x16_bf16(pa2, PK(l2, h2), od, 0, 0, 0);
  od = __builtin_amdgcn_mfma_f32_32x32x16_bf16(pa3, PK(l3, h3), od, 0, 0, 0);
#undef PK
}
__device__ __forceinline__ void pv_d0(f32x16* o, int vb, bf16x8 pa0, bf16x8 pa1, bf16x8 pa2, bf16x8 pa3) {
  pv_one<0>(o[0], vb, pa0, pa1, pa2, pa3); pv_one<1>(o[1], vb, pa0, pa1, pa2, pa3); pv_one<2>(o[2], vb, pa0, pa1, pa2, pa3); pv_one<3>(o[3], vb, pa0, pa1, pa2, pa3);
}
template <typename TQ>
__device__ __forceinline__ void attn_dense_body(const TQ* Qb, const bf16* Kh, const bf16* Vh,
                                                bf16* Ob, int seq, char* lds, float negB, const float* wq, const float* rope, int tok0) {
  using St = Stage<bf16>; using SQ = Stage<TQ>;
  int tid_ = threadIdx.x; asm volatile("" : "+v"(tid_)); const int tid = tid_, wid = tid >> 6, lane = tid & 63, r32 = lane & 31, hi = lane >> 5;
  bf16* V_lds = (bf16*)lds; bf16* K_lds = (bf16*)(lds + 2 * SHM_V);
  float* ws = (float*)(lds + 2 * SHM_V + 2 * SHM_K) + wid * 64; float* li_l = ws; float* al_l = ws + 32;
  float l_reg = 0; f32x16 o[4] = {}; bf16x8 qr[8];
  f32x16 negm; for (int r = 0; r < 16; ++r) negm[r] = negB; asm volatile("" : "+v"(negm));
  { const TQ* Qw = Qb + (long)(wid * QBLK + r32) * LDQ + hi * 8;
    f32x8 xr[8]; float ss = 0.f;
#pragma unroll
    for (int d0 = 0; d0 < 8; ++d0) { xr[d0] = *reinterpret_cast<const f32x8*>(Qw + d0 * 16);
#pragma unroll
      for (int e = 0; e < 8; ++e) ss += xr[d0][e] * xr[d0][e]; }
    { auto rr = __builtin_amdgcn_permlane32_swap(__float_as_uint(ss), __float_as_uint(ss), false, false); ss = __uint_as_float(rr[0]) + __uint_as_float(rr[1]); }
    const float rs = rsqrtf(ss * (1.f / 128.f) + 1e-6f) * 0.12751743f;
#pragma unroll
    for (int d0 = 0; d0 < 8; ++d0) { const f32x8 wv = *reinterpret_cast<const f32x8*>(wq + d0 * 16 + hi * 8);
#pragma unroll
      for (int e = 0; e < 8; ++e) xr[d0][e] = xr[d0][e] * rs * wv[e]; }
    if (tok0 >= 0) { const int tok = tok0 + wid * QBLK + r32;
#pragma unroll
      for (int h2 = 0; h2 < 2; ++h2) { const int pos = h2 == 0 ? (tok >> 6) : (tok & 63);
#pragma unroll
        for (int dd = 0; dd < 2; ++dd) { const float* rp = rope + ((size_t)pos * 32 + dd * 16 + hi * 8) * 2;
#pragma unroll
          for (int e = 0; e < 8; ++e) { const float c = rp[2 * e], s = rp[2 * e + 1]; const float a = xr[4 * h2 + dd][e], bq = xr[4 * h2 + dd + 2][e];
            xr[4 * h2 + dd][e] = a * c - bq * s; xr[4 * h2 + dd + 2][e] = bq * c + a * s; } } } }
#pragma unroll
    for (int d0 = 0; d0 < 8; ++d0) qr[d0] = Stage<float>::tobf(xr[d0]); }
  const int sr = tid >> 4, sc = (tid & 15) * 8, vst0 = v_st(sr, sc), vst1 = v_st(32 + sr, sc);
  const int vb0 = (int)(uintptr_t)V_lds + v_rd_base(lane);
  struct { typename St::T vs0, vs1, ks0, ks1; } sr_[SDEPTH];
#define SLOAD(i, k0) do { sr_[i].vs0 = St::ld8(&Vh[(long)((k0) + sr) * LDK + sc]); sr_[i].vs1 = St::ld8(&Vh[(long)((k0) + 32 + sr) * LDK + sc]); \
    sr_[i].ks0 = St::ld8(&Kh[(long)((k0) + sr) * LDK + sc]); sr_[i].ks1 = St::ld8(&Kh[(long)((k0) + 32 + sr) * LDK + sc]); } while (0)
#define SWRITE(b, i) do { *(bf16x8*)((char*)V_lds + (b) * SHM_V + vst0) = St::tobf(sr_[i].vs0);          \
    *(bf16x8*)((char*)V_lds + (b) * SHM_V + vst1) = St::tobf(sr_[i].vs1); int kc = sc * 2;               \
    *(bf16x8*)((char*)K_lds + (b) * SHM_K + KSWZ(sr, kc)) = St::tobf(sr_[i].ks0);                       \
    *(bf16x8*)((char*)K_lds + (b) * SHM_K + KSWZ(32 + sr, kc)) = St::tobf(sr_[i].ks1); } while (0)
#define SWAIT() do { if constexpr (SDEPTH == 2) asm volatile("s_waitcnt vmcnt(4)" ::: "memory"); else asm volatile("s_waitcnt vmcnt(0)" ::: "memory"); } while (0)
#define RESC(a) do { if (__any((a) < 1.f)) { if (hi == 0) al_l[r32] = (a); asm volatile("s_waitcnt lgkmcnt(0)" ::: "memory"); \
    for (int d = 0; d < 4; ++d) for (int r = 0; r < 16; ++r) o[d][r] *= al_l[crow(r, hi)]; } } while (0)
  f32x16 pA0, pA1, pB0, pB1; bf16x8 pa0, pa1, pa2, pa3; const int NT = seq / KVBLK;
  constexpr int SE = 0, SO = SDEPTH - 1;
  SLOAD(SE, 0); asm volatile("s_waitcnt vmcnt(0)" ::: "memory"); SWRITE(0, SE); __syncthreads();
  qkt(pA0, pA1, K_lds, qr, r32, hi, negm); exp_half(pA0);
  SLOAD(SO, KVBLK); if constexpr (SDEPTH == 2) { if (2 < NT) SLOAD(SE, 2 * KVBLK); }
  SWAIT(); SWRITE(1, SO); __syncthreads();
  for (int j = 1; j + 1 < NT; j += 2) {
    SBAR(); qkt(pB0, pB1, (bf16*)((char*)K_lds + SHM_K), qr, r32, hi, negm);
    finishSM(pA0, pA1, 1.f, l_reg, pa0, pa1, pa2, pa3); SBAR();
    SLOAD(SO, (j + SDEPTH) * KVBLK); SBAR();
    pv_d0(o, vb0, pa0, pa1, pa2, pa3); exp_half(pB0);
    __syncthreads(); SWAIT(); SWRITE(0, SE);
    __syncthreads();
    SBAR(); qkt(pA0, pA1, K_lds, qr, r32, hi, negm);
    finishSM(pB0, pB1, 1.f, l_reg, pa0, pa1, pa2, pa3); SBAR();
    if (SDEPTH == 1 || j + 3 < NT) SLOAD(SE, (j + 1 + SDEPTH) * KVBLK); SBAR();
    pv_d0(o, vb0 + (int)SHM_V, pa0, pa1, pa2, pa3); exp_half(pA0);
    __syncthreads(); SWAIT(); SWRITE(1, SO);
    __syncthreads();
  }
  SBAR(); qkt(pB0, pB1, (bf16*)((char*)K_lds + SHM_K), qr, r32, hi, negm);
  finishSM(pA0, pA1, 1.f, l_reg, pa0, pa1, pa2, pa3); SBAR();
  pv_d0(o, vb0, pa0, pa1, pa2, pa3); exp_half(pB0);
  __syncthreads();
  finishSM(pB0, pB1, 1.f, l_reg, pa0, pa1, pa2, pa3); SBAR();
  pv_d0(o, vb0 + (int)SHM_V, pa0, pa1, pa2, pa3);
  if (hi == 0) li_l[r32] = l_reg; asm volatile("s_waitcnt lgkmcnt(0)" ::: "memory");
  float rli[16];
#pragma unroll
  for (int r = 0; r < 16; ++r) rli[r] = __builtin_amdgcn_rcpf(li_l[crow(r, hi)]);
  bf16* Ow = Ob + (long)(wid * QBLK) * LDO;
#pragma unroll
  for (int r = 0; r < 16; ++r) { int orow = crow(r, hi);
    for (int d0 = 0; d0 < 4; ++d0) Ow[(long)orow * LDO + d0 * 32 + r32] = __float2bfloat16(o[d0][r] * rli[r]); }
#undef SLOAD
#undef SWRITE
#undef SWAIT
#undef RESC
}
}

#define LAS __attribute__((address_space(3)))
typedef unsigned short bf16_t;
typedef float f32x4 __attribute__((ext_vector_type(4)));
typedef float f32x2 __attribute__((ext_vector_type(2)));
typedef unsigned u32x4 __attribute__((ext_vector_type(4)));
typedef unsigned u32x2 __attribute__((ext_vector_type(2)));
typedef short bf16x8 __attribute__((ext_vector_type(8)));

constexpr int L = 16384, NCTX = 256, MT = L + NCTX, DM = 2048, INW = 2560, FF = 5632, NCH = 260;
constexpr float EPS = 1e-6f;

constexpr size_t al256(size_t x) { return (x + 255) / 256 * 256; }
constexpr size_t SZ_WIN = (size_t)INW * DM * 2, SZ_WOUT = (size_t)DM * DM * 2, SZ_WGU = (size_t)2 * FF * DM * 2, SZ_WDN = (size_t)DM * FF * 2,
                 SZ_WGLU = 512 * 512 * 2, SZ_WF = 512 * 1024 * 2;
constexpr size_t O_WIN = 0;
constexpr size_t O_WOUT = O_WIN + 2 * SZ_WIN;
constexpr size_t O_WGU = O_WOUT + 2 * SZ_WOUT;
constexpr size_t O_WDN = O_WGU + 2 * SZ_WGU;
constexpr size_t O_WGLU = O_WDN + 2 * SZ_WDN;
constexpr size_t O_WF = O_WGLU + 2 * SZ_WGLU;
constexpr size_t O_MODP = O_WF + 2 * SZ_WF;
constexpr size_t O_MOD = O_MODP + (size_t)16 * 4 * 12288 * 4;
constexpr size_t O_ROPE = O_MOD + (size_t)4 * 12288 * 4;
constexpr size_t O_AB = O_ROPE + 65536;
constexpr size_t O_BB = O_AB + 8192 * 16;
constexpr size_t O_CB = O_BB + (size_t)8192 * 16 * 8;
constexpr size_t O_W1 = O_CB + (size_t)128 * 16 * 128 * 2;
constexpr size_t O_W2 = O_W1 + 65536;
constexpr size_t O_WC = O_W2 + 131072;
constexpr size_t O_TW = O_WC + 262144;
constexpr size_t O_XC = O_TW + 131072;
constexpr size_t SZ_S = (size_t)2 * NCH * 32 * 128 * 4;
constexpr size_t O_S = O_XC + (size_t)NCTX * DM * 4;
constexpr size_t O_HIN = O_S + SZ_S;
constexpr size_t O_BBT = al256(O_HIN + SZ_S);
constexpr size_t O_BAR = O_BBT + (size_t)128 * 128 * 16 * 2;
constexpr size_t O_H = O_BAR + 16384;
constexpr size_t O_Y = O_H + (size_t)MT * DM * 2;
constexpr size_t O_YP = O_Y + (size_t)72 * 1024 * 1024;
constexpr size_t O_OV = O_Y + (size_t)MT * DM * 4;
static_assert((size_t)MT * DM * 2 <= (size_t)72 * 1024 * 1024 && O_YP + (size_t)4 * 256 * DM * 4 <= O_OV, "YP inside the Y region");
constexpr size_t O_QRAW = O_OV;
constexpr size_t O_KRAW = O_QRAW + (size_t)MT * 1024 * 4;
constexpr size_t O_QB = O_KRAW + (size_t)MT * 256 * 4;
constexpr size_t O_KB = O_QB + (size_t)MT * 1024 * 2;
constexpr size_t O_VB = O_KB + (size_t)MT * 256 * 2;
constexpr size_t O_US = O_VB + (size_t)MT * 256 * 2;
constexpr size_t O_UF = O_US + (size_t)MT * 512 * 4;
constexpr size_t O_TB = O_UF + (size_t)MT * 512 * 2;
constexpr size_t O_XF = O_TB + (size_t)2 * 128 * 128 * 512 * 2;
constexpr size_t O_G = O_XF + (size_t)MT * 1024 * 2;
constexpr size_t O_CAT = O_G + (size_t)MT * 512 * 2;
constexpr size_t O_OVEND = O_CAT + (size_t)MT * DM * 2;
constexpr size_t O_HID = O_OV;
constexpr size_t WS_END = (O_OVEND > O_HID + (size_t)MT * FF * 2) ? O_OVEND : O_HID + (size_t)MT * FF * 2;
static_assert(WS_END <= (size_t)768 * 1024 * 1024, "d_ws map exceeds 768 MiB");

constexpr int LDS_BYTES = 147456;

struct Params { const float* in[28]; float* out; unsigned char* ws; };

__device__ __forceinline__ unsigned pk2(float lo, float hi) { typedef __bf16 bf2_t __attribute__((ext_vector_type(2))); f32x2 v = {lo, hi}; bf2_t b = __builtin_convertvector(v, bf2_t); return __builtin_bit_cast(unsigned, b); }
__device__ __forceinline__ bf16_t f2bf(float f) { return (bf16_t)(pk2(f, 0.f) & 0xffffu); }
__device__ __forceinline__ float bf2f(unsigned b) { return __uint_as_float(b << 16); }
__device__ __forceinline__ float wave_sum(float v) {
#pragma unroll
    for (int o = 1; o < 64; o <<= 1) v += __shfl_xor(v, o);
    return v;
}
__device__ __forceinline__ float sigmoidf_(float x) { return __builtin_amdgcn_rcpf(1.0f + __expf(-x)); }
__device__ __forceinline__ float gelu_tanh(float x) { const float u = 0.7978845608028654f * (x + 0.044715f * x * x * x); return x * sigmoidf_(2.f * u); }
#define LDS_WAIT() asm volatile("s_waitcnt lgkmcnt(0)" ::: "memory")

struct EpiIn {
    static constexpr bool PERM = true, AFTER_DRAIN = false;
    float* qraw; float* kraw; bf16_t* vb; bf16_t* us; bf16_t* uf;
    __device__ __forceinline__ void operator()(const pg8::f32x4 (&acc)[2][2][4][2], const pg8::Unit& u, int wr, int wc, int fr, int fq) const {
        const int row0 = u.pm * 256 + wr * 64 + fr, cl = wc * 32 + 8 * fq, pn = u.pn;
        float* fbase = nullptr; bf16_t* bbase = nullptr; int ldc = 0;
        if (pn < 4) { fbase = qraw + pn * 256; ldc = 1024; } else if (pn == 4) { fbase = kraw; ldc = 256; } else if (pn == 5) { bbase = vb; ldc = 256; }
        else if (pn < 8) { bbase = us + (pn - 6) * 256; ldc = 512; } else { bbase = uf + (pn - 8) * 256; ldc = 512; }
#pragma unroll
        for (int ai = 0; ai < 2; ++ai)
#pragma unroll
            for (int m = 0; m < 4; ++m) { const size_t ro = (size_t)(row0 + ai * 128 + m * 16) * ldc + cl;
#pragma unroll
                for (int bj = 0; bj < 2; ++bj) { const pg8::f32x4 v0 = acc[ai][bj][m][0], v1 = acc[ai][bj][m][1];
                    if (fbase) { float* p = fbase + ro + bj * 128; *(f32x4*)p = (f32x4){v0[0], v0[1], v0[2], v0[3]}; *(f32x4*)(p + 4) = (f32x4){v1[0], v1[1], v1[2], v1[3]}; }
                    else { u32x4 w; w.x = pk2(v0[0], v0[1]); w.y = pk2(v0[2], v0[3]); w.z = pk2(v1[0], v1[1]); w.w = pk2(v1[2], v1[3]); *(u32x4*)(bbase + ro + bj * 128) = w; } } }
    }
};
struct EpiF32 {
    static constexpr bool PERM = true, AFTER_DRAIN = false;
    bf16_t* O; int ldc;
    __device__ __forceinline__ void operator()(const pg8::f32x4 (&acc)[2][2][4][2], const pg8::Unit& u, int wr, int wc, int fr, int fq) const {
        const int row0 = u.pm * 256 + wr * 64 + fr, col0 = u.pn * 256 + wc * 32 + 8 * fq;
#pragma unroll
        for (int ai = 0; ai < 2; ++ai)
#pragma unroll
            for (int m = 0; m < 4; ++m) { bf16_t* rowp = O + (size_t)(row0 + ai * 128 + m * 16) * ldc + col0;
#pragma unroll
                for (int bj = 0; bj < 2; ++bj) { const pg8::f32x4 v0 = acc[ai][bj][m][0], v1 = acc[ai][bj][m][1];
                    u32x4 w; w.x = pk2(v0[0], v0[1]); w.y = pk2(v0[2], v0[3]); w.z = pk2(v1[0], v1[1]); w.w = pk2(v1[2], v1[3]); *(u32x4*)(rowp + bj * 128) = w; } }
    }
};
struct EpiP32 {
    static constexpr bool PERM = true, AFTER_DRAIN = false;
    float* O; int ldc;
    __device__ __forceinline__ void operator()(const pg8::f32x4 (&acc)[2][2][4][2], const pg8::Unit& u, int wr, int wc, int fr, int fq) const {
        const int row0 = u.pm * 256 + wr * 64 + fr, col0 = u.pn * 256 + wc * 32 + 8 * fq;
#pragma unroll
        for (int ai = 0; ai < 2; ++ai)
#pragma unroll
            for (int m = 0; m < 4; ++m) { float* rowp = O + (size_t)(row0 + ai * 128 + m * 16) * ldc + col0;
#pragma unroll
                for (int bj = 0; bj < 2; ++bj) { const pg8::f32x4 v0 = acc[ai][bj][m][0], v1 = acc[ai][bj][m][1];
                    *(f32x4*)(rowp + bj * 128) = (f32x4){v0[0], v0[1], v0[2], v0[3]}; *(f32x4*)(rowp + bj * 128 + 4) = (f32x4){v1[0], v1[1], v1[2], v1[3]}; } }
    }
};
struct EpiUp {
    static constexpr bool PERM = true, AFTER_DRAIN = false;
    bf16_t* hid;
    __device__ __forceinline__ void operator()(const pg8::f32x4 (&acc)[2][2][4][2], const pg8::Unit& u, int wr, int wc, int fr, int fq) const {
        const int row0 = u.pm * 256 + wr * 64 + fr, col0 = u.pn * 128 + wc * 32 + 8 * fq;
#pragma unroll
        for (int ai = 0; ai < 2; ++ai)
#pragma unroll
            for (int m = 0; m < 4; ++m) { bf16_t* rowp = hid + (size_t)(row0 + ai * 128 + m * 16) * FF + col0;
                float o[8];
#pragma unroll
                for (int n = 0; n < 2; ++n)
#pragma unroll
                    for (int e = 0; e < 4; ++e) { const float g = acc[ai][0][m][n][e], up = acc[ai][1][m][n][e]; o[4 * n + e] = g * sigmoidf_(g) * up; }
                u32x4 w; w.x = pk2(o[0], o[1]); w.y = pk2(o[2], o[3]); w.z = pk2(o[4], o[5]); w.w = pk2(o[6], o[7]); *(u32x4*)rowp = w; }
    }
};
struct EpiMix {
    static constexpr bool PERM = true, AFTER_DRAIN = false;
    bf16_t* cat; const bf16_t* gbuf; const float* bias; int mode;
    __device__ __forceinline__ void operator()(const pg8::f32x4 (&acc)[2][2][4][2], const pg8::Unit& u, int wr, int wc, int fr, int fq) const {
        const int row0 = u.pm * 256 + wr * 64 + fr, col0 = u.pn * 256 + wc * 32 + 8 * fq;
#pragma unroll
        for (int ai = 0; ai < 2; ++ai)
#pragma unroll
            for (int m = 0; m < 4; ++m) { const size_t row = (size_t)(row0 + ai * 128 + m * 16);
#pragma unroll
                for (int bj = 0; bj < 2; ++bj) { const int col = col0 + bj * 128; float o[8];
#pragma unroll
                    for (int n = 0; n < 2; ++n)
#pragma unroll
                        for (int e = 0; e < 4; ++e) o[4 * n + e] = acc[ai][bj][m][n][e];
                    if (mode == 0) { const u32x4 gv = *(const u32x4*)(gbuf + row * 512 + col); const f32x4 b0 = *(const f32x4*)(bias + col), b1 = *(const f32x4*)(bias + col + 4);
                        const unsigned gw_[4] = {gv.x, gv.y, gv.z, gv.w};
#pragma unroll
                        for (int q = 0; q < 4; ++q) { const float g0 = bf2f(gw_[q] & 0xffffu), g1 = bf2f(gw_[q] >> 16);
                            const float z0 = o[2 * q] + (q < 2 ? b0[2 * q] : b1[2 * q - 4]), z1 = o[2 * q + 1] + (q < 2 ? b0[2 * q + 1] : b1[2 * q - 3]);
                            o[2 * q] = g0 * sigmoidf_(z0); o[2 * q + 1] = g1 * sigmoidf_(z1); } }
                    u32x4 w; w.x = pk2(o[0], o[1]); w.y = pk2(o[2], o[3]); w.z = pk2(o[4], o[5]); w.w = pk2(o[6], o[7]);
                    *(u32x4*)(cat + row * 2048 + (mode == 0 ? 1024 : 1536) + col) = w; } }
    }
};

__device__ __forceinline__ void tr_item(const float* W, int K, int N, bf16_t* WT, int mode, LAS float* scr, int item, int lane) {
    const int nblk = N / 64, kb = item / nblk, nb = item - kb * nblk, k0 = 64 * kb, n0 = 64 * nb;
    const int drow0 = (mode == 0) ? n0 : ((n0 >> 7) * 256 + (mode == 2 ? 128 : 0) + (n0 & 127));
    const int c4 = lane & 15, kr = lane >> 4;
    f32x4 v[16];
#pragma unroll
    for (int i = 0; i < 16; ++i) v[i] = *(const f32x4*)(W + (size_t)(k0 + 4 * i + kr) * N + n0 + 4 * c4);
#pragma unroll
    for (int i = 0; i < 16; ++i) { LAS float* d = scr + (4 * i + kr) * 65 + 4 * c4; d[0] = v[i].x; d[1] = v[i].y; d[2] = v[i].z; d[3] = v[i].w; }
    LDS_WAIT(); asm volatile("" ::: "memory");
    const int c = lane & 7;
#pragma unroll
    for (int j = 0; j < 8; ++j) { const int n = (lane >> 3) + 8 * j; const LAS float* sp = scr + (8 * c) * 65 + n;
        u32x4 o; o.x = pk2(sp[0 * 65], sp[1 * 65]); o.y = pk2(sp[2 * 65], sp[3 * 65]); o.z = pk2(sp[4 * 65], sp[5 * 65]); o.w = pk2(sp[6 * 65], sp[7 * 65]);
        *(u32x4*)(WT + (size_t)(drow0 + n) * K + k0 + 8 * c) = o; }
    LDS_WAIT(); asm volatile("" ::: "memory");
}

__device__ __forceinline__ void prenorm_rows(const float* xl, const float* xc, bf16_t* H, const float* g, const float* modl, const float* modc, int sh_off, int sc_off,
                                             int nrows, int gw, int NGW, int lane) {
    f32x4 v[8], vn[8];
    if (gw < nrows) { const float* src = gw < L ? xl + (size_t)gw * DM : xc + (size_t)(gw - L) * DM;
#pragma unroll
        for (int j = 0; j < 8; ++j) v[j] = *(const f32x4*)(src + 4 * lane + 256 * j); }
    for (int row = gw; row < nrows; row += NGW) {
        const int nrow = row + NGW;
        if (nrow < nrows) { const float* src = nrow < L ? xl + (size_t)nrow * DM : xc + (size_t)(nrow - L) * DM;
#pragma unroll
            for (int j = 0; j < 8; ++j) vn[j] = *(const f32x4*)(src + 4 * lane + 256 * j); }
        const float* md = row < L ? modl : modc;
        float ss = 0.f;
#pragma unroll
        for (int j = 0; j < 8; ++j) ss += (v[j].x * v[j].x + v[j].y * v[j].y) + (v[j].z * v[j].z + v[j].w * v[j].w);
        const float rstd = rsqrtf(wave_sum(ss) * (1.f / DM) + EPS);
#pragma unroll
        for (int j = 0; j < 8; ++j) { const int col = 4 * lane + 256 * j;
            const f32x4 g4 = *(const f32x4*)(g + col), s4 = *(const f32x4*)(md + sc_off + col), h4 = *(const f32x4*)(md + sh_off + col);
            const f32x4 o = v[j] * rstd * g4 * (1.f + s4) + h4;
            u32x2 w; w.x = pk2(o.x, o.y); w.y = pk2(o.z, o.w); *(u32x2*)(H + (size_t)row * DM + col) = w; }
#pragma unroll
        for (int j = 0; j < 8; ++j) v[j] = vn[j];
    }
}
template <bool PL> __device__ __forceinline__ void post_rows(const float* xl_src, const float* xc_src, float* xl_dst, float* xc_dst, const bf16_t* Y, const float* wpost, const float* modl, const float* modc, int gate_off,
                                          bool do_next, bf16_t* H, const float* wpre, const float* nmodl, const float* nmodc, int sh_off, int sc_off,
                                          int row0, int nrows, int gw, int NGW, int lane, LAS float* pl, int tid, const float* yp4 = nullptr) {
    if (PL) { const int c = 4 * tid;
        *(LAS f32x4*)(pl + c) = *(const f32x4*)(wpost + c); *(LAS f32x4*)(pl + 2048 + c) = *(const f32x4*)(modl + gate_off + c);
        if (do_next) { *(LAS f32x4*)(pl + 4096 + c) = *(const f32x4*)(wpre + c); *(LAS f32x4*)(pl + 6144 + c) = *(const f32x4*)(nmodl + sc_off + c); *(LAS f32x4*)(pl + 8192 + c) = *(const f32x4*)(nmodl + sh_off + c); }
        __syncthreads(); }
    f32x4 x[8], y[8], xn[8], yn[8];
    gw += row0;
    if (gw < nrows) { const float* src = gw < L ? xl_src + (size_t)gw * DM : xc_src + (size_t)(gw - L) * DM; const bf16_t* yr = Y + (size_t)gw * DM;
#pragma unroll
        for (int j = 0; j < 8; ++j) { { if (yp4) { const float* yq = yp4 + (size_t)(gw - L) * DM + 4 * lane + 256 * j; y[j] = (*(const f32x4*)yq + *(const f32x4*)(yq + 256 * DM)) + (*(const f32x4*)(yq + 2 * 256 * DM) + *(const f32x4*)(yq + 3 * 256 * DM)); }
              else { const u32x2 yw = *(const u32x2*)(yr + 4 * lane + 256 * j); y[j] = (f32x4){bf2f(yw.x & 0xffffu), bf2f(yw.x >> 16), bf2f(yw.y & 0xffffu), bf2f(yw.y >> 16)}; } } x[j] = *(const f32x4*)(src + 4 * lane + 256 * j); } }
    for (int row = gw; row < nrows; row += NGW) {
        const bool lat = row < L;
        const int nrow = row + NGW;
        if (nrow < nrows) { const float* src = nrow < L ? xl_src + (size_t)nrow * DM : xc_src + (size_t)(nrow - L) * DM; const bf16_t* yr = Y + (size_t)nrow * DM;
#pragma unroll
            for (int j = 0; j < 8; ++j) { { if (yp4) { const float* yq = yp4 + (size_t)(nrow - L) * DM + 4 * lane + 256 * j; yn[j] = (*(const f32x4*)yq + *(const f32x4*)(yq + 256 * DM)) + (*(const f32x4*)(yq + 2 * 256 * DM) + *(const f32x4*)(yq + 3 * 256 * DM)); }
                  else { const u32x2 yw = *(const u32x2*)(yr + 4 * lane + 256 * j); yn[j] = (f32x4){bf2f(yw.x & 0xffffu), bf2f(yw.x >> 16), bf2f(yw.y & 0xffffu), bf2f(yw.y >> 16)}; } } xn[j] = *(const f32x4*)(src + 4 * lane + 256 * j); } }
        float* dst = lat ? xl_dst + (size_t)row * DM : xc_dst + (size_t)(row - L) * DM;
        const float* md = lat ? modl : modc;
        float ss = 0.f;
#pragma unroll
        for (int j = 0; j < 8; ++j) ss += (y[j].x * y[j].x + y[j].y * y[j].y) + (y[j].z * y[j].z + y[j].w * y[j].w);
        const float rstd = rsqrtf(wave_sum(ss) * (1.f / DM) + EPS);
        float s2 = 0.f;
#pragma unroll
        for (int j = 0; j < 8; ++j) { const int col = 4 * lane + 256 * j;
            const f32x4 w4 = PL ? *(const LAS f32x4*)(pl + col) : *(const f32x4*)(wpost + col), g4 = PL ? *(const LAS f32x4*)(pl + 2048 + col) : *(const f32x4*)(md + gate_off + col);
            x[j] = x[j] + g4 * (y[j] * rstd * w4);
            *(f32x4*)(dst + col) = x[j];
            s2 += (x[j].x * x[j].x + x[j].y * x[j].y) + (x[j].z * x[j].z + x[j].w * x[j].w); }
        if (do_next) {
            const float* nmd = lat ? nmodl : nmodc;
            const float rstd2 = rsqrtf(wave_sum(s2) * (1.f / DM) + EPS);
#pragma unroll
            for (int j = 0; j < 8; ++j) { const int col = 4 * lane + 256 * j;
                const f32x4 g4 = PL ? *(const LAS f32x4*)(pl + 4096 + col) : *(const f32x4*)(wpre + col), s4 = PL ? *(const LAS f32x4*)(pl + 6144 + col) : *(const f32x4*)(nmd + sc_off + col),
                            h4 = PL ? *(const LAS f32x4*)(pl + 8192 + col) : *(const f32x4*)(nmd + sh_off + col);
                const f32x4 o = x[j] * rstd2 * g4 * (1.f + s4) + h4;
                u32x2 w; w.x = pk2(o.x, o.y); w.y = pk2(o.z, o.w); *(u32x2*)(H + (size_t)row * DM + col) = w; }
        }
#pragma unroll
        for (int j = 0; j < 8; ++j) { x[j] = xn[j]; y[j] = yn[j]; }
    }
}

__device__ __forceinline__ void kq_post(const float* qraw, const float* kraw, bf16_t* qb, bf16_t* kb, const float* qn, const float* kn, const float* rope, int gw, int NGW, int lane) {
    const int j = lane & 31, hsel = lane >> 5;
    const f32x4 wq4 = *(const f32x4*)(qn + 4 * j), wk4 = *(const f32x4*)(kn + 4 * j);
    for (int it0 = gw; it0 < MT; it0 += 8 * NGW) {
        f32x4 v[8]; int rows[8], heads[8]; bool ok[8];
#pragma unroll
        for (int q = 0; q < 8; ++q) { const int it = it0 + q * NGW; ok[q] = it < MT; const int itc = ok[q] ? it : it0;
            const int row = itc, head = 8 + hsel; rows[q] = row; heads[q] = head;
            const float* src = head < 8 ? qraw + (size_t)row * 1024 + head * 128 + 4 * j : kraw + (size_t)row * 256 + (head - 8) * 128 + 4 * j;
            v[q] = *(const f32x4*)src; }
#pragma unroll
        for (int q = 0; q < 8; ++q) { const int row = rows[q], head = heads[q]; f32x4 x = v[q];
            float ss = (x.x * x.x + x.y * x.y) + (x.z * x.z + x.w * x.w);
#pragma unroll
            for (int o = 1; o < 32; o <<= 1) ss += __shfl_xor(ss, o);
            const float rstd = rsqrtf(ss * (1.f / 128.f) + EPS);
            x = x * rstd * wk4;
            f32x4 pt; pt.x = __shfl_xor(x.x, 8); pt.y = __shfl_xor(x.y, 8); pt.z = __shfl_xor(x.z, 8); pt.w = __shfl_xor(x.w, 8);
            if (row < L) {
                const int pos = (j < 16) ? (row >> 6) : (row & 63), fi = (4 * j) & 31;
                const f32x4 t0 = *(const f32x4*)(rope + (pos * 32 + fi) * 2), t1 = *(const f32x4*)(rope + (pos * 32 + fi) * 2 + 4);
                const float sg = (j & 8) ? 1.f : -1.f;
                x.x = x.x * t0.x + sg * pt.x * t0.y; x.y = x.y * t0.z + sg * pt.y * t0.w; x.z = x.z * t1.x + sg * pt.z * t1.y; x.w = x.w * t1.z + sg * pt.w * t1.w;
            }
            bf16_t* dst = head < 8 ? qb + (size_t)row * 1024 + head * 128 + 4 * j : kb + (size_t)row * 256 + (head - 8) * 128 + 4 * j;
            u32x2 o; o.x = pk2(x.x, x.y); o.y = pk2(x.z, x.w); if (ok[q]) *(u32x2*)dst = o; }
    }
}

__device__ __forceinline__ void ssm_stage_u(const float* US, LAS float* us, int k, int g, int lane) {
    const float* src = US + (size_t)(64 * k + lane) * 512 + 16 * g;
#pragma unroll
    for (int q = 0; q < 4; ++q) *(LAS f32x4*)(us + lane * 16 + 4 * q) = *(const f32x4*)(src + 4 * q);
}
__device__ __forceinline__ void ssm_bu_tile(const LAS float* us, LAS float* bu, const bf16x8 (&bfr)[8], int t0, int lane) {
    const int fr = lane & 15, fq = lane >> 4;
    const LAS float* up = us + (2 * (fq & 1)) * 256 + (t0 + fr) * 4;
    const f32x4 ua = *(const LAS f32x4*)up, ub = *(const LAS f32x4*)(up + 256);
    u32x4 aw; aw.x = pk2(ua.x, ua.y); aw.y = pk2(ua.z, ua.w); aw.z = pk2(ub.x, ub.y); aw.w = pk2(ub.z, ub.w);
    if (fq >= 2) aw = (u32x4){0u, 0u, 0u, 0u};
    const bf16x8 af = __builtin_bit_cast(bf16x8, aw);
#pragma unroll
    for (int nt = 0; nt < 8; ++nt) {
        const pg8::f32x4 d = __builtin_amdgcn_mfma_f32_16x16x32_bf16(af, bfr[nt], (pg8::f32x4){0.f, 0.f, 0.f, 0.f}, 0, 0, 0);
#pragma unroll
        for (int e = 0; e < 4; ++e) bu[(4 * fq + e) * 132 + 16 * nt + fr] = d[e];
    }
}
__device__ __forceinline__ void ssm_load_bfr(const bf16_t* BBT, bf16x8 (&bfr)[8], int ldg, int lane) {
    const int fr = lane & 15, fq = lane >> 4;
#pragma unroll
    for (int nt = 0; nt < 8; ++nt) { u32x4 w = *(const u32x4*)(BBT + ((size_t)ldg * 128 + 16 * nt + fr) * 16 + 8 * (fq & 1)); if (fq >= 2) w = (u32x4){0u, 0u, 0u, 0u}; bfr[nt] = __builtin_bit_cast(bf16x8, w); }
}
template <int DIR, bool WR> __device__ __forceinline__ void ssm_rec16(float ar, float ai, f32x2& hh, const LAS float* bu, LAS unsigned* st, int lane) {
    f32x2 b[16];
#pragma unroll
    for (int tt = 0; tt < 16; ++tt) { const int t = DIR == 0 ? tt : 15 - tt; b[tt] = (f32x2){bu[t * 132 + lane], bu[t * 132 + 64 + lane]}; }
#pragma unroll
    for (int tt = 0; tt < 16; ++tt) { const int t = DIR == 0 ? tt : 15 - tt;
        const f32x2 hs_ = {-hh.y, hh.x}; hh = b[tt] + (hh * ar + hs_ * ai);
        if (WR) st[t * 68 + lane] = pk2(hh.x, hh.y); }
}
__device__ __forceinline__ void ssm_dma_u(const bf16_t* US, LAS float* us, int k, int g, int lane) {
    const bf16_t* src = US + (size_t)(64 * k + lane) * 512 + 16 * g;
#pragma unroll
    for (int q = 0; q < 2; ++q) __builtin_amdgcn_global_load_lds((const unsigned*)(src + 8 * q), (LAS unsigned*)((LAS unsigned char*)us + q * 1024), 16, 0, 0);
}
typedef float f32x16_t __attribute__((ext_vector_type(16)));
__device__ __forceinline__ void ssm_load_bf4(const bf16_t* BBT, bf16x8 (&bf4)[4], int ldg, int lane) {
    const int r32 = lane & 31, hi = lane >> 5;
#pragma unroll
    for (int n = 0; n < 4; ++n) bf4[n] = *(const bf16x8*)(BBT + ((size_t)ldg * 128 + 32 * n + r32) * 16 + 8 * hi);
}
#define SSM_SWAP32(a, b) { auto rr_ = __builtin_amdgcn_permlane32_swap(__float_as_uint(a), __float_as_uint(b), false, false); a = __uint_as_float(rr_[0]); b = __uint_as_float(rr_[1]); }
template <int DIR, bool WR> __device__ __forceinline__ void ssm_tile32(const LAS float* us, const bf16x8 (&bf4)[4], float ar, float ai, f32x2& hh, LAS unsigned* st, int t0, int lane) {
    const int r32 = lane & 31, hi = lane >> 5;
    const bf16x8 af = *(const LAS bf16x8*)((const LAS unsigned char*)us + hi * 1024 + (t0 + r32) * 16);
    const f32x16_t z = {0.f, 0.f, 0.f, 0.f, 0.f, 0.f, 0.f, 0.f, 0.f, 0.f, 0.f, 0.f, 0.f, 0.f, 0.f, 0.f};
    f32x16_t dre0 = __builtin_amdgcn_mfma_f32_32x32x16_bf16(af, bf4[0], z, 0, 0, 0), dre1 = __builtin_amdgcn_mfma_f32_32x32x16_bf16(af, bf4[1], z, 0, 0, 0);
    f32x16_t dim0 = __builtin_amdgcn_mfma_f32_32x32x16_bf16(af, bf4[2], z, 0, 0, 0), dim1 = __builtin_amdgcn_mfma_f32_32x32x16_bf16(af, bf4[3], z, 0, 0, 0);
#pragma unroll
    for (int r = 0; r < 16; ++r) { SSM_SWAP32(dre0[r], dre1[r]) SSM_SWAP32(dim0[r], dim1[r]) }
#pragma unroll
    for (int tt = 0; tt < 32; ++tt) { const int t = DIR == 0 ? tt : 31 - tt; const int ri = 4 * (t >> 3) + (t & 3);
        const f32x2 b = ((t >> 2) & 1) ? (f32x2){dre1[ri], dim1[ri]} : (f32x2){dre0[ri], dim0[ri]};
        const f32x2 hs_ = {-hh.y, hh.x}; hh = b + (hh * ar + hs_ * ai);
        if (WR) st[t * 68 + lane] = pk2(hh.x, hh.y); }
}
template <int DIR> __device__ __forceinline__ void ssm_s1_run(float ar, float ai, const bf16x8 (&bf4)[4], const LAS float* us, float* o, int lane) {
    f32x2 hh = {0.f, 0.f};
    if (DIR == 0) { ssm_tile32<0, false>(us, bf4, ar, ai, hh, nullptr, 0, lane); ssm_tile32<0, false>(us, bf4, ar, ai, hh, nullptr, 32, lane); }
    else          { ssm_tile32<1, false>(us, bf4, ar, ai, hh, nullptr, 32, lane); ssm_tile32<1, false>(us, bf4, ar, ai, hh, nullptr, 0, lane); }
    o[lane] = hh.x; o[64 + lane] = hh.y;
}
template <int DIR, int T> __device__ __forceinline__ void ssm_s3_tile(float ar, float ai, const bf16x8 (&bf4)[4], const bf16x8 (&cb)[4], f32x2& hh, const LAS float* us, LAS unsigned* st, pg8::f32x4 (&yacc)[4], int lane) {
    const int fr = lane & 15, fq = lane >> 4;
    ssm_tile32<DIR, true>(us, bf4, ar, ai, hh, st, 32 * T, lane);
#pragma unroll
    for (int mt = 0; mt < 2; ++mt)
#pragma unroll
        for (int ks = 0; ks < 4; ++ks) { const bf16x8 a0 = *(const LAS bf16x8*)((const LAS unsigned char*)st + (16 * mt + fr) * 272 + (32 * ks + 8 * fq) * 2);
            yacc[2 * T + mt] = __builtin_amdgcn_mfma_f32_16x16x32_bf16(cb[ks], a0, yacc[2 * T + mt], 0, 0, 0); }
}
template <int DIR> __device__ __forceinline__ void ssm_s3_run(float ar, float ai, const bf16x8 (&bf4)[4], const bf16x8 (&cb)[4], f32x2 hh, const LAS float* us, LAS unsigned* st, pg8::f32x4 (&yacc)[4], int lane) {
    if (DIR == 0) { ssm_s3_tile<0, 0>(ar, ai, bf4, cb, hh, us, st, yacc, lane); ssm_s3_tile<0, 1>(ar, ai, bf4, cb, hh, us, st, yacc, lane); }
    else          { ssm_s3_tile<1, 1>(ar, ai, bf4, cb, hh, us, st, yacc, lane); ssm_s3_tile<1, 0>(ar, ai, bf4, cb, hh, us, st, yacc, lane); }
}
__device__ __forceinline__ void cmul_add(float& dr, float& di, float ar, float ai, float br, float bi, float cr, float ci) { dr = ar * br - ai * bi + cr; di = ar * bi + ai * br + ci; }
__device__ __forceinline__ void ssm_s2_task(const f32x4* AB, const float* S, float* HIN, int layer, int task, int lane) {
    const int p = task & 63, g = (task >> 6) & 31, dir = task >> 11;
    const f32x4 ab = AB[((layer * 2 + dir) * 32 + g) * 64 + p]; const float ar = ab.z, ai = ab.w;
    const size_t dbase = (size_t)dir * NCH * 32 * 128 + (size_t)g * 128 + p;
#define CH_OF(q) (dir == 0 ? (((q) + 256) % NCH) : (NCH - 1 - (q)))
    float h4r = 0.f, h4i = 0.f;
    for (int q = 0; q < 4; ++q) { const size_t o = dbase + (size_t)CH_OF(q) * 4096; if (lane == 0) { HIN[o] = h4r; HIN[o + 64] = h4i; }
        const float sr = S[o], si = S[o + 64]; float nr, ni; cmul_add(nr, ni, ar, ai, h4r, h4i, sr, si); h4r = nr; h4i = ni; }
    float sr[4], si[4];
#pragma unroll
    for (int i = 0; i < 4; ++i) { const size_t o = dbase + (size_t)CH_OF(4 + 4 * lane + i) * 4096; sr[i] = S[o]; si[i] = S[o + 64]; }
    float er = sr[0], ei = si[0];
#pragma unroll
    for (int i = 1; i < 4; ++i) { float nr, ni; cmul_add(nr, ni, ar, ai, er, ei, sr[i], si[i]); er = nr; ei = ni; }
    float mr, mi; { const float a2r = ar * ar - ai * ai, a2i = 2.f * ar * ai; mr = a2r * a2r - a2i * a2i; mi = 2.f * a2r * a2i; }
#pragma unroll
    for (int d = 1; d < 64; d <<= 1) {
        const float pr = __shfl_up(er, d), pi = __shfl_up(ei, d), qr = __shfl_up(mr, d), qi = __shfl_up(mi, d);
        if (lane >= d) { float nr, ni; cmul_add(nr, ni, mr, mi, pr, pi, er, ei); er = nr; ei = ni; const float tr = mr * qr - mi * qi, ti = mr * qi + mi * qr; mr = tr; mi = ti; }
    }
    float outr, outi; cmul_add(outr, outi, mr, mi, h4r, h4i, er, ei);
    float inr = __shfl_up(outr, 1), ini = __shfl_up(outi, 1);
    if (lane == 0) { inr = h4r; ini = h4i; }
#pragma unroll
    for (int i = 0; i < 4; ++i) { const size_t o = dbase + (size_t)CH_OF(4 + 4 * lane + i) * 4096; HIN[o] = inr; HIN[o + 64] = ini; float nr, ni; cmul_add(nr, ni, ar, ai, inr, ini, sr[i], si[i]); inr = nr; ini = ni; }
#undef CH_OF
}

#define MFMA16(a, b, c) __builtin_amdgcn_mfma_f32_16x16x32_bf16(a, b, c, 0, 0, 0)
__device__ __forceinline__ void fft1_task(const bf16_t* UF, bf16_t* TB, const f32x2* TW, const LAS unsigned char* w1, int task, int lane) {
    const int fr = lane & 15, fq = lane >> 4, n2 = task >> 5, cb = task & 31;
    bf16x8 xb[4];
#pragma unroll
    for (int ks = 0; ks < 4; ++ks)
#pragma unroll
        for (int i = 0; i < 8; ++i) xb[ks][i] = (short)UF[(size_t)(128 * (32 * ks + 8 * fq + i) + n2) * 512 + 16 * cb + fr];
    f32x2 twc = TW[fr * 128 + n2];
    bf16_t* tbp = TB + ((size_t)fr * 128 + n2) * 512 + 16 * cb + 4 * fq;
#pragma unroll 1
    for (int mt = 0; mt < 8; ++mt) {
        const int mn = mt < 7 ? mt + 1 : mt; const f32x2 twn = TW[(16 * mn + fr) * 128 + n2];
        pg8::f32x4 accr = {0.f, 0.f, 0.f, 0.f}, acci = {0.f, 0.f, 0.f, 0.f};
#pragma unroll
        for (int ks = 0; ks < 4; ++ks) {
            const bf16x8 wre = *(const LAS bf16x8*)(w1 + (16 * mt + fr) * 272 + (32 * ks + 8 * fq) * 2);
            const bf16x8 wim = *(const LAS bf16x8*)(w1 + (128 + 16 * mt + fr) * 272 + (32 * ks + 8 * fq) * 2);
            accr = MFMA16(xb[ks], wre, accr); acci = MFMA16(xb[ks], wim, acci);
        }
        float tr[4], ti[4];
#pragma unroll
        for (int e = 0; e < 4; ++e) { tr[e] = accr[e] * twc.x + acci[e] * twc.y; ti[e] = acci[e] * twc.x - accr[e] * twc.y; }
        u32x2 wr_; wr_.x = pk2(tr[0], tr[1]); wr_.y = pk2(tr[2], tr[3]); u32x2 wi_; wi_.x = pk2(ti[0], ti[1]); wi_.y = pk2(ti[2], ti[3]);
        *(u32x2*)tbp = wr_; *(u32x2*)(tbp + (size_t)128 * 65536) = wi_;
        tbp += (size_t)16 * 65536;
        twc = twn;
    }
}
__device__ __forceinline__ void fft2_task(const bf16_t* TB, bf16_t* XF, const LAS unsigned char* w2, int task, int lane) {
    const int fr = lane & 15, fq = lane >> 4, k1 = task >> 5, cb = task & 31, c = 16 * cb + fr, hh = cb >> 3, cc4 = (16 * cb & 127) + 4 * fq;
    bf16x8 tb[8];
#pragma unroll
    for (int ks = 0; ks < 8; ++ks)
#pragma unroll
        for (int i = 0; i < 8; ++i) { const int kk = 32 * ks + 8 * fq + i; tb[ks][i] = (short)TB[((size_t)((kk >> 7) * 128 + k1) * 128 + (kk & 127)) * 512 + c]; }
    for (int mt = 0; mt < 16; ++mt) {
        pg8::f32x4 acc = {0.f, 0.f, 0.f, 0.f};
#pragma unroll
        for (int ks = 0; ks < 8; ++ks) { const bf16x8 w = *(const LAS bf16x8*)(w2 + (16 * mt + fr) * 528 + (32 * ks + 8 * fq) * 2); acc = MFMA16(tb[ks], w, acc); }
        const int r = 16 * mt + fr, po = r >> 7, k2 = r & 127;
        u32x2 o; o.x = pk2(acc[0], acc[1]); o.y = pk2(acc[2], acc[3]);
        *(u32x2*)(XF + (size_t)(k1 + 128 * k2) * 1024 + hh * 256 + po * 128 + cc4) = o;
    }
}
__device__ __forceinline__ void fftc_task(const bf16_t* UF, bf16_t* XF, const bf16_t* WC, int task, int lane) {
    const int fr = lane & 15, fq = lane >> 4, cb = task & 31, mtg = task >> 5, c = 16 * cb + fr, hh = cb >> 3, cc4 = (16 * cb & 127) + 4 * fq;
    bf16x8 xb[8];
#pragma unroll
    for (int ks = 0; ks < 8; ++ks)
#pragma unroll
        for (int i = 0; i < 8; ++i) xb[ks][i] = (short)UF[(size_t)(L + 32 * ks + 8 * fq + i) * 512 + c];
    for (int mt = 8 * mtg; mt < 8 * mtg + 8; ++mt) {
        pg8::f32x4 acc = {0.f, 0.f, 0.f, 0.f};
#pragma unroll
        for (int ks = 0; ks < 8; ++ks) { const bf16x8 w = *(const bf16x8*)(WC + (size_t)(16 * mt + fr) * 256 + 32 * ks + 8 * fq); acc = MFMA16(xb[ks], w, acc); }
        const int r = 16 * mt + fr, po = r >> 8, kk = r & 255;
        u32x2 o; o.x = pk2(acc[0], acc[1]); o.y = pk2(acc[2], acc[3]);
        *(u32x2*)(XF + (size_t)(L + kk) * 1024 + hh * 256 + po * 128 + cc4) = o;
    }
}

#define XB_TMO      128
#define XB_XCNT(j)  (256  + 64 * (j))
#define XB_XSUB(j)  (1280 + 64 * (j))
#define XB_XGEN(j)  (2304 + 64 * (j))
#define XB_TOP      3328
#define XB_TOPGEN   3392
#define XCD_BAR_WORDS 3456
#define XB_SPIN_CAP (1u << 18)

__device__ __forceinline__ unsigned xb_ld(unsigned* p)              { return __hip_atomic_load(p, __ATOMIC_RELAXED, __HIP_MEMORY_SCOPE_AGENT); }
__device__ __forceinline__ unsigned xb_add(unsigned* p, unsigned v) { return __hip_atomic_fetch_add(p, v, __ATOMIC_RELAXED, __HIP_MEMORY_SCOPE_AGENT); }
__device__ __forceinline__ unsigned xb_xcc_id() { return (unsigned)__builtin_amdgcn_s_getreg((3 << 11) | 20) & 0xFu; }
#define XB_SPIN(cond, bar) do { unsigned _sp = 0; while (cond) { __builtin_amdgcn_s_sleep(1); \
    if ((++_sp & 255u) == 0u) { if (xb_ld(&(bar)[XB_TMO])) break; if (_sp > XB_SPIN_CAP) { atomicAdd(&(bar)[XB_TMO], 1u); break; } } } } while (0)

struct XcdBarrier {
    unsigned* bar; unsigned x;
    volatile LAS unsigned* st;
};

__device__ __forceinline__ XcdBarrier xcd_barrier_post(unsigned* bar, volatile LAS unsigned* st) {
    XcdBarrier b; b.bar = bar; b.x = xb_xcc_id(); b.st = st;
    if (threadIdx.x == 0) (void)xb_add(&bar[XB_XCNT(b.x)], 1u);
    return b;
}
__device__ __forceinline__ void xcd_barrier_complete(unsigned* bar, unsigned x, unsigned& nloc, unsigned& nx) {
    const unsigned G = gridDim.x * gridDim.y * gridDim.z;
    unsigned sum, cnt, mine, sp = 0u;
    for (;;) {
        sum = 0u; cnt = 0u; mine = 0u;
#pragma unroll
        for (unsigned j = 0; j < 16; ++j) { const unsigned c = xb_ld(&bar[XB_XCNT(j)]); sum += c; cnt += (c > 0u) ? 1u : 0u; mine = (j == x) ? c : mine; }
        if (sum == G) break;
        __builtin_amdgcn_s_sleep(1);
        if ((++sp & 255u) == 0u) { if (xb_ld(&bar[XB_TMO])) break; if (sp > XB_SPIN_CAP) { atomicAdd(&bar[XB_TMO], 1u); break; } }
    }
    nloc = mine > 0u ? mine : 1u; nx = cnt > 0u ? cnt : 1u;
}

__device__ __forceinline__ void xcd_barrier(const XcdBarrier& b) {
    asm volatile("s_waitcnt vmcnt(0)" ::: "memory");
    __syncthreads();
    if (threadIdx.x == 0) {
        unsigned* bar = b.bar;
        __builtin_amdgcn_s_waitcnt(0);
        unsigned nloc = b.st[0], nx = b.st[1];
        if (nloc == 0u) { xcd_barrier_complete(bar, b.x, nloc, nx); b.st[0] = nloc; b.st[1] = nx; }
        const unsigned old = xb_add(&bar[XB_XSUB(b.x)], 1u);
        const unsigned gen = old / nloc;
        if (old + 1u == (gen + 1u) * nloc) {
            __builtin_amdgcn_fence(__ATOMIC_RELEASE, "agent");
            asm volatile("s_waitcnt vmcnt(0)" ::: "memory");
            const unsigned og = xb_add(&bar[XB_TOP], 1u);
            const unsigned tg = og / nx;
            if (og + 1u == (tg + 1u) * nx) xb_add(&bar[XB_TOPGEN], 1u);
            else XB_SPIN(xb_ld(&bar[XB_TOPGEN]) == tg, bar);
            __builtin_amdgcn_fence(__ATOMIC_ACQUIRE, "agent");
            xb_add(&bar[XB_XGEN(b.x)], 1u);
            asm volatile("s_waitcnt vmcnt(0)" ::: "memory");
        } else {
            XB_SPIN(xb_ld(&bar[XB_XGEN(b.x)]) == gen, bar);
            __builtin_amdgcn_fence(__ATOMIC_ACQUIRE, "agent");
            asm volatile("s_waitcnt vmcnt(0)" ::: "memory");
        }
    }
    __syncthreads();
}

constexpr int TAB_OFF = LDS_BYTES - 256;
__device__ __forceinline__ const void* tabptr(LAS unsigned char* lds, int i) {
    const LAS unsigned* t = (const LAS unsigned*)(lds + TAB_OFF) + 2 * i;
    const unsigned lo = __builtin_amdgcn_readfirstlane(t[0]), hi = __builtin_amdgcn_readfirstlane(t[1]);
    return (const void*)(((unsigned long long)hi << 32) | lo);
}
#define INP(i) ((const float*)tabptr(lds, (i)))
#define PH_IDS \
    int tid = threadIdx.x; asm volatile("" : "+v"(tid)); const int lane = tid & 63, wave = __builtin_amdgcn_readfirstlane(tid >> 6); \
    int bx = blockIdx.x, G = gridDim.x; asm volatile("" : "+s"(bx), "+s"(G)); \
    const int gw = bx * 8 + wave, NGW = G * 8, gt = bx * 512 + tid, NTH = G * 512; (void)lane; (void)gw; (void)NGW; (void)gt; (void)NTH; \
    unsigned char* ws = (unsigned char*)tabptr(lds, 29); (void)ws;
#define WSP(T, off) ((T*)(ws + (off)))
__device__ __forceinline__ void conv_item(LAS unsigned char* lds, unsigned char* ws, int it, LAS float* scr, int lane) {
    const int layer = it / 10816; int r = it - layer * 10816;
    if (r < 1280) { tr_item(INP(10) + (size_t)layer * DM * INW, DM, INW, WSP(bf16_t, O_WIN) + (size_t)layer * INW * DM, 0, scr, r, lane); return; } r -= 1280;
    if (r < 1024) { tr_item(INP(24) + (size_t)layer * DM * DM, DM, DM, WSP(bf16_t, O_WOUT) + (size_t)layer * DM * DM, 0, scr, r, lane); return; } r -= 1024;
    if (r < 2816) { tr_item(INP(25) + (size_t)layer * DM * FF, DM, FF, WSP(bf16_t, O_WGU) + (size_t)layer * 2 * FF * DM, 1, scr, r, lane); return; } r -= 2816;
    if (r < 2816) { tr_item(INP(26) + (size_t)layer * DM * FF, DM, FF, WSP(bf16_t, O_WGU) + (size_t)layer * 2 * FF * DM, 2, scr, r, lane); return; } r -= 2816;
    if (r < 2816) { tr_item(INP(27) + (size_t)layer * FF * DM, FF, DM, WSP(bf16_t, O_WDN) + (size_t)layer * DM * FF, 0, scr, r, lane); return; } r -= 2816;
    tr_item(INP(21) + (size_t)layer * 512 * 512, 512, 512, WSP(bf16_t, O_WGLU) + (size_t)layer * 512 * 512, 0, scr, r, lane);
}
constexpr int CONV_P0 = 6552;
constexpr int CONV_B = 6616;
constexpr int CONV_A = 4200;

#define GSYNC() do { XcdBarrier b_; b_.bar = (unsigned*)((unsigned char*)tabptr(lds, 29) + O_BAR); b_.x = xb_xcc_id(); b_.st = (volatile LAS unsigned*)(lds + TAB_OFF - 16); xcd_barrier(b_); } while (0)

#ifndef PROBE_CAT
#define PROBE_CAT 0
#endif
#if PROBE_CAT
#define PB(cat) do { if (PROBE_CAT == (cat)) t_st = __builtin_amdgcn_s_memrealtime(); } while (0)
#define PE(cat) do { if (PROBE_CAT == (cat)) t_acc += __builtin_amdgcn_s_memrealtime() - t_st; } while (0)
#else
#define PB(cat) do {} while (0)
#define PE(cat) do {} while (0)
#endif
__global__ void __launch_bounds__(512, 2) hybrid_fwd(Params P) {
    extern __shared__ __attribute__((aligned(16))) unsigned char lds_raw[];
    cg::grid_group grid = cg::this_grid();
#if PROBE_CAT
    unsigned long long t_acc = 0, t_st = 0;
#endif
    LAS unsigned char* lds = (LAS unsigned char*)lds_raw;
    if (threadIdx.x == 0) {
        LAS unsigned long long* t = (LAS unsigned long long*)(lds + TAB_OFF);
#pragma unroll
        for (int i = 0; i < 28; ++i) t[i] = (unsigned long long)P.in[i];
        t[28] = (unsigned long long)P.out; t[29] = (unsigned long long)P.ws;
        LAS unsigned* xst = (LAS unsigned*)(lds + TAB_OFF - 16); xst[0] = 0u; xst[1] = 0u;
        (void)xb_add((unsigned*)(P.ws + O_BAR) + XB_XCNT(xb_xcc_id()), 1u);
    }
    __syncthreads();

    PB(5);
    {
        PH_IDS
        LAS float* sl = (LAS float*)lds;
        LAS float* ct = (LAS float*)(lds + 16384);
        { const float* cin = INP(1); const float* cctx = INP(3);
          for (int i = tid; i < 2048; i += 512) { const float a = cin[i], b = cctx[i]; sl[i] = a / (1.f + expf(-a)); sl[2048 + i] = b / (1.f + expf(-b)); } }
        if (tid < 128) ct[tid] = cospif((float)tid * (1.f / 64.f));
        __syncthreads();
        { const float* adaw = INP(4); float* MODP = WSP(float, O_MODP);
          for (int it = gt; it < 98304; it += NTH) {
            const int kc = it / 6144, r = it - kc * 6144, layer = r / 3072, c4 = r - layer * 3072;
            const float* w = adaw + ((size_t)layer * 2048 + kc * 128) * 12288 + 4 * c4;
            f32x4 a0 = {0.f, 0.f, 0.f, 0.f}, a1 = {0.f, 0.f, 0.f, 0.f};
#pragma unroll 8
            for (int k = 0; k < 128; ++k) { const f32x4 wv = *(const f32x4*)(w + (size_t)k * 12288); const float s0 = sl[kc * 128 + k], s1 = sl[2048 + kc * 128 + k]; a0 += wv * s0; a1 += wv * s1; }
            float* o = MODP + ((size_t)(kc * 2 + layer) * 2) * 12288 + 4 * c4;
            *(f32x4*)o = a0; *(f32x4*)(o + 12288) = a1;
          } }
        { float* ROPE = WSP(float, O_ROPE);
          for (int it = gt; it < 8192; it += NTH) { const int pos = it >> 5, i = it & 31; const float freq = powf(10000.f, -(float)i * (1.f / 32.f)); const float ang = (float)pos * freq;
            const double a = (double)ang, kq = rint(a * 0.15915494309189535), rr = a - kq * 6.283185307179586; const float rf = (float)rr; ROPE[2 * it] = cosf(rf); ROPE[2 * it + 1] = sinf(rf); } }
        { const float* lamre = INP(13); const float* lamim = INP(14); const float* logdt = INP(15); const float* bre = INP(16); const float* bim = INP(17); const float* cre = INP(18); const float* cim = INP(19);
          f32x4* AB = WSP(f32x4, O_AB); unsigned* BBT32 = WSP(unsigned, O_BBT); unsigned* CB32 = WSP(unsigned, O_CB);
          for (int it = gt; it < 8192; it += NTH) {
            const int p = it & 63;
            const float lr = lamre[it], li = lamim[it], ldt = logdt[it >> 6];
            const float dt = expf(ldt), mag = expf(lr * dt), th = li * dt;
            const float ar = mag * cosf(th), ai = mag * sinf(th);
            const float den = lr * lr + li * li, cr = ((ar - 1.f) * lr + ai * li) / den, ci = (ai * lr - (ar - 1.f) * li) / den;
            float pr = ar, pi = ai;
#pragma unroll
            for (int s = 0; s < 6; ++s) { const float nr = pr * pr - pi * pi, ni = 2.f * pr * pi; pr = nr; pi = ni; }
            AB[it] = (f32x4){ar, ai, pr, pi};
#pragma unroll
            for (int h = 0; h < 16; h += 2) { const float br0 = bre[(size_t)it * 16 + h], bi0 = bim[(size_t)it * 16 + h], br1 = bre[(size_t)it * 16 + h + 1], bi1 = bim[(size_t)it * 16 + h + 1];
                BBT32[((size_t)(it >> 6) * 128 + p) * 8 + (h >> 1)] = pk2(cr * br0 - ci * bi0, cr * br1 - ci * bi1);
                BBT32[((size_t)(it >> 6) * 128 + 64 + p) * 8 + (h >> 1)] = pk2(cr * bi0 + ci * br0, cr * bi1 + ci * br1); }
#pragma unroll
            for (int h = 0; h < 16; ++h) { const size_t ci_ = ((size_t)(it >> 6) * 16 + h) * 64 + p; CB32[ci_] = pk2(cre[ci_], -cim[ci_]); }
          } }
        { bf16_t* W1 = WSP(bf16_t, O_W1); bf16_t* W2 = WSP(bf16_t, O_W2); bf16_t* WC = WSP(bf16_t, O_WC); f32x2* TW = WSP(f32x2, O_TW);
          for (int it = gt; it < 32768; it += NTH) { const int r = it >> 7, n1 = it & 127, m = ((r & 127) * n1) & 127; const float x = (float)m * (1.f / 64.f); W1[it] = f2bf(r < 128 ? cospif(x) : -sinpif(x)); }
          for (int it = gt; it < 65536; it += NTH) { const int r = it >> 8, kk = it & 255, po = r >> 7, k2 = r & 127, pi_ = kk >> 7, n2 = kk & 127, m = (k2 * n2) & 127; const float x = (float)m * (1.f / 64.f);
            const float cv = cospif(x), sv = sinpif(x); W2[it] = f2bf(po == pi_ ? cv : (po == 0 ? sv : -sv)); }
          for (int it = gt; it < 131072; it += NTH) { const int r = it >> 8, n = it & 255, part = r >> 8, k = r & 255, m = (k * n) & 255; const float x = (float)m * (1.f / 128.f); WC[it] = f2bf(8.f * (part == 0 ? cospif(x) : -sinpif(x))); }
          for (int it = gt; it < 16384; it += NTH) { const int k1 = it >> 7, n2 = it & 127; const float x = (float)(k1 * n2) * (1.f / 8192.f); TW[it] = (f32x2){cospif(x), sinpif(x)}; } }
        { const float* fwp = INP(23); bf16_t* WF = WSP(bf16_t, O_WF);
          for (int it = gt; it < 2 * 131072; it += NTH) { const int layer = it >> 17, r = it & 131071, n4 = r & 127, kk = r >> 7, hh = kk >> 8, part = (kk >> 7) & 1, c = kk & 127;
            const float* fw = fwp + (size_t)layer * 262144 + (size_t)(hh * 128) * 512 + 4 * n4; f32x4 acc = {0.f, 0.f, 0.f, 0.f};
#pragma unroll 4
            for (int j = 0; j < 128; ++j) { const int m = (c * j) & 127; const float t = part ? ct[(m + 96) & 127] : ct[m]; acc += *(const f32x4*)(fw + (size_t)j * 512) * t; }
            bf16_t* o = WF + (size_t)layer * 524288 + (size_t)(4 * n4) * 1024 + kk;
            o[0] = f2bf(acc.x * 6.9053396600248786e-4f); o[1024] = f2bf(acc.y * 6.9053396600248786e-4f); o[2048] = f2bf(acc.z * 6.9053396600248786e-4f); o[3072] = f2bf(acc.w * 6.9053396600248786e-4f); } }
        __syncthreads();
        { LAS float* scr = (LAS float*)(lds + wave * 16640);
          if (G == 256) { for (int it = gw; it < CONV_P0 + 64; it += NGW) conv_item(lds, ws, it < CONV_P0 ? it : 10752 + (it - CONV_P0), scr, lane); }
          else { for (int it = gw; it < 2 * 10816; it += NGW) conv_item(lds, ws, it, scr, lane); } }
    }
    grid.sync();
    {
        PH_IDS
        const float* adab = INP(5); const float* MODP = WSP(float, O_MODP); float* MOD = WSP(float, O_MOD);
        for (int it = gt; it < 49152; it += NTH) { const int layer = it / 24576, v = (it / 12288) & 1, col = it % 12288; float s = adab[layer * 12288 + col];
#pragma unroll
            for (int kc = 0; kc < 16; ++kc) s += MODP[((size_t)(kc * 2 + layer) * 2 + v) * 12288 + col];
            MOD[it] = s; }
    }
    GSYNC();
    PE(5); PB(4);
    {
        PH_IDS
        const float* MOD = WSP(float, O_MOD);
        prenorm_rows(INP(0), INP(2), WSP(bf16_t, O_H), INP(6), MOD, MOD + 12288, 0, 2048, MT, gw, NGW, lane);
    }
    GSYNC();

    PE(4);
#pragma unroll 1
    for (int layer = 0; layer < 2; ++layer) {
        PB(1);
        { PH_IDS
          pg8::Gemm g{WSP(bf16_t, O_H), WSP(bf16_t, O_WIN) + (size_t)layer * INW * DM, MT, INW, DM}; pg8::StaticOrder S; S.init(MT, INW, G, bx);
          EpiIn E{WSP(float, O_QRAW), WSP(float, O_KRAW), WSP(bf16_t, O_VB), WSP(bf16_t, O_US), WSP(bf16_t, O_UF)};
          pg8::gemm_phase<EpiIn, pg8::StaticOrder, true, true>(lds, g, S, E);
          if (G == 256 && bx >= 138) { LAS float* scr = (LAS float*)(lds + wave * 16640);
              if (layer == 0) { for (int r = CONV_P0 + (bx - 138) * 8 + wave; r < 10752; r += 118 * 8) conv_item(lds, ws, r, scr, lane); }
              else            { for (int r = CONV_B + (bx - 138) * 8 + wave; r < 10816; r += 118 * 8) conv_item(lds, ws, 10816 + r, scr, lane); } } }
        GSYNC();
        PE(1); PB(3); PB(31);
        {
            PH_IDS
            { const bf16_t* W1 = WSP(bf16_t, O_W1);
              for (int i = tid; i < 256 * 16; i += 512) { const int r = i >> 4, ch = i & 15; *(LAS u32x4*)(lds + r * 272 + ch * 16) = *(const u32x4*)(W1 + r * 128 + ch * 8); } }
            __syncthreads();
            { const bf16_t* UF = WSP(bf16_t, O_UF); bf16_t* TB = WSP(bf16_t, O_TB); const f32x2* TW = WSP(f32x2, O_TW);
              for (int task = gw; task < 4096; task += NGW) fft1_task(UF, TB, TW, lds, task, lane); }
            { LAS float* usb = (LAS float*)(lds + 69632 + wave * 8192);
              const bf16_t* US = WSP(bf16_t, O_US); const f32x4* AB = WSP(f32x4, O_AB); const bf16_t* BBT = WSP(bf16_t, O_BBT); float* SS = WSP(float, O_S);
              int cur = 0;
              if (gw < NCH * 32) ssm_dma_u(US, usb, gw >> 5, gw & 31, lane);
              for (int task = gw; task < NCH * 32; task += NGW) { const int k = task >> 5, g = task & 31, nxt = task + NGW;
                asm volatile("s_waitcnt vmcnt(0)" ::: "memory");
                if (nxt < NCH * 32) ssm_dma_u(US, usb + (cur ^ 1) * 1024, nxt >> 5, nxt & 31, lane);
                const int ldg0 = (layer * 2) * 32 + g, ldg1 = ldg0 + 32;
                const f32x4 ab0 = AB[ldg0 * 64 + lane], ab1 = AB[ldg1 * 64 + lane];
                const LAS float* us = usb + cur * 1024;
                bf16x8 bf0[4], bf1[4]; ssm_load_bf4(BBT, bf0, ldg0, lane); ssm_load_bf4(BBT, bf1, ldg1, lane);
                ssm_s1_run<0>(ab0.x, ab0.y, bf0, us, SS + ((size_t)(0 * NCH + k) * 32 + g) * 128, lane);
                ssm_s1_run<1>(ab1.x, ab1.y, bf1, us, SS + ((size_t)(1 * NCH + k) * 32 + g) * 128, lane);
                cur ^= 1; } }
            kq_post(WSP(float, O_QRAW), WSP(float, O_KRAW), WSP(bf16_t, O_QB), WSP(bf16_t, O_KB), INP(11) + layer * 128, INP(12) + layer * 128, WSP(float, O_ROPE), gw, NGW, lane);
        }
        GSYNC();
        PE(31); PB(32);
        {
            PH_IDS
            { const bf16_t* W2 = WSP(bf16_t, O_W2);
              for (int i = tid; i < 256 * 32; i += 512) { const int r = i >> 5, ch = i & 31; *(LAS u32x4*)(lds + r * 528 + ch * 16) = *(const u32x4*)(W2 + r * 256 + ch * 8); } }
            __syncthreads();
            { const f32x4* AB = WSP(f32x4, O_AB); const float* SS = WSP(float, O_S); float* HIN = WSP(float, O_HIN);
              for (int task = gw; task < 4096; task += NGW) ssm_s2_task(AB, SS, HIN, layer, task, lane); }
            { const bf16_t* TB = WSP(bf16_t, O_TB); bf16_t* XF = WSP(bf16_t, O_XF);
              for (int task = gw; task < 4096; task += NGW) fft2_task(TB, XF, lds, task, lane); }
            if (layer == 0) { const bf16_t* UF = WSP(bf16_t, O_UF); bf16_t* XF = WSP(bf16_t, O_XF); const bf16_t* WC = WSP(bf16_t, O_WC);
              for (int task = gw; task < 128; task += NGW) fftc_task(UF, XF, WC, task, lane); }
        }
        GSYNC();
        PE(32); PB(33);
        {
            PH_IDS
            LAS float* usb = (LAS float*)(lds + wave * 16896);
            LAS unsigned* st = (LAS unsigned*)(lds + wave * 16896 + 8192);
            const int fr = lane & 15, fq = lane >> 4;
            const int ntask = (layer == 0 ? NCH : 256) * 32;
            const bf16_t* US = WSP(bf16_t, O_US); const f32x4* AB = WSP(f32x4, O_AB); const bf16_t* BBT = WSP(bf16_t, O_BBT); const bf16_t* CB = WSP(bf16_t, O_CB); const float* HIN = WSP(float, O_HIN);
            bf16_t* GB = WSP(bf16_t, O_G); const float* dvp = INP(20) + layer * 512;
            int cur = 0;
            if (gw < ntask) ssm_dma_u(US, usb, gw >> 5, gw & 31, lane);
            for (int task = gw; task < ntask; task += NGW) { const int k = task >> 5, g = task & 31, nxt = task + NGW;
                asm volatile("s_waitcnt vmcnt(0)" ::: "memory");
                if (nxt < ntask) ssm_dma_u(US, usb + (cur ^ 1) * 1024, nxt >> 5, nxt & 31, lane);
                const int ldg0 = (layer * 2) * 32 + g, ldg1 = ldg0 + 32;
                const f32x4 ab0 = AB[ldg0 * 64 + lane], ab1 = AB[ldg1 * 64 + lane];
                const float* hin0 = HIN + ((size_t)(0 * NCH + k) * 32 + g) * 128; const float* hin1 = HIN + ((size_t)(1 * NCH + k) * 32 + g) * 128;
                const f32x2 hh0 = {hin0[lane], hin0[64 + lane]}, hh1 = {hin1[lane], hin1[64 + lane]};
                const f32x4 dv4 = *(const f32x4*)(dvp + 16 * g + 4 * fq);
                bf16x8 cb0[4], cb1[4];
#pragma unroll
                for (int ks = 0; ks < 4; ++ks) { cb0[ks] = *(const bf16x8*)(CB + ((size_t)(ldg0 * 16 + fr)) * 128 + 32 * ks + 8 * fq); cb1[ks] = *(const bf16x8*)(CB + ((size_t)(ldg1 * 16 + fr)) * 128 + 32 * ks + 8 * fq); }
                const LAS float* us = usb + cur * 1024;
                pg8::f32x4 yacc[4];
#pragma unroll
                for (int q = 0; q < 4; ++q) yacc[q] = (pg8::f32x4){0.f, 0.f, 0.f, 0.f};
                bf16x8 bf0[4], bf1[4]; ssm_load_bf4(BBT, bf0, ldg0, lane); ssm_load_bf4(BBT, bf1, ldg1, lane);
                ssm_s3_run<0>(ab0.x, ab0.y, bf0, cb0, hh0, us, st, yacc, lane);
                ssm_s3_run<1>(ab1.x, ab1.y, bf1, cb1, hh1, us, st, yacc, lane);
#pragma unroll
                for (int q = 0; q < 4; ++q) { const int tok = 16 * q + fr; const u32x2 uw_ = *(const LAS u32x2*)((const LAS unsigned char*)us + (fq >> 1) * 1024 + tok * 16 + (fq & 1) * 8); const f32x4 u4 = {bf2f(uw_.x & 0xffffu), bf2f(uw_.x >> 16), bf2f(uw_.y & 0xffffu), bf2f(uw_.y >> 16)};
                    const float y0 = gelu_tanh(yacc[q][0] + dv4.x * u4.x), y1 = gelu_tanh(yacc[q][1] + dv4.y * u4.y), y2 = gelu_tanh(yacc[q][2] + dv4.z * u4.z), y3 = gelu_tanh(yacc[q][3] + dv4.w * u4.w);
                    u32x2 o; o.x = pk2(y0, y1); o.y = pk2(y2, y3); *(u32x2*)(GB + (size_t)(64 * k + tok) * 512 + 16 * g + 4 * fq) = o; }
                cur ^= 1;
            }
        }
        GSYNC();
        PE(3); PE(33); PB(6);
        { PH_IDS
          const int MR = layer == 0 ? MT : L;
          pg8::Gemm g{WSP(bf16_t, O_G), WSP(bf16_t, O_WGLU) + (size_t)layer * 512 * 512, MR, 512, 512}; pg8::StaticOrder S; S.init(MR, 512, G, bx);
          EpiMix E{WSP(bf16_t, O_CAT), WSP(bf16_t, O_G), INP(22) + layer * 512, 0};
          pg8::gemm_phase<EpiMix, pg8::StaticOrder, true, true>(lds, g, S, E); }
        __syncthreads();
        { PH_IDS
          const int MR = layer == 0 ? MT : L;
          pg8::Gemm g{WSP(bf16_t, O_XF), WSP(bf16_t, O_WF) + (size_t)layer * 524288, MR, 512, 1024}; pg8::StaticOrder S; S.init(MR, 512, G, (bx + 128) % G);
          EpiMix E{WSP(bf16_t, O_CAT), WSP(bf16_t, O_G), INP(22) + layer * 512, 1};
          pg8::gemm_phase<EpiMix, pg8::StaticOrder, true, true>(lds, g, S, E); }
        __syncthreads();
        PE(6); PB(2);
        { PH_IDS
          const float* q_ = WSP(const float, O_QRAW); const att::bf16* k_ = WSP(const att::bf16, O_KB); const att::bf16* v_ = WSP(const att::bf16, O_VB); att::bf16* o_ = WSP(att::bf16, O_CAT);
          const float* wqn = INP(11) + layer * 128; const float* ropet = WSP(float, O_ROPE);
          float negB;
          { const float* qn = INP(11) + layer * 128; const float* kn = INP(12) + layer * 128;
            float wq = fmaxf(fabsf(qn[lane]), fabsf(qn[64 + lane])), wk = fmaxf(fabsf(kn[lane]), fabsf(kn[64 + lane]));
#pragma unroll
            for (int o = 1; o < 64; o <<= 1) { wq = fmaxf(wq, __shfl_xor(wq, o)); wk = fmaxf(wk, __shfl_xor(wk, o)); }
            negB = -(16.32212f * wq * wk * 1.02f + 0.25f); }
          for (int u = bx; u < 512; u += G) { const int xcd = u & 7, j = (u >> 3) & 31, rr = u >> 8, kvh = xcd & 1, head = 4 * kvh + (xcd >> 1), qb = j + 32 * rr;
              att::attn_dense_body<float>(q_ + (size_t)qb * 256 * 1024 + head * 128, k_ + kvh * 128, v_ + kvh * 128, o_ + (size_t)qb * 256 * 2048 + head * 128, MT, (char*)lds_raw, negB, wqn, ropet, qb * 256);
              __syncthreads(); }
          if (layer == 0 && bx >= 8 && bx < 16) { const int head = bx - 8, kvh = head >> 2;
              att::attn_dense_body<float>(q_ + (size_t)L * 1024 + head * 128, k_ + (size_t)L * 256 + kvh * 128, v_ + (size_t)L * 256 + kvh * 128, o_ + (size_t)L * 2048 + head * 128, 256, (char*)lds_raw, negB, wqn, ropet, -1);
              __syncthreads(); }
        }
        GSYNC();
        PE(2); PB(1);
        { PH_IDS
          pg8::Gemm g{WSP(bf16_t, O_CAT), WSP(bf16_t, O_WOUT) + (size_t)layer * DM * DM, L, DM, DM}; pg8::StaticOrder S; S.init(L, DM, G, bx);
          EpiF32 E{WSP(bf16_t, O_Y), DM};
          pg8::gemm_phase<EpiF32, pg8::StaticOrder, true, true>(lds, g, S, E); }
        GSYNC();
        PE(1); PB(4);
        { PH_IDS
          const bool ctxl = (layer == 0) && (G > 16);
          if (ctxl && bx < 8) {
              pg8::Gemm g{WSP(bf16_t, O_CAT) + (size_t)L * DM, WSP(bf16_t, O_WOUT) + (size_t)layer * DM * DM, 256, DM, DM}; pg8::StaticOrder S; S.init(256, DM, 8, bx);
              EpiF32 E{WSP(bf16_t, O_Y) + (size_t)L * DM, DM};
              pg8::gemm_phase<EpiF32, pg8::StaticOrder, true, true>(lds, g, S, E);
          } else {
              const float* modl = WSP(float, O_MOD) + (size_t)layer * 24576; const float* modc = modl + 12288;
              float* outp = (float*)tabptr(lds, 28); float* XC = WSP(float, O_XC);
              const float* xl_src = layer == 0 ? INP(0) : outp; const float* xc_src = layer == 0 ? INP(2) : XC;
              const int gwp = ctxl ? gw - 64 : gw, ngwp = ctxl ? NGW - 64 : NGW;
              post_rows<true>(xl_src, xc_src, outp, XC, WSP(bf16_t, O_Y), INP(7) + layer * DM, modl, modc, 2 * 2048, true, WSP(bf16_t, O_H), INP(8) + layer * DM, modl, modc, 3 * 2048, 4 * 2048,
                        0, L, gwp, ngwp, lane, (LAS float*)lds, tid);
          } }
        GSYNC();
        if (layer == 0 && gridDim.x > 16) {
            { PH_IDS
              const float* modl = WSP(float, O_MOD); const float* modc = modl + 12288; float* outp = (float*)tabptr(lds, 28); float* XC = WSP(float, O_XC);
              post_rows<false>(INP(0), INP(2), outp, XC, WSP(bf16_t, O_Y), INP(7), modl, modc, 2 * 2048, true, WSP(bf16_t, O_H), INP(8), modl, modc, 3 * 2048, 4 * 2048, L, MT, gw, NGW, lane, (LAS float*)lds, tid); }
            GSYNC();
        }
        PE(4); PB(1);
        { PH_IDS
          const int MR = layer == 0 ? MT : L;
          pg8::Gemm g{WSP(bf16_t, O_H), WSP(bf16_t, O_WGU) + (size_t)layer * 2 * FF * DM, MR, 2 * FF, DM}; pg8::StaticOrder S; S.init(MR, 2 * FF, G, bx);
          EpiUp E{WSP(bf16_t, O_HID)};
          pg8::gemm_phase<EpiUp, pg8::StaticOrder, true, true>(lds, g, S, E);
          if (layer == 0 && G == 256 && bx >= 44) { LAS float* scr = (LAS float*)(lds + wave * 16640);
              for (int r = (bx - 44) * 8 + wave; r < CONV_B; r += 212 * 8) conv_item(lds, ws, 10816 + r, scr, lane); } }
        GSYNC();
        { PH_IDS
          pg8::Gemm g{WSP(bf16_t, O_HID), WSP(bf16_t, O_WDN) + (size_t)layer * DM * FF, L, DM, FF}; pg8::StaticOrder S; S.init(L, DM, G, bx);
          EpiF32 E{WSP(bf16_t, O_Y), DM};
          pg8::gemm_phase<EpiF32, pg8::StaticOrder, true, true>(lds, g, S, E); }
        GSYNC();
        PE(1); PB(4);
        { PH_IDS
          const bool ctxl = (layer == 0) && (G > 16);
          if (ctxl && bx < 32) {
              const int kp = bx >> 3;
              pg8::Gemm g{WSP(bf16_t, O_HID) + (size_t)L * FF + kp * (FF / 4), WSP(bf16_t, O_WDN) + (size_t)layer * DM * FF + kp * (FF / 4), 256, DM, FF / 4, FF}; pg8::StaticOrder S; S.init(256, DM, 8, bx & 7);
              EpiP32 E{WSP(float, O_YP) + (size_t)kp * 256 * DM, DM};
              pg8::gemm_phase<EpiP32, pg8::StaticOrder, true, true>(lds, g, S, E);
          } else {
              const float* modl = WSP(float, O_MOD) + (size_t)layer * 24576; const float* modc = modl + 12288; const float* nmodl = modl + 24576;
              float* outp = (float*)tabptr(lds, 28); float* XC = WSP(float, O_XC);
              const int gwp = ctxl ? gw - 256 : gw, ngwp = ctxl ? NGW - 256 : NGW;
              post_rows<true>(outp, XC, outp, XC, WSP(bf16_t, O_Y), INP(9) + layer * DM, modl, modc, 5 * 2048, layer == 0, WSP(bf16_t, O_H), INP(6) + (layer + 1) * DM, nmodl, nmodl + 12288, 0, 2048,
                        0, L, gwp, ngwp, lane, (LAS float*)lds, tid);
          } }
        GSYNC();
        if (layer == 0 && gridDim.x > 16) {
            { PH_IDS
              const float* modl = WSP(float, O_MOD); const float* modc = modl + 12288; const float* nmodl = modl + 24576; float* outp = (float*)tabptr(lds, 28); float* XC = WSP(float, O_XC);
              post_rows<false>(outp, XC, outp, XC, WSP(bf16_t, O_Y), INP(9), modl, modc, 5 * 2048, true, WSP(bf16_t, O_H), INP(6) + DM, nmodl, nmodl + 12288, 0, 2048, L, MT, gw, NGW, lane, (LAS float*)lds, tid, WSP(float, O_YP)); }
            GSYNC();
        }
        PE(4);
    }
#if PROBE_CAT == 9
    for (int i = 0; i < 40; ++i) grid.sync();
#endif
#if PROBE_CAT
    if (blockIdx.x == 0) { const unsigned long long t0 = __builtin_amdgcn_s_memrealtime(); while (__builtin_amdgcn_s_memrealtime() - t0 < t_acc) __builtin_amdgcn_s_sleep(8); }
#endif
}

extern "C" void kernel_launch(void* const* d_in, const int* in_sizes, int n_in, void* d_out, int out_size, void* d_ws, size_t ws_size, hipStream_t stream) {
    static int grid = 0;
    if (grid == 0) {
        if (n_in != 28 || ws_size < WS_END) { fprintf(stderr, "kernel_launch: n_in %d (want 28), ws %zu (want >= %zu)\n", n_in, ws_size, (size_t)WS_END); grid = -1; return; }
        int dev = 0, cus = 0, per_cu = 0;
        (void)hipGetDevice(&dev); (void)hipDeviceGetAttribute(&cus, hipDeviceAttributeMultiprocessorCount, dev);
        if (hipFuncSetAttribute((const void*)hybrid_fwd, hipFuncAttributeMaxDynamicSharedMemorySize, LDS_BYTES) != hipSuccess) { fprintf(stderr, "kernel_launch: hipFuncSetAttribute failed\n"); grid = -1; return; }
        if (hipOccupancyMaxActiveBlocksPerMultiprocessor(&per_cu, (const void*)hybrid_fwd, 512, LDS_BYTES) != hipSuccess || per_cu < 1) { fprintf(stderr, "kernel_launch: occupancy query gave %d\n", per_cu); per_cu = 1; }
        (void)hipGetLastError();
        grid = cus * 1;
        if (grid <= 0) grid = 256;
    }
    if (grid < 0) return;
    Params p{};
    for (int i = 0; i < 28; ++i) p.in[i] = (const float*)d_in[i];
    p.out = (float*)d_out; p.ws = (unsigned char*)d_ws;
    (void)hipMemsetAsync((unsigned char*)d_ws + O_BAR, 0, 16384, stream);
    void* args[] = {&p};
    hipError_t e = hipLaunchCooperativeKernel((const void*)hybrid_fwd, dim3(grid), dim3(512), args, LDS_BYTES, stream);
    if (e != hipSuccess) fprintf(stderr, "kernel_launch: cooperative launch failed: %s (grid %d)\n", hipGetErrorString(e), grid);
}
```
